# Optimizing an MI355X kernel written in HIP

```python
import jax, jax.numpy as jnp
from jax import lax
import numpy as np

D_MODEL = 1024
BATCH = 2
SEQ = 8192
DEPTH = 2

A_HEADS = 8
HEAD_DIM = 64
A_WIDTH = A_HEADS * HEAD_DIM
IDX_HEADS = 4
IDX_DIM = 64
TOPK_MAX = 256
Q_BLOCK = 128
ATTN_SCALE = HEAD_DIM ** -0.5
IDX_SCALE = (IDX_DIM ** -0.5) * (IDX_HEADS ** -0.5)

ROPE_THETA = 500000.0
ROT_DIM = HEAD_DIM // 4

B_HEADS = 4
B_DK = 32
B_DV = 64
B_KWIDTH = B_HEADS * B_DK
B_VWIDTH = B_HEADS * B_DV
GATE_RANK = 16
GATE_TAU = 16.0
CHUNK = 64

POOL_WINDOWS = (2, 4, 8, 16)
C_GROUPS = 4
C_GROUP_DIM = 64
C_WIDTH = C_GROUPS * C_GROUP_DIM

MIX_WIDTH = A_WIDTH + B_VWIDTH + C_WIDTH

SPLIT_SIZES = (
    A_WIDTH, A_WIDTH, A_WIDTH,
    IDX_HEADS * IDX_DIM, IDX_DIM, IDX_HEADS,
    B_KWIDTH, B_KWIDTH, B_VWIDTH, B_VWIDTH,
    GATE_RANK,
    C_WIDTH,
)
IN_WIDTH = sum(SPLIT_SIZES)

D_FF = 2816
CONV_WIDTH = 3
EPS = 1e-6

kernel_name = "hymba_dsa_gla_pool_convglu"


def rms_norm(x, g):
    xf = x.astype(jnp.float32)
    y = xf * lax.rsqrt(jnp.mean(xf * xf, axis=-1, keepdims=True) + EPS)
    return (y * g.astype(jnp.float32)).astype(x.dtype)


def rope_tables(positions):
    inv = ROPE_THETA ** (-jnp.arange(0, ROT_DIM, 2, dtype=jnp.float32) / ROT_DIM)
    ang = positions.astype(jnp.float32)[..., None] * inv
    return jnp.cos(ang), jnp.sin(ang)


def partial_rope(x, cos, sin):
    half = ROT_DIM // 2
    x1 = x[..., :half].astype(jnp.float32)
    x2 = x[..., half:ROT_DIM].astype(jnp.float32)
    c = cos[:, :, None, :]
    s = sin[:, :, None, :]
    rot = jnp.concatenate([x1 * c - x2 * s, x2 * c + x1 * s], axis=-1).astype(x.dtype)
    return jnp.concatenate([rot, x[..., ROT_DIM:]], axis=-1)


def split_cols(p):
    outs = []
    off = 0
    for n in SPLIT_SIZES:
        outs.append(p[..., off:off + n])
        off += n
    return outs


def dsa_attention(q, k, v, qi, ki, wi):
    nbat, S, H, Dh = q.shape
    n_keep = min(TOPK_MAX, S // 4)
    nb = S // Q_BLOCK
    key_pos = jnp.arange(S)
    ki_f = ki.astype(jnp.float32)

    def to_blocks(a):
        return a.reshape(nbat, nb, Q_BLOCK, *a.shape[2:]).swapaxes(0, 1)

    def block(args):
        qb, qib, wib, qpos = args
        logits = jnp.einsum('bqhd,bsd->bqhs', qib.astype(jnp.float32), ki_f)
        score = jnp.einsum('bqh,bqhs->bqs', wib.astype(jnp.float32), jax.nn.relu(logits)) * IDX_SCALE
        causal = key_pos[None, :] <= qpos[:, None]
        score = jnp.where(causal[None], score, -jnp.inf)
        _, idx = lax.top_k(score, n_keep)
        valid = idx <= qpos[None, :, None]
        kg = jax.vmap(lambda kk, ii: kk[ii])(k, idx)
        vg = jax.vmap(lambda vv, ii: vv[ii])(v, idx)
        s = jnp.einsum('bqhd,bqkhd->bhqk', qb.astype(jnp.float32), kg.astype(jnp.float32)) * ATTN_SCALE
        s = jnp.where(valid[:, None], s, -jnp.inf)
        p = jax.nn.softmax(s, axis=-1)
        o = jnp.einsum('bhqk,bqkhd->bqhd', p, vg.astype(jnp.float32))
        return o.astype(q.dtype)

    qpos_blocks = jnp.arange(S).reshape(nb, Q_BLOCK)
    out = lax.map(block, (to_blocks(q), to_blocks(qi), to_blocks(wi), qpos_blocks))
    return out.swapaxes(0, 1).reshape(nbat, S, H, Dh)


def gla_chunked(q, k, v, log_a):
    nbat, S, H, DK = q.shape
    DV = v.shape[-1]
    nc = S // CHUNK

    def chunks(a):
        return a.astype(jnp.float32).reshape(nbat, nc, CHUNK, H, a.shape[-1]).transpose(1, 0, 3, 2, 4)

    qc = chunks(q * (DK ** -0.5))
    kc, vc, gc = chunks(k), chunks(v), chunks(log_a)
    tri = jnp.tril(jnp.ones((CHUNK, CHUNK), dtype=bool))

    def step(state, inp):
        qq, kk, vv, gg = inp
        b = jnp.cumsum(gg, axis=2)
        o_inter = jnp.einsum('bhcd,bhde->bhce', qq * jnp.exp(b), state)
        diff = b[:, :, :, None, :] - b[:, :, None, :, :]
        decay = jnp.exp(jnp.where(tri[:, :, None], diff, -jnp.inf))
        att = jnp.einsum('bhid,bhjd,bhijd->bhij', qq, kk, decay)
        o_intra = jnp.einsum('bhij,bhje->bhie', att, vv)
        b_last = b[:, :, -1:, :]
        new_state = state * jnp.exp(b_last[:, :, 0, :, None]) + jnp.einsum(
            'bhcd,bhce->bhde', kk * jnp.exp(b_last - b), vv)
        return new_state, o_inter + o_intra

    state0 = jnp.zeros((nbat, H, DK, DV), jnp.float32)
    _, o = lax.scan(step, state0, (qc, kc, vc, gc))
    return o.transpose(1, 0, 3, 2, 4).reshape(nbat, S, H, DV)


def multiscale_pool(u, w_pool, pool_scale):
    nbat, S, _ = u.shape
    uf = u.astype(jnp.float32).reshape(nbat, S, C_GROUPS, C_GROUP_DIM)
    cs = jnp.concatenate([jnp.zeros((nbat, 1, C_GROUPS, C_GROUP_DIM), jnp.float32),
                          jnp.cumsum(uf, axis=1)], axis=1)
    pos = jnp.arange(S)
    win = jnp.array(POOL_WINDOWS, dtype=jnp.int32)
    lo_idx = jnp.maximum(pos[:, None] + 1 - win[None, :], 0)
    lo = cs[:, lo_idx, jnp.arange(C_GROUPS)[None, :]]
    cnt = jnp.minimum(pos[:, None] + 1, win[None, :]).astype(jnp.float32)
    pooled = (cs[:, 1:] - lo) / cnt[None, :, :, None] - uf
    y = jnp.einsum('bsgd,gde->bsge', pooled, w_pool.astype(jnp.float32))
    y = y * pool_scale.astype(jnp.float32).reshape(C_GROUPS, C_GROUP_DIM)
    return y.reshape(nbat, S, C_WIDTH).astype(u.dtype)


def conv_glu_ffn(x, w_up, conv_w, conv_b, w_down):
    S = x.shape[1]
    h = x @ w_up
    a, b = h[..., :D_FF], h[..., D_FF:]
    ap = jnp.pad(a, ((0, 0), (CONV_WIDTH - 1, 0), (0, 0)))
    conv = conv_b + ap[:, 0:S] * conv_w[0]
    for j in range(1, CONV_WIDTH):
        conv = conv + ap[:, j:j + S] * conv_w[j]
    return (jax.nn.silu(conv) * b) @ w_down


def hybrid_layer(x, cos, sin, norm1_g, w_in, w_gate_up, b_gate, gla_norm_g, w_pool, pool_scale,
                 w_out, norm2_g, w_up, conv_w, conv_b, w_down):
    nbat, S, _ = x.shape
    h = rms_norm(x, norm1_g)
    proj = h @ w_in
    (qa, ka, va, qi, ki, wi, qb, kb, vb, rb, gl, uc) = split_cols(proj)

    qa = partial_rope(qa.reshape(nbat, S, A_HEADS, HEAD_DIM), cos, sin)
    ka = partial_rope(ka.reshape(nbat, S, A_HEADS, HEAD_DIM), cos, sin)
    va = va.reshape(nbat, S, A_HEADS, HEAD_DIM)
    qi = partial_rope(qi.reshape(nbat, S, IDX_HEADS, IDX_DIM), cos, sin)
    ki = partial_rope(ki[:, :, None, :], cos, sin)[:, :, 0, :]
    o_a = dsa_attention(qa, ka, va, qi, ki, wi).reshape(nbat, S, A_WIDTH)

    z = (gl @ w_gate_up + b_gate).astype(jnp.float32)
    log_a = (jax.nn.log_sigmoid(z) / GATE_TAU).reshape(nbat, S, B_HEADS, B_DK)
    o_b = gla_chunked(qb.reshape(nbat, S, B_HEADS, B_DK), kb.reshape(nbat, S, B_HEADS, B_DK),
                      vb.reshape(nbat, S, B_HEADS, B_DV), log_a)
    o_b = rms_norm(o_b, gla_norm_g).reshape(nbat, S, B_VWIDTH)
    o_b = (o_b * jax.nn.silu(rb.astype(jnp.float32))).astype(x.dtype)

    o_c = multiscale_pool(uc, w_pool, pool_scale)

    mix = jnp.concatenate([o_a.astype(x.dtype), o_b, o_c], axis=-1) @ w_out
    x = x + mix
    x = x + conv_glu_ffn(rms_norm(x, norm2_g), w_up, conv_w, conv_b, w_down)
    return x


def setup_inputs(seed: int = 0) -> dict:
    key = jax.random.key(seed)
    ks = jax.random.split(key, 16)
    f32 = jnp.float32
    nrm = lambda k, shape, s: jax.random.normal(k, shape, f32) * s
    return {
        "x": jax.random.normal(ks[0], (BATCH, SEQ, D_MODEL), f32),
        "positions": jnp.broadcast_to(jnp.arange(SEQ, dtype=jnp.int32)[None, :], (BATCH, SEQ)),
        "norm1_g": 1.0 + nrm(ks[1], (DEPTH, D_MODEL), 0.02),
        "w_in": nrm(ks[2], (DEPTH, D_MODEL, IN_WIDTH), D_MODEL ** -0.5),
        "w_gate_up": nrm(ks[3], (DEPTH, GATE_RANK, B_KWIDTH), GATE_RANK ** -0.5),
        "b_gate": nrm(ks[4], (DEPTH, B_KWIDTH), 0.01),
        "gla_norm_g": 1.0 + nrm(ks[5], (DEPTH, B_HEADS, B_DV), 0.02),
        "w_pool": nrm(ks[6], (DEPTH, C_GROUPS, C_GROUP_DIM, C_GROUP_DIM), C_GROUP_DIM ** -0.5),
        "pool_scale": 1.0 + nrm(ks[7], (DEPTH, C_WIDTH), 0.1),
        "w_out": nrm(ks[8], (DEPTH, MIX_WIDTH, D_MODEL), MIX_WIDTH ** -0.5),
        "norm2_g": 1.0 + nrm(ks[9], (DEPTH, D_MODEL), 0.02),
        "w_up": nrm(ks[10], (DEPTH, D_MODEL, 2 * D_FF), D_MODEL ** -0.5),
        "conv_w": nrm(ks[11], (DEPTH, CONV_WIDTH, D_FF), CONV_WIDTH ** -0.5),
        "conv_b": nrm(ks[12], (DEPTH, D_FF), 0.01),
        "w_down": nrm(ks[13], (DEPTH, D_FF, D_MODEL), D_FF ** -0.5),
        "final_norm_g": 1.0 + nrm(ks[14], (D_MODEL,), 0.02),
    }


def reference(x, positions, norm1_g, w_in, w_gate_up, b_gate, gla_norm_g, w_pool, pool_scale,
              w_out, norm2_g, w_up, conv_w, conv_b, w_down, final_norm_g):
    cos, sin = rope_tables(positions)
    for l in range(DEPTH):
        x = hybrid_layer(x, cos, sin, norm1_g[l], w_in[l], w_gate_up[l], b_gate[l], gla_norm_g[l],
                         w_pool[l], pool_scale[l], w_out[l], norm2_g[l], w_up[l], conv_w[l],
                         conv_b[l], w_down[l])
    return rms_norm(x, final_norm_g)
```

```cpp
#include <hip/hip_runtime.h>
#include <cstdint>
#include <cstdio>
#include <cstring>

typedef unsigned short u16;
typedef short bf16x8 __attribute__((ext_vector_type(8)));
typedef float f32x4 __attribute__((ext_vector_type(4)));

constexpr int D_MODEL = 1024, BATCH = 2, SEQ = 8192, DEPTH = 2, M_TOK = BATCH * SEQ;
constexpr int IN_WIDTH = 2900, PP = 2912;
constexpr int C_Q = 0, C_K = 512, C_V = 1024, C_QI = 1536, C_KI = 1792, C_WI = 1856, C_QB = 1860, C_KB = 1988, C_VB = 2116, C_RB = 2372, C_GL = 2628, C_UC = 2644;
constexpr int D_FF = 2816;
constexpr float EPS = 1e-6f;
constexpr int TOPK = 256;

constexpr size_t MiB = 1u << 20;
constexpr size_t WS_CS = 0;
constexpr size_t WS_WI = 1 * MiB;
constexpr size_t WS_HN = 2 * MiB;
constexpr size_t WS_PROJ = 34 * MiB;
constexpr size_t WS_MASK = 125 * MiB;
constexpr size_t WS_MIX = 141 * MiB;
constexpr size_t WS_GDS = 173 * MiB;
constexpr size_t WS_GS0 = 181 * MiB;
constexpr size_t WS_GDD = 189 * MiB;
constexpr size_t WS_AB = 34 * MiB;

__device__ __forceinline__ unsigned f2bf(float f) { unsigned u = __float_as_uint(f); return (u + 0x7fffu + ((u >> 16) & 1u)) >> 16; }
__device__ __forceinline__ float bf2f(unsigned h) { return __uint_as_float(h << 16); }
__device__ __forceinline__ unsigned pk2(float lo, float hi) { return f2bf(lo) | (f2bf(hi) << 16); }
__device__ __forceinline__ unsigned f2h(float f) { _Float16 h = (_Float16)f; return (unsigned)__builtin_bit_cast(unsigned short, h); }
__device__ __forceinline__ float h2f(unsigned h) { return (float)__builtin_bit_cast(_Float16, (unsigned short)h); }
__device__ __forceinline__ float wave_sum(float v) {
#pragma unroll
    for (int o = 1; o < 64; o <<= 1) v += __shfl_xor(v, o);
    return v;
}
__device__ __forceinline__ float silu_f(float x) { return x / (1.f + __expf(-x)); }

__global__ void __launch_bounds__(256) k_rope_table(const int* __restrict__ pos, float* __restrict__ cs, float* __restrict__ sn) {
    const int i = blockIdx.x * 256 + threadIdx.x;
    if (i >= M_TOK * 8) return;
    const int t = i >> 3, j = i & 7;
    const float inv = powf(500000.0f, -(float)(2 * j) / 16.0f);
    const float ang = (float)pos[t] * inv;
    float s, c; sincosf(ang, &s, &c);
    cs[i] = c; sn[i] = s;
}

template <bool FINAL>
__global__ void __launch_bounds__(256) k_rmsnorm(const float* x, const float* __restrict__ g, u16* obf, float* of32) {
    const int row = blockIdx.x * 4 + (threadIdx.x >> 6), lane = threadIdx.x & 63;
    const f32x4* xr = (const f32x4*)(x + (size_t)row * D_MODEL) + lane;
    f32x4 v[4]; float ss = 0.f;
#pragma unroll
    for (int j = 0; j < 4; ++j) { v[j] = xr[64 * j]; ss += v[j][0] * v[j][0] + v[j][1] * v[j][1] + v[j][2] * v[j][2] + v[j][3] * v[j][3]; }
    ss = wave_sum(ss);
    const float rs = rsqrtf(ss * (1.f / D_MODEL) + EPS);
#pragma unroll
    for (int j = 0; j < 4; ++j) {
        const f32x4 gg = *((const f32x4*)g + lane + 64 * j);
        f32x4 o = v[j] * rs * gg;
        if (FINAL) { *((f32x4*)(of32 + (size_t)row * D_MODEL) + lane + 64 * j) = o; }
        else { uint2 w; w.x = pk2(o[0], o[1]); w.y = pk2(o[2], o[3]); *((uint2*)(obf + (size_t)row * D_MODEL) + lane + 64 * j) = w; }
    }
}

struct ALoadBf16 {
    const u16* A; int lda; int pad;
    __device__ __forceinline__ void operator()(int row, int k, uint4& v0, uint4& v1) const { const uint4* p = (const uint4*)(A + (size_t)row * lda + k); v0 = p[0]; v1 = p[1]; }
};
struct ALoadConvGlu {
    const u16* AB; const float* cw; const float* cb;
    __device__ __forceinline__ void operator()(int row, int k, uint4& v0, uint4& v1) const {
        const int pos = row & (SEQ - 1);
        const u16* pa = AB + (size_t)row * (2 * D_FF) + k;
        unsigned r[8];
#pragma unroll
        for (int half = 0; half < 2; ++half) {
            const uint4 a0 = *(const uint4*)(pa + half * 8);
            uint4 a1 = make_uint4(0, 0, 0, 0), a2 = make_uint4(0, 0, 0, 0);
            if (pos >= 1) a1 = *(const uint4*)(pa - 2 * D_FF + half * 8);
            if (pos >= 2) a2 = *(const uint4*)(pa - 4 * D_FF + half * 8);
            const uint4 bb = *(const uint4*)(pa + D_FF + half * 8);
            const unsigned A0[4] = {a0.x, a0.y, a0.z, a0.w}, A1[4] = {a1.x, a1.y, a1.z, a1.w}, A2[4] = {a2.x, a2.y, a2.z, a2.w}, BB[4] = {bb.x, bb.y, bb.z, bb.w};
#pragma unroll
            for (int q = 0; q < 4; ++q) {
                float o[2];
#pragma unroll
                for (int e = 0; e < 2; ++e) {
                    const int kk = k + half * 8 + q * 2 + e;
                    const float x0 = bf2f(e ? (A0[q] >> 16) : (A0[q] & 0xffffu)), x1 = bf2f(e ? (A1[q] >> 16) : (A1[q] & 0xffffu)), x2 = bf2f(e ? (A2[q] >> 16) : (A2[q] & 0xffffu));
                    const float bv = bf2f(e ? (BB[q] >> 16) : (BB[q] & 0xffffu));
                    const float cv = cb[kk] + x2 * cw[kk] + x1 * cw[D_FF + kk] + x0 * cw[2 * D_FF + kk];
                    o[e] = silu_f(cv) * bv;
                }
                r[half * 4 + q] = pk2(o[0], o[1]);
            }
        }
        v0 = make_uint4(r[0], r[1], r[2], r[3]); v1 = make_uint4(r[4], r[5], r[6], r[7]);
    }
};
struct BLoadF32 {
    const float* W; int N; int pad;
    __device__ __forceinline__ void operator()(int k, int n, uint4& v0, uint4& v1) const {
        float f[16];
#pragma unroll
        for (int j = 0; j < 16; ++j) f[j] = (n < N) ? W[(size_t)(k + j) * N + n] : 0.f;
        v0 = make_uint4(pk2(f[0], f[1]), pk2(f[2], f[3]), pk2(f[4], f[5]), pk2(f[6], f[7]));
        v1 = make_uint4(pk2(f[8], f[9]), pk2(f[10], f[11]), pk2(f[12], f[13]), pk2(f[14], f[15]));
    }
};

template <class AL, class BL, class EP>
__device__ __forceinline__ void gemm128_tile(int m0, int n0, int K, const AL& al, const BL& bl, const EP& ep, u16* As, u16* Bs) {
    const int tid = threadIdx.x, lane = tid & 63, w = tid >> 6, wr = w >> 1, wc = w & 1;
    f32x4 acc[4][4];
#pragma unroll
    for (int i = 0; i < 4; ++i)
#pragma unroll
        for (int j = 0; j < 4; ++j) acc[i][j] = (f32x4){0.f, 0.f, 0.f, 0.f};
    for (int k0 = 0; k0 < K; k0 += 32) {
        uint4 a0, a1, b0, b1;
        al(m0 + (tid >> 1), k0 + (tid & 1) * 16, a0, a1);
        bl(k0 + (tid >> 7) * 16, n0 + (tid & 127), b0, b1);
        __syncthreads();
        *(uint4*)&As[(tid >> 1) * 40 + (tid & 1) * 16] = a0; *(uint4*)&As[(tid >> 1) * 40 + (tid & 1) * 16 + 8] = a1;
        *(uint4*)&Bs[(tid & 127) * 40 + (tid >> 7) * 16] = b0; *(uint4*)&Bs[(tid & 127) * 40 + (tid >> 7) * 16 + 8] = b1;
        __syncthreads();
        bf16x8 af[4], bfr[4];
#pragma unroll
        for (int i = 0; i < 4; ++i) af[i] = *(const bf16x8*)&As[(wr * 64 + i * 16 + (lane & 15)) * 40 + 8 * (lane >> 4)];
#pragma unroll
        for (int j = 0; j < 4; ++j) bfr[j] = *(const bf16x8*)&Bs[(wc * 64 + j * 16 + (lane & 15)) * 40 + 8 * (lane >> 4)];
#pragma unroll
        for (int i = 0; i < 4; ++i)
#pragma unroll
            for (int j = 0; j < 4; ++j) acc[i][j] = __builtin_amdgcn_mfma_f32_16x16x32_bf16(af[i], bfr[j], acc[i][j], 0, 0, 0);
    }
    ep(acc, m0 + wr * 64, n0 + wc * 64, lane);
}

struct EpiProj {
    u16* P; float* WI; const float* cs; const float* sn;
    __device__ __forceinline__ void operator()(const f32x4 (&acc)[4][4], int mb, int nb, int lane) const {
#pragma unroll
        for (int j = 0; j < 4; ++j) {
            const int cb = nb + j * 16, col = cb + (lane & 15);
            const bool rope = ((cb < C_V) || (cb >= C_QI && cb < C_WI)) && ((cb & 63) == 0);
            const bool half16 = (cb >= C_QI && cb < C_WI);
#pragma unroll
            for (int i = 0; i < 4; ++i)
#pragma unroll
                for (int r = 0; r < 4; ++r) {
                    const int row = mb + i * 16 + (lane >> 4) * 4 + r;
                    float v = acc[i][j][r];
                    const float partner = __shfl_xor(v, 8);
                    if (rope) {
                        const int d = lane & 15; const float c = cs[row * 8 + (d & 7)], s = sn[row * 8 + (d & 7)];
                        v = (d < 8) ? (v * c - partner * s) : (v * c + partner * s);
                    }
                    if (col < IN_WIDTH) {
                        if (col >= C_WI && col < C_QB) WI[row * 4 + (col - C_WI)] = v;
                        else P[(size_t)row * PP + col] = (u16)(half16 ? f2h(v) : f2bf(v));
                    }
                }
        }
    }
};
struct EpiResidual {
    const float* xr; float* xw;
    __device__ __forceinline__ void operator()(const f32x4 (&acc)[4][4], int mb, int nb, int lane) const {
#pragma unroll
        for (int i = 0; i < 4; ++i)
#pragma unroll
            for (int j = 0; j < 4; ++j)
#pragma unroll
                for (int r = 0; r < 4; ++r) { const size_t o = (size_t)(mb + i * 16 + (lane >> 4) * 4 + r) * D_MODEL + nb + j * 16 + (lane & 15); xw[o] = xr[o] + acc[i][j][r]; }
    }
};
struct EpiStoreBf16 {
    u16* O; int ldo; int pad;
    __device__ __forceinline__ void operator()(const f32x4 (&acc)[4][4], int mb, int nb, int lane) const {
#pragma unroll
        for (int i = 0; i < 4; ++i)
#pragma unroll
            for (int j = 0; j < 4; ++j)
#pragma unroll
                for (int r = 0; r < 4; ++r) O[(size_t)(mb + i * 16 + (lane >> 4) * 4 + r) * ldo + nb + j * 16 + (lane & 15)] = (u16)f2bf(acc[i][j][r]);
    }
};

template <class AL, class BL, class EP> struct GemmArgs { AL al; BL bl; EP ep; long long K; };
template <class AL, class BL, class EP>
__global__ void __launch_bounds__(256) k_gemm(GemmArgs<AL, BL, EP> a) {
    __shared__ __attribute__((aligned(16))) u16 As[128 * 40];
    __shared__ __attribute__((aligned(16))) u16 Bs[128 * 40];
    gemm128_tile(blockIdx.y * 128, blockIdx.x * 128, (int)a.K, a.al, a.bl, a.ep, As, Bs);
}
template <class AL, class BL, class EP>
static void launch_gemm(dim3 grid, hipStream_t stream, int K, AL al, BL bl, EP ep) {
    GemmArgs<AL, BL, EP> a; memset(&a, 0, sizeof(a)); a.al = al; a.bl = bl; a.ep = ep; a.K = K;
    k_gemm<AL, BL, EP><<<grid, 256, 0, stream>>>(a);
}

__device__ __forceinline__ unsigned f2ord(float x) { const unsigned u = __float_as_uint(x + 0.0f); return (u & 0x80000000u) ? ~u : (u | 0x80000000u); }

__global__ void __launch_bounds__(256) k_index_topk(const u16* __restrict__ P, const float* __restrict__ WI, unsigned* __restrict__ MASK) {
    __shared__ float qs[256];
    __shared__ unsigned sc[256 * 33];
    __shared__ int red[2][4];
    __shared__ int wtot[4];
    const int q = blockIdx.x, b = q >> 13, t = q & (SEQ - 1), n = t + 1, tid = threadIdx.x, lane = tid & 63, w = tid >> 6;
    unsigned* mrow = MASK + (size_t)q * 256;
    if (n <= TOPK) {
        const int lo = tid * 32; unsigned word = 0u;
        if (lo <= t) { const int cnt = t - lo + 1; word = cnt >= 32 ? 0xffffffffu : ((1u << cnt) - 1u); }
        mrow[tid] = word; return;
    }
    qs[tid] = h2f(P[(size_t)q * PP + C_QI + tid]);
    const float w0 = WI[q * 4 + 0], w1 = WI[q * 4 + 1], w2 = WI[q * 4 + 2], w3 = WI[q * 4 + 3];
    __syncthreads();
    for (int j = 0; j < 32; ++j) {
        const int s = tid * 32 + j; unsigned key = 0u;
        if (s < n) {
            const uint4* kp = (const uint4*)(P + (size_t)(b * SEQ + s) * PP + C_KI);
            float d0 = 0.f, d1 = 0.f, d2 = 0.f, d3 = 0.f;
#pragma unroll
            for (int c = 0; c < 8; ++c) {
                const uint4 kv = kp[c]; const unsigned kw[4] = {kv.x, kv.y, kv.z, kv.w};
#pragma unroll
                for (int e = 0; e < 4; ++e) {
                    const float k0 = h2f(kw[e] & 0xffffu), k1 = h2f(kw[e] >> 16); const int d = c * 8 + e * 2;
                    d0 += qs[d] * k0 + qs[d + 1] * k1; d1 += qs[64 + d] * k0 + qs[64 + d + 1] * k1;
                    d2 += qs[128 + d] * k0 + qs[128 + d + 1] * k1; d3 += qs[192 + d] * k0 + qs[192 + d + 1] * k1;
                }
            }
            const float score = w0 * fmaxf(d0, 0.f) + w1 * fmaxf(d1, 0.f) + w2 * fmaxf(d2, 0.f) + w3 * fmaxf(d3, 0.f);
            key = f2ord(score);
        }
        sc[tid * 33 + j] = key;
    }
    __syncthreads();
    unsigned u[32];
#pragma unroll
    for (int j = 0; j < 32; ++j) u[j] = sc[tid * 33 + j];
    unsigned T = 0u;
    for (int bit = 31; bit >= 0; --bit) {
        const unsigned cand = T | (1u << bit); int c = 0;
#pragma unroll
        for (int j = 0; j < 32; ++j) c += (u[j] >= cand) ? 1 : 0;
        c = (int)wave_sum((float)c);
        if (lane == 0) red[bit & 1][w] = c;
        __syncthreads();
        const int tot = red[bit & 1][0] + red[bit & 1][1] + red[bit & 1][2] + red[bit & 1][3];
        if (tot >= TOPK) T = cand;
    }
    int cgt = 0, ceq = 0;
#pragma unroll
    for (int j = 0; j < 32; ++j) { cgt += (u[j] > T) ? 1 : 0; ceq += (u[j] == T) ? 1 : 0; }
    float fg = wave_sum((float)cgt);
    int incl = ceq;
#pragma unroll
    for (int o = 1; o < 64; o <<= 1) { const int v = __shfl_up(incl, o); if (lane >= o) incl += v; }
    __syncthreads();
    if (lane == 63) wtot[w] = incl;
    if (lane == 0) red[0][w] = (int)fg;
    __syncthreads();
    const int cgt_tot = red[0][0] + red[0][1] + red[0][2] + red[0][3];
    int excl = incl - ceq;
    for (int ww = 0; ww < w; ++ww) excl += wtot[ww];
    const int need = TOPK - cgt_tot;
    unsigned word = 0u; int rk = excl;
#pragma unroll
    for (int j = 0; j < 32; ++j) {
        bool sel = u[j] > T;
        if (u[j] == T) { sel = rk < need; ++rk; }
        word |= sel ? (1u << j) : 0u;
    }
    mrow[tid] = word;
}

__global__ void __launch_bounds__(256) k_sparse_attn(const u16* __restrict__ P, const unsigned* __restrict__ MASK, u16* __restrict__ MIX) {
    __shared__ int idx[256];
    __shared__ float qf[512];
    __shared__ float lg[8][256];
    __shared__ int wtot[4];
    const int q = blockIdx.x, b = q >> 13, tid = threadIdx.x, lane = tid & 63, w = tid >> 6;
    const unsigned word = MASK[(size_t)q * 256 + tid];
    const int pc = __popc(word);
    int incl = pc;
#pragma unroll
    for (int o = 1; o < 64; o <<= 1) { const int v = __shfl_up(incl, o); if (lane >= o) incl += v; }
    if (lane == 63) wtot[w] = incl;
    qf[tid] = bf2f(P[(size_t)q * PP + C_Q + tid]); qf[256 + tid] = bf2f(P[(size_t)q * PP + C_Q + 256 + tid]);
    __syncthreads();
    int off = incl - pc;
    for (int ww = 0; ww < w; ++ww) off += wtot[ww];
    const int cnt = wtot[0] + wtot[1] + wtot[2] + wtot[3];
    { unsigned m = word; while (m) { const int j = __ffs(m) - 1; m &= m - 1; if (off < 256) idx[off] = tid * 32 + j; ++off; } }
    __syncthreads();
    const int h = tid >> 5, l32 = tid & 31;
    float mx = -INFINITY;
    for (int j = l32; j < cnt; j += 32) {
        const uint4* kp = (const uint4*)(P + (size_t)(b * SEQ + idx[j]) * PP + C_K + h * 64);
        float d = 0.f;
#pragma unroll
        for (int c = 0; c < 8; ++c) {
            const uint4 kv = kp[c]; const unsigned kw[4] = {kv.x, kv.y, kv.z, kv.w};
#pragma unroll
            for (int e = 0; e < 4; ++e) d += qf[h * 64 + c * 8 + e * 2] * bf2f(kw[e] & 0xffffu) + qf[h * 64 + c * 8 + e * 2 + 1] * bf2f(kw[e] >> 16);
        }
        d *= 0.125f; lg[h][j] = d; mx = fmaxf(mx, d);
    }
#pragma unroll
    for (int o = 16; o >= 1; o >>= 1) mx = fmaxf(mx, __shfl_xor(mx, o));
    float sum = 0.f;
    for (int j = l32; j < cnt; j += 32) { const float p = __expf(lg[h][j] - mx); lg[h][j] = p; sum += p; }
#pragma unroll
    for (int o = 16; o >= 1; o >>= 1) sum += __shfl_xor(sum, o);
    __syncthreads();
    float a0 = 0.f, a1 = 0.f;
    for (int j = 0; j < cnt; ++j) {
        const unsigned vv = *(const unsigned*)(P + (size_t)(b * SEQ + idx[j]) * PP + C_V + h * 64 + 2 * l32);
        const float p = lg[h][j]; a0 += p * bf2f(vv & 0xffffu); a1 += p * bf2f(vv >> 16);
    }
    const float inv = 1.f / sum;
    *(unsigned*)(MIX + (size_t)q * D_MODEL + h * 64 + 2 * l32) = pk2(a0 * inv, a1 * inv);
}

__device__ __forceinline__ void gla_cumlog(const u16* __restrict__ P, const float* __restrict__ wg, const float* __restrict__ bg, int tok0, int h, float (*bl)[33]) {
    const int tid = threadIdx.x, i = tid >> 2, dq = tid & 3;
    float gl[16];
#pragma unroll
    for (int r = 0; r < 16; ++r) gl[r] = bf2f(P[(size_t)(tok0 + i) * PP + C_GL + r]);
#pragma unroll
    for (int dd = 0; dd < 8; ++dd) {
        const int d = dq * 8 + dd; float z = bg[h * 32 + d];
#pragma unroll
        for (int r = 0; r < 16; ++r) z += gl[r] * wg[r * 128 + h * 32 + d];
        const float ls = fminf(z, 0.f) - log1pf(__expf(-fabsf(z)));
        bl[i][d] = ls * (1.f / 16.f);
    }
    __syncthreads();
    if (tid < 32) { float a = 0.f; for (int ii = 0; ii < 64; ++ii) { a += bl[ii][tid]; bl[ii][tid] = a; } }
    __syncthreads();
}

__global__ void __launch_bounds__(256) k_gla1(const u16* __restrict__ P, const float* __restrict__ wg, const float* __restrict__ bg, float* __restrict__ DS, float* __restrict__ DD) {
    __shared__ float bl[64][33];
    __shared__ float kh[64][33];
    __shared__ float vv[64][64];
    const int blk = blockIdx.x, b = blk >> 9, h = (blk >> 7) & 3, c = blk & 127, tid = threadIdx.x, tok0 = b * SEQ + c * 64;
    gla_cumlog(P, wg, bg, tok0, h, bl);
    { const int j = tid >> 2, dq = tid & 3;
#pragma unroll
      for (int dd = 0; dd < 8; ++dd) { const int d = dq * 8 + dd; kh[j][d] = bf2f(P[(size_t)(tok0 + j) * PP + C_KB + h * 32 + d]) * __expf(bl[63][d] - bl[j][d]); }
#pragma unroll
      for (int ee = 0; ee < 16; ++ee) { const int e = dq * 16 + ee; vv[j][e] = bf2f(P[(size_t)(tok0 + j) * PP + C_VB + h * 64 + e]); } }
    __syncthreads();
    const int e = tid & 63, dg = tid >> 6;
#pragma unroll
    for (int dd = 0; dd < 8; ++dd) { const int d = dg * 8 + dd; float s = 0.f; for (int j = 0; j < 64; ++j) s += kh[j][d] * vv[j][e]; DS[(size_t)blk * 2048 + d * 64 + e] = s; }
    if (tid < 32) DD[blk * 32 + tid] = __expf(bl[63][tid]);
}
__global__ void __launch_bounds__(256) k_gla2(const float* __restrict__ DS, const float* __restrict__ DD, float* __restrict__ S0) {
    const int idx = blockIdx.x * 256 + threadIdx.x, bh = idx >> 11, de = idx & 2047;
    float S = 0.f;
    for (int c = 0; c < 128; ++c) { const int blk = bh * 128 + c; S0[(size_t)blk * 2048 + de] = S; S = DD[blk * 32 + (de >> 6)] * S + DS[(size_t)blk * 2048 + de]; }
}
__global__ void __launch_bounds__(256) k_gla3(const u16* __restrict__ P, const float* __restrict__ wg, const float* __restrict__ bg, const float* __restrict__ S0, const float* __restrict__ gn, u16* __restrict__ MIX) {
    __shared__ float bl[64][33];
    __shared__ float qt[64][33];
    __shared__ float kt[64][33];
    __shared__ u16 vv[64][64];
    __shared__ float Ss[32][64];
    __shared__ float at[64][65];
    const int blk = blockIdx.x, b = blk >> 9, h = (blk >> 7) & 3, c = blk & 127, tid = threadIdx.x, tok0 = b * SEQ + c * 64;
    gla_cumlog(P, wg, bg, tok0, h, bl);
    const int i = tid >> 2, qd = tid & 3;
#pragma unroll
    for (int dd = 0; dd < 8; ++dd) { const int d = qd * 8 + dd; const float bb = bl[i][d];
        qt[i][d] = bf2f(P[(size_t)(tok0 + i) * PP + C_QB + h * 32 + d]) * 0.17677669529663687f * __expf(bb);
        kt[i][d] = bf2f(P[(size_t)(tok0 + i) * PP + C_KB + h * 32 + d]) * __expf(-bb); }
#pragma unroll
    for (int ee = 0; ee < 16; ++ee) { const int e = qd * 16 + ee; vv[i][e] = P[(size_t)(tok0 + i) * PP + C_VB + h * 64 + e]; }
    for (int x = tid; x < 2048; x += 256) Ss[x >> 6][x & 63] = S0[(size_t)blk * 2048 + x];
    __syncthreads();
#pragma unroll
    for (int jj = 0; jj < 16; ++jj) { const int j = qd * 16 + jj; float s = 0.f;
        if (j <= i) { for (int d = 0; d < 32; ++d) s += qt[i][d] * kt[j][d]; }
        at[i][j] = s; }
    __syncthreads();
    float o[16]; float ss = 0.f;
#pragma unroll
    for (int ee = 0; ee < 16; ++ee) { const int e = qd * 16 + ee; float s = 0.f;
        for (int d = 0; d < 32; ++d) s += qt[i][d] * Ss[d][e];
        for (int j = 0; j <= i; ++j) s += at[i][j] * bf2f(vv[j][e]);
        o[ee] = s; ss += s * s; }
    ss += __shfl_xor(ss, 1); ss += __shfl_xor(ss, 2);
    const float rs = rsqrtf(ss * (1.f / 64.f) + EPS);
#pragma unroll
    for (int ee = 0; ee < 16; ++ee) { const int e = qd * 16 + ee;
        const float r = bf2f(P[(size_t)(tok0 + i) * PP + C_RB + h * 64 + e]);
        MIX[(size_t)(tok0 + i) * D_MODEL + 512 + h * 64 + e] = (u16)f2bf(o[ee] * rs * gn[h * 64 + e] * silu_f(r)); }
}

__global__ void __launch_bounds__(256) k_pool(const u16* __restrict__ P, const float* __restrict__ wp, const float* __restrict__ psc, u16* __restrict__ MIX) {
    __shared__ float pl[16][256];
    const int tok0 = blockIdx.x * 16, tid = threadIdx.x, g = tid >> 6;
    const int win = 2 << g;
    for (int tt = 0; tt < 16; ++tt) {
        const int tok = tok0 + tt, pos = tok & (SEQ - 1); const int cnt = (pos + 1 < win) ? pos + 1 : win;
        float s = 0.f;
        for (int j = 0; j < cnt; ++j) s += bf2f(P[(size_t)(tok - j) * PP + C_UC + tid]);
        pl[tt][tid] = s / (float)cnt - bf2f(P[(size_t)tok * PP + C_UC + tid]);
    }
    __syncthreads();
    const int e = tid & 63;
    float acc[16];
#pragma unroll
    for (int tt = 0; tt < 16; ++tt) acc[tt] = 0.f;
    for (int d = 0; d < 64; ++d) { const float wv = wp[(g * 64 + d) * 64 + e];
#pragma unroll
        for (int tt = 0; tt < 16; ++tt) acc[tt] += pl[tt][g * 64 + d] * wv; }
    const float sc = psc[tid];
#pragma unroll
    for (int tt = 0; tt < 16; ++tt) MIX[(size_t)(tok0 + tt) * D_MODEL + 768 + tid] = (u16)f2bf(acc[tt] * sc);
}

extern "C" void kernel_launch(void* const* d_in, const int* in_sizes, int n_in, void* d_out, int out_size, void* d_ws, size_t ws_size, hipStream_t stream) {
    const float* x = (const float*)d_in[0]; const int* pos = (const int*)d_in[1];
    const float* norm1_g = (const float*)d_in[2]; const float* w_in = (const float*)d_in[3]; const float* w_gate_up = (const float*)d_in[4]; const float* b_gate = (const float*)d_in[5];
    const float* gla_norm_g = (const float*)d_in[6]; const float* w_pool = (const float*)d_in[7]; const float* pool_scale = (const float*)d_in[8]; const float* w_out = (const float*)d_in[9];
    const float* norm2_g = (const float*)d_in[10]; const float* w_up = (const float*)d_in[11]; const float* conv_w = (const float*)d_in[12]; const float* conv_b = (const float*)d_in[13];
    const float* w_down = (const float*)d_in[14]; const float* final_g = (const float*)d_in[15];
    float* out = (float*)d_out; unsigned char* ws = (unsigned char*)d_ws;
    float* cs = (float*)(ws + WS_CS); float* sn = cs + M_TOK * 8; float* WI = (float*)(ws + WS_WI);
    u16* HN = (u16*)(ws + WS_HN); u16* P = (u16*)(ws + WS_PROJ); unsigned* MASK = (unsigned*)(ws + WS_MASK); u16* MIX = (u16*)(ws + WS_MIX);
    float* GDS = (float*)(ws + WS_GDS); float* GS0 = (float*)(ws + WS_GS0); float* GDD = (float*)(ws + WS_GDD); u16* AB = (u16*)(ws + WS_AB);

    k_rope_table<<<M_TOK * 8 / 256, 256, 0, stream>>>(pos, cs, sn);
    for (int l = 0; l < DEPTH; ++l) {
        const float* xin = (l == 0) ? x : out;
        k_rmsnorm<false><<<M_TOK / 4, 256, 0, stream>>>(xin, norm1_g + l * D_MODEL, HN, nullptr);
        launch_gemm(dim3((IN_WIDTH + 127) / 128, M_TOK / 128), stream, D_MODEL, ALoadBf16{HN, D_MODEL, 0}, BLoadF32{w_in + (size_t)l * D_MODEL * IN_WIDTH, IN_WIDTH, 0}, EpiProj{P, WI, cs, sn});
        k_index_topk<<<M_TOK, 256, 0, stream>>>(P, WI, MASK);
        k_sparse_attn<<<M_TOK, 256, 0, stream>>>(P, MASK, MIX);
        k_gla1<<<1024, 256, 0, stream>>>(P, w_gate_up + l * 16 * 128, b_gate + l * 128, GDS, GDD);
        k_gla2<<<64, 256, 0, stream>>>(GDS, GDD, GS0);
        k_gla3<<<1024, 256, 0, stream>>>(P, w_gate_up + l * 16 * 128, b_gate + l * 128, GS0, gla_norm_g + l * 256, MIX);
        k_pool<<<M_TOK / 16, 256, 0, stream>>>(P, w_pool + (size_t)l * 4 * 64 * 64, pool_scale + l * 256, MIX);
        launch_gemm(dim3(D_MODEL / 128, M_TOK / 128), stream, D_MODEL, ALoadBf16{MIX, D_MODEL, 0}, BLoadF32{w_out + (size_t)l * D_MODEL * D_MODEL, D_MODEL, 0}, EpiResidual{xin, out});
        k_rmsnorm<false><<<M_TOK / 4, 256, 0, stream>>>(out, norm2_g + l * D_MODEL, HN, nullptr);
        launch_gemm(dim3(2 * D_FF / 128, M_TOK / 128), stream, D_MODEL, ALoadBf16{HN, D_MODEL, 0}, BLoadF32{w_up + (size_t)l * D_MODEL * 2 * D_FF, 2 * D_FF, 0}, EpiStoreBf16{AB, 2 * D_FF, 0});
        launch_gemm(dim3(D_MODEL / 128, M_TOK / 128), stream, D_FF, ALoadConvGlu{AB, conv_w + (size_t)l * 3 * D_FF, conv_b + (size_t)l * D_FF}, BLoadF32{w_down + (size_t)l * D_FF * D_MODEL, D_MODEL, 0}, EpiResidual{out, out});
    }
    k_rmsnorm<true><<<M_TOK / 4, 256, 0, stream>>>(out, final_g, nullptr, out);
}
```

```cpp
#include <hip/hip_runtime.h>
#include <cstdint>
#include <cstdio>
#include <cstring>

typedef unsigned short u16;
typedef _Float16 f16x8 __attribute__((ext_vector_type(8)));

constexpr int D_MODEL = 1024, BATCH = 2, SEQ = 8192, DEPTH = 2, M_TOK = BATCH * SEQ;
constexpr int IN_WIDTH = 2900, NPROJ = 3072;
constexpr int D_FF = 2816;
constexpr float EPS = 1e-6f;
constexpr int TOPK = 256;
constexpr float C2 = 0.125f * 1.4426950408889634f;

constexpr size_t MiB = 1u << 20;
constexpr size_t WS_CTL = 0, CTL_ZERO_BYTES = 64 * 1024;
constexpr size_t WS_CS = 1 * MiB;
constexpr size_t WS_WI = 2 * MiB;
constexpr size_t WS_GL = 3 * MiB;
constexpr size_t WS_RSS = 4 * MiB;
constexpr size_t WS_WIN0 = 5 * MiB, WS_WOUT0 = 11 * MiB, WS_WIN1 = 13 * MiB, WS_WOUT1 = 19 * MiB;
constexpr size_t WS_WUP = 21 * MiB, WS_WDN = 32 * MiB;
constexpr size_t WS_XG = 38 * MiB;
constexpr size_t WS_AB = 70 * MiB;
constexpr size_t WS_Q = 70 * MiB, WS_K = 86 * MiB, WS_V = 102 * MiB;
constexpr size_t WS_QI = 118 * MiB;
constexpr size_t WS_KI = 126 * MiB;
constexpr size_t WS_GQK = 128 * MiB, WS_GV = 136 * MiB, WS_GR = 144 * MiB, WS_UC = 152 * MiB;
constexpr size_t WS_MIX = 160 * MiB;
constexpr size_t WS_LIST = 192 * MiB;
constexpr size_t WS_MASK = 38 * MiB;
constexpr size_t WS_GST = 54 * MiB;
constexpr size_t WS_END = 256 * MiB;

__device__ __forceinline__ unsigned f2bf(float f) { unsigned u = __float_as_uint(f); return (u + 0x7fffu + ((u >> 16) & 1u)) >> 16; }
__device__ __forceinline__ float bf2f(unsigned h) { return __uint_as_float(h << 16); }
__device__ __forceinline__ unsigned f2h(float f) { _Float16 h = (_Float16)f; return (unsigned)__builtin_bit_cast(unsigned short, h); }
__device__ __forceinline__ float h2f(unsigned h) { return (float)__builtin_bit_cast(_Float16, (unsigned short)h); }
typedef float f32x2_t __attribute__((ext_vector_type(2))); typedef __bf16 bf16x2_t __attribute__((ext_vector_type(2))); typedef _Float16 f16x2_t __attribute__((ext_vector_type(2)));
__device__ __forceinline__ unsigned pkbf(float lo, float hi) { f32x2_t v = {lo, hi}; bf16x2_t b = __builtin_convertvector(v, bf16x2_t); return __builtin_bit_cast(unsigned, b); }
__device__ __forceinline__ unsigned pkh(float lo, float hi) { f32x2_t v = {lo, hi}; f16x2_t b = __builtin_convertvector(v, f16x2_t); return __builtin_bit_cast(unsigned, b); }
__device__ __forceinline__ float wave_sum(float v) {
#pragma unroll
    for (int o = 1; o < 64; o <<= 1) v += __shfl_xor(v, o);
    return v;
}
__device__ __forceinline__ float silu_f(float x) { return x / (1.f + __expf(-x)); }

namespace pg8 {
#define PG8_LAS __attribute__((address_space(3)))
typedef unsigned short bf16_t;
typedef short bf16x8 __attribute__((ext_vector_type(8)));
typedef float f32x4 __attribute__((ext_vector_type(4)));
typedef unsigned u32x4 __attribute__((ext_vector_type(4)));
constexpr int BM = 256, BK = 64, HALF = 128, HTB = HALF * BK * 2  , STAGE_BYTES = 8 * HTB, NXCD = 8, WGM = 8;

__host__ __device__ __forceinline__ int lds_byte(int r, int c) { const int st = (r >> 4) * 2 + (c >> 5), rr = r & 15, cc = c & 31, ob = rr * 64 + cc * 2; return st * 1024 + (ob ^ (((ob >> 9) & 1) << 5)); }
__host__ __device__ __forceinline__ void stage_rc(int b, int& R, int& C) { const int st = b / 1024, sb = b % 1024, swz = sb ^ (((sb >> 9) & 1) << 5); R = (st >> 1) * 16 + swz / 64; C = (st & 1) * 32 + (swz % 64) / 2; }
__host__ __device__ __forceinline__ int perm32(int rho) { const int n = rho >> 4, i = rho & 15; return 8 * (i >> 2) + 4 * n + (i & 3); }

struct Unit { int pm, pn; };
struct Gemm { const bf16_t* A; const bf16_t* Bt; int M, N, K, lda; };

struct StaticOrder {
    int nM, nN, nwg, G, c;
    __host__ __device__ void init(int M, int N, int G_, int c_) { nM = M / BM; nN = N / BM; nwg = nM * nN; G = G_; c = c_; }
    __host__ __device__ bool next(int i, Unit& u) const {
        const long L = (long)i * G + c; if (L >= nwg) return false;
        int wgid = (int)L; { const int q = nwg / NXCD, r = nwg % NXCD, xcd = wgid % NXCD, off = wgid / NXCD; wgid = (xcd < r ? xcd * (q + 1) : r * (q + 1) + (xcd - r) * q) + off; }
        const int nig = WGM * nN, gid = wgid / nig, fm = gid * WGM, gsz = (nM - fm) < WGM ? (nM - fm) : WGM;
        u.pm = fm + ((wgid % nig) % gsz); u.pn = (wgid % nig) / gsz; return true;
    }
    __device__ __forceinline__ void a_ready(const Unit&) const {}
    __device__ __forceinline__ void done(const Unit&) const {}
};

__device__ __forceinline__ float row_rs(const float* rss, int row) {
    const f32x4* rp = (const f32x4*)(rss + (size_t)row * 16);
    const f32x4 s0 = rp[0], s1 = rp[1], s2 = rp[2], s3 = rp[3];
    const float t = (((s0[0] + s0[1]) + (s0[2] + s0[3])) + ((s1[0] + s1[1]) + (s1[2] + s1[3]))) + (((s2[0] + s2[1]) + (s2[2] + s2[3])) + ((s3[0] + s3[1]) + (s3[2] + s3[3])));
    return rsqrtf(t * (1.f / D_MODEL) + EPS);
}
__device__ __forceinline__ u32x4 pack8_bf(const f32x4& a, const f32x4& b) { u32x4 w; w.x = pkbf(a[0], a[1]); w.y = pkbf(a[2], a[3]); w.z = pkbf(b[0], b[1]); w.w = pkbf(b[2], b[3]); return w; }
__device__ __forceinline__ u32x4 pack8_h(const f32x4& a, const f32x4& b) { u32x4 w; w.x = pkh(a[0], a[1]); w.y = pkh(a[2], a[3]); w.z = pkh(b[0], b[1]); w.w = pkh(b[2], b[3]); return w; }

struct EpiProj {
    static constexpr bool PERM = true, AFTER_DRAIN = false;
    const float* rss; const float* cs; const float* sn;
    u16 *Q, *K, *V, *QI, *KI, *GQK, *GV, *GR, *UC; float *WI, *GL;
    __device__ __forceinline__ void operator()(const f32x4 (&acc)[2][2][4][2], const Unit& u, int wr, int wc, int fr, int fq) const {
        const int pn = u.pn;
        const bool ropetile = (pn < 4) || pn == 6 || pn == 7;
#pragma unroll
        for (int ai = 0; ai < 2; ++ai)
#pragma unroll
            for (int m = 0; m < 4; ++m) {
                const int row = u.pm * BM + ai * HALF + wr * 64 + m * 16 + fr;
                const float rs = row_rs(rss, row);
                f32x4 c0 = {0.f, 0.f, 0.f, 0.f}, c1 = c0, s0 = c0, s1 = c0;
                if (ropetile) { c0 = *(const f32x4*)(cs + row * 8); c1 = *(const f32x4*)(cs + row * 8 + 4); s0 = *(const f32x4*)(sn + row * 8); s1 = *(const f32x4*)(sn + row * 8 + 4); }
#pragma unroll
                for (int bj = 0; bj < 2; ++bj) {
                    f32x4 v0 = acc[ai][bj][m][0] * rs, v1 = acc[ai][bj][m][1] * rs;
                    const int cl = bj * HALF + wc * 32 + fq * 8;
                    if (ropetile) {
                        f32x4 p0, p1;
#pragma unroll
                        for (int e = 0; e < 4; ++e) { p0[e] = __shfl_xor(v0[e], 16); p1[e] = __shfl_xor(v1[e], 16); }
                        const bool dorope = ((wc & 1) == 0) && (fq < 2) && (pn != 7 || (bj == 0 && wc == 0));
                        if (dorope) {
                            if (fq == 0) { v0 = v0 * c0 - p0 * s0; v1 = v1 * c1 - p1 * s1; }
                            else         { v0 = v0 * c0 + p0 * s0; v1 = v1 * c1 + p1 * s1; }
                        }
                    }
                    if (pn < 2)       { *(u32x4*)(Q + (size_t)row * 512 + pn * 256 + cl) = pack8_bf(v0 * C2, v1 * C2); }
                    else if (pn < 4)  { *(u32x4*)(K + (size_t)row * 512 + (pn - 2) * 256 + cl) = pack8_bf(v0, v1); }
                    else if (pn < 6)  { *(u32x4*)(V + (size_t)row * 512 + (pn - 4) * 256 + cl) = pack8_bf(v0, v1); }
                    else if (pn == 6) { *(u32x4*)(QI + (size_t)row * 256 + cl) = pack8_h(v0, v1); }
                    else if (pn == 7) {
                        if (cl < 64) *(u32x4*)(KI + (size_t)row * 64 + cl) = pack8_h(v0, v1);
                        else if (cl == 64) *(f32x4*)(WI + (size_t)row * 4) = v0;
                        else if (cl == 72) { *(f32x4*)(GL + (size_t)row * 16) = v0; *(f32x4*)(GL + (size_t)row * 16 + 4) = v1; }
                        else if (cl == 80) { *(f32x4*)(GL + (size_t)row * 16 + 8) = v0; *(f32x4*)(GL + (size_t)row * 16 + 12) = v1; }
                    }
                    else if (pn == 8) { *(u32x4*)(GQK + (size_t)row * 256 + cl) = pack8_bf(v0, v1); }
                    else if (pn == 9) { *(u32x4*)(GV + (size_t)row * 256 + cl) = pack8_bf(v0, v1); }
                    else if (pn == 10) { *(u32x4*)(GR + (size_t)row * 256 + cl) = pack8_bf(v0, v1); }
                    else { *(u32x4*)(UC + (size_t)row * 256 + cl) = pack8_bf(v0, v1); }
                }
            }
    }
};
struct EpiResid {
    static constexpr bool PERM = true, AFTER_DRAIN = false;
    const float* xr; float* xw; u16* XG; const float* gn; float* rss;
    __device__ __forceinline__ void operator()(const f32x4 (&acc)[2][2][4][2], const Unit& u, int wr, int wc, int fr, int fq) const {
#pragma unroll
        for (int ai = 0; ai < 2; ++ai)
#pragma unroll
            for (int m = 0; m < 4; ++m) {
                const int row = u.pm * BM + ai * HALF + wr * 64 + m * 16 + fr; float ss = 0.f;
#pragma unroll
                for (int bj = 0; bj < 2; ++bj) {
                    const int c0 = u.pn * BM + bj * HALF + wc * 32 + fq * 8; const size_t off = (size_t)row * D_MODEL + c0;
                    const f32x4 o0 = *(const f32x4*)(xr + off) + acc[ai][bj][m][0], o1 = *(const f32x4*)(xr + off + 4) + acc[ai][bj][m][1];
                    *(f32x4*)(xw + off) = o0; *(f32x4*)(xw + off + 4) = o1;
                    ss += (o0[0] * o0[0] + o0[1] * o0[1]) + (o0[2] * o0[2] + o0[3] * o0[3]) + (o1[0] * o1[0] + o1[1] * o1[1]) + (o1[2] * o1[2] + o1[3] * o1[3]);
                    const f32x4 g0 = *(const f32x4*)(gn + c0), g1 = *(const f32x4*)(gn + c0 + 4);
                    *(u32x4*)(XG + off) = pack8_h(o0 * g0, o1 * g1);
                }
                ss += __shfl_xor(ss, 16); ss += __shfl_xor(ss, 32);
                if (fq == 0) rss[(size_t)row * 16 + u.pn * 4 + wc] = ss;
            }
    }
};
struct EpiUp {
    static constexpr bool PERM = true, AFTER_DRAIN = false;
    const float* rss; u16* AB;
    __device__ __forceinline__ void operator()(const f32x4 (&acc)[2][2][4][2], const Unit& u, int wr, int wc, int fr, int fq) const {
#pragma unroll
        for (int ai = 0; ai < 2; ++ai)
#pragma unroll
            for (int m = 0; m < 4; ++m) {
                const int row = u.pm * BM + ai * HALF + wr * 64 + m * 16 + fr; const float rs = row_rs(rss, row);
#pragma unroll
                for (int bj = 0; bj < 2; ++bj) *(u32x4*)(AB + (size_t)row * (2 * D_FF) + u.pn * BM + bj * HALF + wc * 32 + fq * 8) = pack8_h(acc[ai][bj][m][0] * rs, acc[ai][bj][m][1] * rs);
            }
    }
};

template <class Epi, class Sched, bool ALIGN_EPI = false, bool SP2 = false, bool F16 = false>
__device__ __forceinline__ void gemm_phase(PG8_LAS unsigned char* lds, const Gemm g, const Sched& S, const Epi& E) {
    const int tid = threadIdx.x, wid = __builtin_amdgcn_readfirstlane(tid >> 6), lane = tid & 63, wr = wid >> 2, wc = wid & 3, fr = lane & 15, fq = lane >> 4;
    const int K = g.K, nt = K / BK;
    unsigned voffA[2], voffB[2];
#pragma unroll
    for (int i = 0; i < 2; ++i) { int R, C; stage_rc(tid * 16 + i * 8192, R, C); const int Rb = Epi::PERM ? ((R & ~31) + perm32(R & 31)) : R;
        voffA[i] = (unsigned)(R * g.lda + C) * 2u; voffB[i] = (unsigned)(Rb * K + C) * 2u; }
    const size_t kstep = (size_t)(BK * 2);
    const size_t hstepA = (size_t)HALF * g.lda * 2, hstepB = (size_t)HALF * K * 2;
    const size_t tstepA = 2 * hstepA, tstepB = 2 * hstepB;
    const unsigned ldsw = (unsigned)wid * 1024u;
    const int aoff = lds_byte(wr * 64 + fr, fq * 8), boff = lds_byte(wc * 32 + fr, fq * 8);
#define PG8_SA(b, h) (((b) * 2 + (h)) * HTB)
#define PG8_SB(b, h) ((4 + (b) * 2 + (h)) * HTB)
#define PG8_STAGE(bufoff, gbase, voff) do { _Pragma("unroll") for (int _i = 0; _i < 2; ++_i) \
        __builtin_amdgcn_global_load_lds((const unsigned*)((const char*)(gbase) + (voff)[_i]), (PG8_LAS unsigned*)(lds + (bufoff) + ldsw + _i * 8192), 16, 0, 0); } while (0)
#define PG8_LDA(dst, b, h) do { _Pragma("unroll") for (int m = 0; m < 4; ++m) _Pragma("unroll") for (int k = 0; k < 2; ++k) dst[m][k] = *(const PG8_LAS bf16x8*)(lds + PG8_SA(b, h) + aoff + m * 2048 + k * 1024); } while (0)
#define PG8_LDB(dst, b, h) do { _Pragma("unroll") for (int n = 0; n < 2; ++n) _Pragma("unroll") for (int k = 0; k < 2; ++k) dst[n][k] = *(const PG8_LAS bf16x8*)(lds + PG8_SB(b, h) + boff + n * 2048 + k * 1024); } while (0)
#define PG8_MMA(ai, bj, At, Bt) do { __builtin_amdgcn_s_setprio(1); _Pragma("unroll") for (int m = 0; m < 4; ++m) _Pragma("unroll") for (int n = 0; n < 2; ++n) _Pragma("unroll") for (int k = 0; k < 2; ++k) \
        acc[ai][bj][m][n] = F16 ? __builtin_amdgcn_mfma_f32_16x16x32_f16(__builtin_bit_cast(f16x8, Bt[n][k]), __builtin_bit_cast(f16x8, At[m][k]), acc[ai][bj][m][n], 0, 0, 0) : __builtin_amdgcn_mfma_f32_16x16x32_bf16(Bt[n][k], At[m][k], acc[ai][bj][m][n], 0, 0, 0); __builtin_amdgcn_s_setprio(0); } while (0)
#define PG8_WAIT_V(n) asm volatile("s_waitcnt vmcnt(" #n ")" ::: "memory")
#define PG8_WAIT_L(n) asm volatile("s_waitcnt lgkmcnt(" #n ")" ::: "memory")
#define PG8_BAR __builtin_amdgcn_s_barrier()
#define PG8_SCHED __builtin_amdgcn_sched_barrier(0)
    Unit cur, nxt; int ui = 0;
    if (!S.next(0, cur)) return;
    f32x4 acc[2][2][4][2];
#pragma unroll
    for (int a = 0; a < 2; ++a)
#pragma unroll
        for (int b = 0; b < 2; ++b)
#pragma unroll
            for (int m = 0; m < 4; ++m)
#pragma unroll
                for (int n = 0; n < 2; ++n) acc[a][b][m][n] = (f32x4){0.f, 0.f, 0.f, 0.f};
    bf16x8 At[4][2], B0[2][2], B1[2][2];
    const char* cA = (const char*)g.A + (size_t)cur.pm * tstepA; const char* cB = (const char*)g.Bt + (size_t)cur.pn * tstepB;
    S.a_ready(cur);
    if constexpr (SP2) {
        PG8_STAGE(PG8_SB(0, 0), cB, voffB); PG8_STAGE(PG8_SB(0, 1), cB + hstepB, voffB); PG8_STAGE(PG8_SA(0, 0), cA, voffA); PG8_STAGE(PG8_SA(0, 1), cA + hstepA, voffA);
        if (wr == 1) PG8_BAR;
        PG8_WAIT_V(2); PG8_BAR;
        PG8_STAGE(PG8_SB(1, 0), cB + kstep, voffB); PG8_STAGE(PG8_SA(1, 0), cA + kstep, voffA); PG8_STAGE(PG8_SB(1, 1), cB + hstepB + kstep, voffB);
        PG8_WAIT_V(6); PG8_BAR;
    } else {
        PG8_STAGE(PG8_SB(0, 0), cB, voffB); PG8_STAGE(PG8_SA(0, 0), cA, voffA); PG8_STAGE(PG8_SB(0, 1), cB + hstepB, voffB); PG8_STAGE(PG8_SA(0, 1), cA + hstepA, voffA);
        if (wr == 1) PG8_BAR;
        PG8_WAIT_V(4); PG8_BAR;
        PG8_STAGE(PG8_SB(1, 0), cB + kstep, voffB); PG8_STAGE(PG8_SA(1, 0), cA + kstep, voffA); PG8_STAGE(PG8_SB(1, 1), cB + hstepB + kstep, voffB);
        PG8_WAIT_V(6); PG8_BAR;
    }
    for (;;) {
        const bool has_next = S.next(ui + 1, nxt);
        const char* nA = has_next ? (const char*)g.A + (size_t)nxt.pm * tstepA : cA; const char* nB = has_next ? (const char*)g.Bt + (size_t)nxt.pn * tstepB : cB;
        for (int t = 0; t < nt; t += 2) {
            const bool last = (t == nt - 2);
            const char* a1 = cA + (size_t)(t + 1) * kstep;
            const char* a2 = last ? nA : cA + (size_t)(t + 2) * kstep; const char* b2 = last ? nB : cB + (size_t)(t + 2) * kstep;
            const char* a3 = a2 + kstep; const char* b3 = b2 + kstep;
            if (last && has_next) S.a_ready(nxt);
            if constexpr (SP2) {
            PG8_LDB(B0, 0, 0); PG8_LDB(B1, 0, 1); PG8_SCHED; PG8_LDA(At, 0, 0); PG8_STAGE(PG8_SA(1, 1), a1 + hstepA, voffA);
            PG8_WAIT_V(8); PG8_WAIT_L(0); PG8_BAR; PG8_MMA(0, 0, At, B0); PG8_MMA(0, 1, At, B1); PG8_BAR; PG8_SCHED;
            PG8_LDA(At, 0, 1); PG8_STAGE(PG8_SB(0, 0), b2, voffB); PG8_STAGE(PG8_SB(0, 1), b2 + hstepB, voffB); PG8_STAGE(PG8_SA(0, 0), a2, voffA);
            PG8_WAIT_V(8); PG8_WAIT_L(0); PG8_BAR; PG8_MMA(1, 0, At, B0); PG8_MMA(1, 1, At, B1); PG8_BAR; PG8_SCHED;
            PG8_LDB(B0, 1, 0); PG8_LDB(B1, 1, 1); PG8_SCHED; PG8_LDA(At, 1, 0); PG8_STAGE(PG8_SA(0, 1), a2 + hstepA, voffA);
            PG8_WAIT_V(8); PG8_WAIT_L(0); PG8_BAR; PG8_MMA(0, 0, At, B0); PG8_MMA(0, 1, At, B1); PG8_BAR; PG8_SCHED;
            PG8_LDA(At, 1, 1); PG8_STAGE(PG8_SB(1, 0), b3, voffB); PG8_STAGE(PG8_SB(1, 1), b3 + hstepB, voffB); PG8_STAGE(PG8_SA(1, 0), a3, voffA);
            PG8_WAIT_V(8); PG8_WAIT_L(0); PG8_BAR; PG8_MMA(1, 0, At, B0); PG8_MMA(1, 1, At, B1); PG8_BAR; PG8_SCHED;
            } else {
            PG8_LDB(B0, 0, 0); PG8_SCHED; PG8_LDA(At, 0, 0); PG8_STAGE(PG8_SA(1, 1), a1 + hstepA, voffA);
            PG8_WAIT_L(8); PG8_BAR; PG8_WAIT_L(0); PG8_MMA(0, 0, At, B0); PG8_BAR; PG8_SCHED;
            PG8_LDB(B1, 0, 1); PG8_STAGE(PG8_SB(0, 0), b2, voffB);
            PG8_BAR; PG8_WAIT_L(0); PG8_MMA(0, 1, At, B1); PG8_BAR;
            PG8_LDA(At, 0, 1); PG8_STAGE(PG8_SA(0, 0), a2, voffA);
            PG8_BAR; PG8_WAIT_L(0); PG8_MMA(1, 0, At, B0); PG8_BAR; PG8_SCHED;
            PG8_STAGE(PG8_SB(0, 1), b2 + hstepB, voffB);
            PG8_WAIT_V(6); PG8_BAR; PG8_MMA(1, 1, At, B1); PG8_BAR;
            PG8_LDB(B0, 1, 0); PG8_SCHED; PG8_LDA(At, 1, 0); PG8_STAGE(PG8_SA(0, 1), a2 + hstepA, voffA);
            PG8_WAIT_L(8); PG8_BAR; PG8_WAIT_L(0); PG8_MMA(0, 0, At, B0); PG8_BAR; PG8_SCHED;
            PG8_LDB(B1, 1, 1); PG8_STAGE(PG8_SB(1, 0), b3, voffB);
            PG8_BAR; PG8_WAIT_L(0); PG8_MMA(0, 1, At, B1); PG8_BAR;
            PG8_LDA(At, 1, 1); PG8_STAGE(PG8_SA(1, 0), a3, voffA);
            PG8_BAR; PG8_WAIT_L(0); PG8_MMA(1, 0, At, B0); PG8_BAR; PG8_SCHED;
            PG8_STAGE(PG8_SB(1, 1), b3 + hstepB, voffB);
            PG8_WAIT_V(6); PG8_BAR; PG8_MMA(1, 1, At, B1); PG8_BAR;
            }
        }
        if constexpr (ALIGN_EPI) { if (wr == 0) PG8_BAR; }
        if constexpr (!Epi::AFTER_DRAIN) { E(acc, cur, wr, wc, fr, fq); S.done(cur); }
        if (!has_next) break;
#pragma unroll
        for (int a = 0; a < 2; ++a)
#pragma unroll
            for (int b = 0; b < 2; ++b)
#pragma unroll
                for (int m = 0; m < 4; ++m)
#pragma unroll
                    for (int n = 0; n < 2; ++n) acc[a][b][m][n] = (f32x4){0.f, 0.f, 0.f, 0.f};
        cur = nxt; cA = nA; cB = nB; ++ui;
        if constexpr (ALIGN_EPI) { if (wr == 1) PG8_BAR; }
    }
    PG8_WAIT_V(0);
    if constexpr (!ALIGN_EPI) { if (wr == 0) PG8_BAR; }
    PG8_BAR;
    if constexpr (Epi::AFTER_DRAIN) { E.fused(acc, cur, wr, wc, fr, fq, lds, wid, lane); S.done(cur); }
#undef PG8_SA
#undef PG8_SB
#undef PG8_STAGE
#undef PG8_LDA
#undef PG8_LDB
#undef PG8_MMA
#undef PG8_WAIT_V
#undef PG8_WAIT_L
#undef PG8_BAR
#undef PG8_SCHED
}
}

#define LAS __attribute__((address_space(3)))
constexpr int NWAVES = 8, NTHR = 512;
constexpr int LDS_BYTES = 147456;
typedef float f32x4 __attribute__((ext_vector_type(4)));
typedef unsigned u32x4 __attribute__((ext_vector_type(4)));

struct Params {
    const float* x; const int* pos; const float* norm1_g; const float* w_in; const float* w_gate_up; const float* b_gate; const float* gla_norm_g; const float* w_pool;
    const float* pool_scale; const float* w_out; const float* norm2_g; const float* w_up; const float* conv_w; const float* conv_b; const float* w_down; const float* final_g;
    float* out; unsigned char* ws; long long layer;
};

template <class CM>
__device__ __forceinline__ void transpose_item(const float* W, int K, int Nsrc, u16* WT, LAS float* scr, int item, int nblk, int lane, const CM& cm) {
    const int kb = item / nblk, nb = item % nblk, k0 = 64 * kb, n0 = 32 * nb;
    const int sc = cm(n0 + (lane & 31));
#pragma unroll 8
    for (int i = 0; i < 32; ++i) { const int kk = 2 * i + (lane >> 5); scr[kk * 33 + (lane & 31)] = (sc >= 0) ? W[(size_t)(k0 + kk) * Nsrc + sc] : 0.f; }
    asm volatile("s_waitcnt lgkmcnt(0)" ::: "memory");
    const int c = lane & 7;
#pragma unroll
    for (int j = 0; j < 4; ++j) { const int n = (lane >> 3) + 8 * j; const LAS float* s = scr + (8 * c) * 33 + n;
        u32x4 o; o.x = pkh(s[0 * 33], s[1 * 33]); o.y = pkh(s[2 * 33], s[3 * 33]); o.z = pkh(s[4 * 33], s[5 * 33]); o.w = pkh(s[6 * 33], s[7 * 33]);
        *(u32x4*)(WT + (size_t)(n0 + n) * K + k0 + 8 * c) = o; }
    asm volatile("s_waitcnt lgkmcnt(0)" ::: "memory");
}
struct CmIdent { __device__ __forceinline__ int operator()(int n) const { return n; } };
struct CmWin {
    __device__ __forceinline__ int operator()(int n) const {
        if (n < 1860) return n;
        if (n < 1864) return -1;
        if (n < 1880) return 2628 + (n - 1864);
        if (n < 2048) return -1;
        if (n < 2304) return 1860 + (n - 2048);
        if (n < 2560) return 2116 + (n - 2304);
        if (n < 2816) return 2372 + (n - 2560);
        return 2644 + (n - 2816);
    }
};
__device__ __forceinline__ int wconv_items(int which) { return which == 0 ? (D_MODEL / 64) * (NPROJ / 32) : which == 1 ? (D_MODEL / 64) * (D_MODEL / 32) : which == 2 ? (D_MODEL / 64) * (2 * D_FF / 32) : (D_FF / 64) * (D_MODEL / 32); }
__device__ __forceinline__ void wconv_item(const Params& p, int l, int which, int item, LAS float* scr, int lane) {
    unsigned char* ws = p.ws;
    if (which == 0) transpose_item(p.w_in + (size_t)l * D_MODEL * IN_WIDTH, D_MODEL, IN_WIDTH, (u16*)(ws + (l ? WS_WIN1 : WS_WIN0)), scr, item, NPROJ / 32, lane, CmWin{});
    else if (which == 1) transpose_item(p.w_out + (size_t)l * D_MODEL * D_MODEL, D_MODEL, D_MODEL, (u16*)(ws + (l ? WS_WOUT1 : WS_WOUT0)), scr, item, D_MODEL / 32, lane, CmIdent{});
    else if (which == 2) transpose_item(p.w_up + (size_t)l * D_MODEL * 2 * D_FF, D_MODEL, 2 * D_FF, (u16*)(ws + WS_WUP), scr, item, 2 * D_FF / 32, lane, CmIdent{});
    else transpose_item(p.w_down + (size_t)l * D_FF * D_MODEL, D_FF, D_MODEL, (u16*)(ws + WS_WDN), scr, item, D_MODEL / 32, lane, CmIdent{});
}
__device__ __forceinline__ void xg_row(const float* xrow, const float* g, u16* orow, float* rssrow, int lane) {
    const f32x4* xr = (const f32x4*)xrow + lane; f32x4 v[4]; float ss = 0.f;
#pragma unroll
    for (int j = 0; j < 4; ++j) { v[j] = xr[64 * j]; ss += (v[j][0] * v[j][0] + v[j][1] * v[j][1]) + (v[j][2] * v[j][2] + v[j][3] * v[j][3]); }
    ss = wave_sum(ss);
#pragma unroll
    for (int j = 0; j < 4; ++j) { const f32x4 gg = *((const f32x4*)g + lane + 64 * j); const f32x4 o = v[j] * gg; uint2 w; w.x = pkh(o[0], o[1]); w.y = pkh(o[2], o[3]); *((uint2*)orow + lane + 64 * j) = w; }
    if (lane < 16) rssrow[lane] = (lane == 0) ? ss : 0.f;
}

__global__ void __launch_bounds__(NTHR, 2) k_prologue(Params p) {
    extern __shared__ __attribute__((aligned(16))) unsigned char lds[];
    const int tid = threadIdx.x, lane = tid & 63, wave = tid >> 6;
    LAS float* scr = (LAS float*)((LAS unsigned char*)lds + wave * 16384);
    const int gw = blockIdx.x * NWAVES + wave, NGW = gridDim.x * NWAVES;
    for (int l = 0; l < 2; ++l)
        for (int which = 0; which < (l == 0 ? 4 : 2); ++which) { const int n = wconv_items(which); for (int it = gw; it < n; it += NGW) wconv_item(p, l, which, it, scr, lane); }
    float* cs = (float*)(p.ws + WS_CS); float* sn = cs + M_TOK * 8;
    for (int i = blockIdx.x * NTHR + tid; i < M_TOK * 8; i += gridDim.x * NTHR) {
        const int t = i >> 3, j = i & 7; const float inv = powf(500000.0f, -(float)(2 * j) / 16.0f); const float ang = (float)p.pos[t] * inv;
        float s, c; sincosf(ang, &s, &c); cs[i] = c; sn[i] = s; }
    for (int m = gw; m < M_TOK; m += NGW) xg_row(p.x + (size_t)m * D_MODEL, p.norm1_g, (u16*)(p.ws + WS_XG) + (size_t)m * D_MODEL, (float*)(p.ws + WS_RSS) + (size_t)m * 16, lane);
}
__global__ void __launch_bounds__(NTHR, 2) k_wconv_updown(Params p) {
    extern __shared__ __attribute__((aligned(16))) unsigned char lds[];
    const int tid = threadIdx.x, lane = tid & 63, wave = tid >> 6;
    LAS float* scr = (LAS float*)((LAS unsigned char*)lds + wave * 16384);
    const int gw = blockIdx.x * NWAVES + wave, NGW = gridDim.x * NWAVES;
    for (int which = 2; which < 4; ++which) { const int n = wconv_items(which); for (int it = gw; it < n; it += NGW) wconv_item(p, 1, which, it, scr, lane); }
}

__global__ void __launch_bounds__(NTHR, 2) k_gemm_proj(Params p) {
    extern __shared__ __attribute__((aligned(16))) unsigned char lds[];
    unsigned char* ws = p.ws; const int l = (int)p.layer;
    pg8::Gemm g{(const u16*)(ws + WS_XG), (const u16*)(ws + (l ? WS_WIN1 : WS_WIN0)), M_TOK, NPROJ, D_MODEL, D_MODEL};
    pg8::StaticOrder S; S.init(M_TOK, NPROJ, gridDim.x, blockIdx.x);
    pg8::EpiProj E{(const float*)(ws + WS_RSS), (const float*)(ws + WS_CS), (const float*)(ws + WS_CS) + M_TOK * 8,
                   (u16*)(ws + WS_Q), (u16*)(ws + WS_K), (u16*)(ws + WS_V), (u16*)(ws + WS_QI), (u16*)(ws + WS_KI), (u16*)(ws + WS_GQK), (u16*)(ws + WS_GV), (u16*)(ws + WS_GR), (u16*)(ws + WS_UC),
                   (float*)(ws + WS_WI), (float*)(ws + WS_GL)};
    pg8::gemm_phase<pg8::EpiProj, pg8::StaticOrder, true, true, true>((LAS unsigned char*)lds, g, S, E);
}
__global__ void __launch_bounds__(NTHR, 2) k_gemm_out(Params p) {
    extern __shared__ __attribute__((aligned(16))) unsigned char lds[];
    unsigned char* ws = p.ws; const int l = (int)p.layer;
    pg8::Gemm g{(const u16*)(ws + WS_MIX), (const u16*)(ws + (l ? WS_WOUT1 : WS_WOUT0)), M_TOK, D_MODEL, D_MODEL, D_MODEL};
    pg8::StaticOrder S; S.init(M_TOK, D_MODEL, gridDim.x, blockIdx.x);
    pg8::EpiResid E{l == 0 ? p.x : p.out, p.out, (u16*)(ws + WS_XG), p.norm2_g + l * D_MODEL, (float*)(ws + WS_RSS)};
    pg8::gemm_phase<pg8::EpiResid, pg8::StaticOrder, true, true, true>((LAS unsigned char*)lds, g, S, E);
}
__global__ void __launch_bounds__(NTHR, 2) k_gemm_up(Params p) {
    extern __shared__ __attribute__((aligned(16))) unsigned char lds[];
    unsigned char* ws = p.ws;
    pg8::Gemm g{(const u16*)(ws + WS_XG), (const u16*)(ws + WS_WUP), M_TOK, 2 * D_FF, D_MODEL, D_MODEL};
    pg8::StaticOrder S; S.init(M_TOK, 2 * D_FF, gridDim.x, blockIdx.x);
    pg8::EpiUp E{(const float*)(ws + WS_RSS), (u16*)(ws + WS_AB)};
    pg8::gemm_phase<pg8::EpiUp, pg8::StaticOrder, true, true, true>((LAS unsigned char*)lds, g, S, E);
}
__global__ void __launch_bounds__(NTHR, 2) k_gemm_down(Params p) {
    extern __shared__ __attribute__((aligned(16))) unsigned char lds[];
    unsigned char* ws = p.ws; const int l = (int)p.layer;
    pg8::Gemm g{(const u16*)(ws + WS_AB) + D_FF, (const u16*)(ws + WS_WDN), M_TOK, D_MODEL, D_FF, 2 * D_FF};
    pg8::StaticOrder S; S.init(M_TOK, D_MODEL, gridDim.x, blockIdx.x);
    pg8::EpiResid E{p.out, p.out, (u16*)(ws + WS_XG), (l + 1 < DEPTH) ? p.norm1_g + (l + 1) * D_MODEL : p.final_g, (float*)(ws + WS_RSS)};
    pg8::gemm_phase<pg8::EpiResid, pg8::StaticOrder, true, true, true>((LAS unsigned char*)lds, g, S, E);
}
__global__ void __launch_bounds__(NTHR, 2) k_convgate(Params p) {
    const int l = (int)p.layer; u16* AB = (u16*)(p.ws + WS_AB);
    const float* cw = p.conv_w + (size_t)l * 3 * D_FF; const float* cb = p.conv_b + (size_t)l * D_FF;
    constexpr int CPR = D_FF / 8;
    for (long it = (long)blockIdx.x * NTHR + threadIdx.x; it < (long)M_TOK * CPR; it += (long)gridDim.x * NTHR) {
        const int row = (int)(it / CPR), c0 = (int)(it % CPR) * 8, pos = row & (SEQ - 1);
        const u16* pa = AB + (size_t)row * (2 * D_FF) + c0;
        const u32x4 a0 = *(const u32x4*)pa; u32x4 a1 = {0u, 0u, 0u, 0u}, a2 = a1;
        if (pos >= 1) a1 = *(const u32x4*)(pa - 2 * D_FF);
        if (pos >= 2) a2 = *(const u32x4*)(pa - 4 * D_FF);
        const u32x4 bb = *(const u32x4*)(pa + D_FF);
        u32x4 o;
#pragma unroll
        for (int q = 0; q < 4; ++q) {
            float r[2];
#pragma unroll
            for (int e = 0; e < 2; ++e) { const int kk = c0 + q * 2 + e;
                const float x0 = h2f(e ? (a0[q] >> 16) : (a0[q] & 0xffffu)), x1 = h2f(e ? (a1[q] >> 16) : (a1[q] & 0xffffu)), x2 = h2f(e ? (a2[q] >> 16) : (a2[q] & 0xffffu)), bv = h2f(e ? (bb[q] >> 16) : (bb[q] & 0xffffu));
                const float cv = cb[kk] + x2 * cw[kk] + x1 * cw[D_FF + kk] + x0 * cw[2 * D_FF + kk]; r[e] = silu_f(cv) * bv; }
            o[q] = pkh(r[0], r[1]);
        }
        *(u32x4*)(AB + (size_t)row * (2 * D_FF) + D_FF + c0) = o;
    }
}
__global__ void __launch_bounds__(NTHR, 2) k_final_norm(Params p) {
    const float* rss = (const float*)(p.ws + WS_RSS);
    for (long it = (long)blockIdx.x * NTHR + threadIdx.x; it < (long)M_TOK * (D_MODEL / 4); it += (long)gridDim.x * NTHR) {
        const int row = (int)(it >> 8), c = (int)(it & 255) * 4; const float rs = pg8::row_rs(rss, row);
        f32x4* px = (f32x4*)(p.out + (size_t)row * D_MODEL + c); const f32x4 g = *(const f32x4*)(p.final_g + c); *px = (*px) * rs * g;
    }
}

__device__ __forceinline__ unsigned f2ord(float x) { const unsigned u = __float_as_uint(x + 0.0f); return (u & 0x80000000u) ? ~u : (u | 0x80000000u); }

__global__ void __launch_bounds__(256) k_index_topk(const u16* __restrict__ QI, const u16* __restrict__ KI, const float* __restrict__ WI, unsigned* __restrict__ MASK) {
    __shared__ float qs[256];
    __shared__ unsigned sc[256 * 33];
    __shared__ int red[2][4];
    __shared__ int wtot[4];
    const int q = blockIdx.x, b = q >> 13, t = q & (SEQ - 1), n = t + 1, tid = threadIdx.x, lane = tid & 63, w = tid >> 6;
    unsigned* mrow = MASK + (size_t)q * 256;
    if (n <= TOPK) {
        const int lo = tid * 32; unsigned word = 0u;
        if (lo <= t) { const int cnt = t - lo + 1; word = cnt >= 32 ? 0xffffffffu : ((1u << cnt) - 1u); }
        mrow[tid] = word; return;
    }
    qs[tid] = h2f(QI[(size_t)q * 256 + tid]);
    const float w0 = WI[q * 4 + 0], w1 = WI[q * 4 + 1], w2 = WI[q * 4 + 2], w3 = WI[q * 4 + 3];
    __syncthreads();
    for (int j = 0; j < 32; ++j) {
        const int s = tid * 32 + j; unsigned key = 0u;
        if (s < n) {
            const uint4* kp = (const uint4*)(KI + (size_t)(b * SEQ + s) * 64);
            float d0 = 0.f, d1 = 0.f, d2 = 0.f, d3 = 0.f;
#pragma unroll
            for (int c = 0; c < 8; ++c) {
                const uint4 kv = kp[c]; const unsigned kw[4] = {kv.x, kv.y, kv.z, kv.w};
#pragma unroll
                for (int e = 0; e < 4; ++e) {
                    const float k0 = h2f(kw[e] & 0xffffu), k1 = h2f(kw[e] >> 16); const int d = c * 8 + e * 2;
                    d0 += qs[d] * k0 + qs[d + 1] * k1; d1 += qs[64 + d] * k0 + qs[64 + d + 1] * k1;
                    d2 += qs[128 + d] * k0 + qs[128 + d + 1] * k1; d3 += qs[192 + d] * k0 + qs[192 + d + 1] * k1;
                }
            }
            const float score = w0 * fmaxf(d0, 0.f) + w1 * fmaxf(d1, 0.f) + w2 * fmaxf(d2, 0.f) + w3 * fmaxf(d3, 0.f);
            key = f2ord(score);
        }
        sc[tid * 33 + j] = key;
    }
    __syncthreads();
    unsigned u[32];
#pragma unroll
    for (int j = 0; j < 32; ++j) u[j] = sc[tid * 33 + j];
    unsigned T = 0u;
    for (int bit = 31; bit >= 0; --bit) {
        const unsigned cand = T | (1u << bit); int c = 0;
#pragma unroll
        for (int j = 0; j < 32; ++j) c += (u[j] >= cand) ? 1 : 0;
        c = (int)wave_sum((float)c);
        if (lane == 0) red[bit & 1][w] = c;
        __syncthreads();
        const int tot = red[bit & 1][0] + red[bit & 1][1] + red[bit & 1][2] + red[bit & 1][3];
        if (tot >= TOPK) T = cand;
    }
    int cgt = 0, ceq = 0;
#pragma unroll
    for (int j = 0; j < 32; ++j) { cgt += (u[j] > T) ? 1 : 0; ceq += (u[j] == T) ? 1 : 0; }
    float fg = wave_sum((float)cgt);
    int incl = ceq;
#pragma unroll
    for (int o = 1; o < 64; o <<= 1) { const int v = __shfl_up(incl, o); if (lane >= o) incl += v; }
    __syncthreads();
    if (lane == 63) wtot[w] = incl;
    if (lane == 0) red[0][w] = (int)fg;
    __syncthreads();
    const int cgt_tot = red[0][0] + red[0][1] + red[0][2] + red[0][3];
    int excl = incl - ceq;
    for (int ww = 0; ww < w; ++ww) excl += wtot[ww];
    const int need = TOPK - cgt_tot;
    unsigned word = 0u; int rk = excl;
#pragma unroll
    for (int j = 0; j < 32; ++j) {
        bool sel = u[j] > T;
        if (u[j] == T) { sel = rk < need; ++rk; }
        word |= sel ? (1u << j) : 0u;
    }
    mrow[tid] = word;
}

__global__ void __launch_bounds__(256) k_sparse_attn(const u16* __restrict__ Q, const u16* __restrict__ K, const u16* __restrict__ V, const unsigned* __restrict__ MASK, u16* __restrict__ MIX) {
    __shared__ int idx[256];
    __shared__ float qf[512];
    __shared__ float lg[8][256];
    __shared__ int wtot[4];
    const int q = blockIdx.x, b = q >> 13, tid = threadIdx.x, lane = tid & 63, w = tid >> 6;
    const unsigned word = MASK[(size_t)q * 256 + tid];
    const int pc = __popc(word);
    int incl = pc;
#pragma unroll
    for (int o = 1; o < 64; o <<= 1) { const int v = __shfl_up(incl, o); if (lane >= o) incl += v; }
    if (lane == 63) wtot[w] = incl;
    qf[tid] = bf2f(Q[(size_t)q * 512 + tid]); qf[256 + tid] = bf2f(Q[(size_t)q * 512 + 256 + tid]);
    __syncthreads();
    int off = incl - pc;
    for (int ww = 0; ww < w; ++ww) off += wtot[ww];
    const int cnt = wtot[0] + wtot[1] + wtot[2] + wtot[3];
    { unsigned m = word; while (m) { const int j = __ffs(m) - 1; m &= m - 1; if (off < 256) idx[off] = tid * 32 + j; ++off; } }
    __syncthreads();
    const int h = tid >> 5, l32 = tid & 31;
    float mx = -INFINITY;
    for (int j = l32; j < cnt; j += 32) {
        const uint4* kp = (const uint4*)(K + (size_t)(b * SEQ + idx[j]) * 512 + h * 64);
        float d = 0.f;
#pragma unroll
        for (int c = 0; c < 8; ++c) {
            const uint4 kv = kp[c]; const unsigned kw[4] = {kv.x, kv.y, kv.z, kv.w};
#pragma unroll
            for (int e = 0; e < 4; ++e) d += qf[h * 64 + c * 8 + e * 2] * bf2f(kw[e] & 0xffffu) + qf[h * 64 + c * 8 + e * 2 + 1] * bf2f(kw[e] >> 16);
        }
        lg[h][j] = d; mx = fmaxf(mx, d);
    }
#pragma unroll
    for (int o = 16; o >= 1; o >>= 1) mx = fmaxf(mx, __shfl_xor(mx, o));
    float sum = 0.f;
    for (int j = l32; j < cnt; j += 32) { const float pr = exp2f(lg[h][j] - mx); lg[h][j] = pr; sum += pr; }
#pragma unroll
    for (int o = 16; o >= 1; o >>= 1) sum += __shfl_xor(sum, o);
    __syncthreads();
    float a0 = 0.f, a1 = 0.f;
    for (int j = 0; j < cnt; ++j) {
        const unsigned vv = *(const unsigned*)(V + (size_t)(b * SEQ + idx[j]) * 512 + h * 64 + 2 * l32);
        const float pr = lg[h][j]; a0 += pr * bf2f(vv & 0xffffu); a1 += pr * bf2f(vv >> 16);
    }
    const float inv = 1.f / sum;
    *(unsigned*)(MIX + (size_t)q * D_MODEL + h * 64 + 2 * l32) = pkh(a0 * inv, a1 * inv);
}

__device__ __forceinline__ void gla_cumlog(const float* __restrict__ GL, const float* __restrict__ wg, const float* __restrict__ bg, int tok0, int h, float (*bl)[33]) {
    const int tid = threadIdx.x, i = tid >> 2, dq = tid & 3;
    float gl[16];
#pragma unroll
    for (int r = 0; r < 16; ++r) gl[r] = GL[(size_t)(tok0 + i) * 16 + r];
#pragma unroll
    for (int dd = 0; dd < 8; ++dd) {
        const int d = dq * 8 + dd; float z = bg[h * 32 + d];
#pragma unroll
        for (int r = 0; r < 16; ++r) z += gl[r] * wg[r * 128 + h * 32 + d];
        const float ls = fminf(z, 0.f) - log1pf(__expf(-fabsf(z)));
        bl[i][d] = ls * (1.f / 16.f);
    }
    __syncthreads();
    if (tid < 32) { float a = 0.f; for (int ii = 0; ii < 64; ++ii) { a += bl[ii][tid]; bl[ii][tid] = a; } }
    __syncthreads();
}
__global__ void __launch_bounds__(256) k_gla1(const float* __restrict__ GL, const u16* __restrict__ GQK, const u16* __restrict__ GV, const float* __restrict__ wg, const float* __restrict__ bg, float* __restrict__ DS, float* __restrict__ DD) {
    __shared__ float bl[64][33];
    __shared__ float kh[64][33];
    __shared__ float vv[64][64];
    const int blk = blockIdx.x, b = blk >> 9, h = (blk >> 7) & 3, c = blk & 127, tid = threadIdx.x, tok0 = b * SEQ + c * 64;
    gla_cumlog(GL, wg, bg, tok0, h, bl);
    { const int j = tid >> 2, dq = tid & 3;
#pragma unroll
      for (int dd = 0; dd < 8; ++dd) { const int d = dq * 8 + dd; kh[j][d] = bf2f(GQK[(size_t)(tok0 + j) * 256 + 128 + h * 32 + d]) * __expf(bl[63][d] - bl[j][d]); }
#pragma unroll
      for (int ee = 0; ee < 16; ++ee) { const int e = dq * 16 + ee; vv[j][e] = bf2f(GV[(size_t)(tok0 + j) * 256 + h * 64 + e]); } }
    __syncthreads();
    const int e = tid & 63, dg = tid >> 6;
#pragma unroll
    for (int dd = 0; dd < 8; ++dd) { const int d = dg * 8 + dd; float s = 0.f; for (int j = 0; j < 64; ++j) s += kh[j][d] * vv[j][e]; DS[(size_t)blk * 2048 + d * 64 + e] = s; }
    if (tid < 32) DD[blk * 32 + tid] = __expf(bl[63][tid]);
}
__global__ void __launch_bounds__(256) k_gla2(const float* __restrict__ DS, const float* __restrict__ DD, float* __restrict__ S0) {
    const int idx = blockIdx.x * 256 + threadIdx.x, bh = idx >> 11, de = idx & 2047;
    float S = 0.f;
    for (int c = 0; c < 128; ++c) { const int blk = bh * 128 + c; S0[(size_t)blk * 2048 + de] = S; S = DD[blk * 32 + (de >> 6)] * S + DS[(size_t)blk * 2048 + de]; }
}
__global__ void __launch_bounds__(256) k_gla3(const float* __restrict__ GL, const u16* __restrict__ GQK, const u16* __restrict__ GV, const u16* __restrict__ GR, const float* __restrict__ wg, const float* __restrict__ bg,
                                             const float* __restrict__ S0, const float* __restrict__ gn, u16* __restrict__ MIX) {
    __shared__ float bl[64][33];
    __shared__ float qt[64][33];
    __shared__ float kt[64][33];
    __shared__ u16 vv[64][64];
    __shared__ float Ss[32][64];
    __shared__ float at[64][65];
    const int blk = blockIdx.x, b = blk >> 9, h = (blk >> 7) & 3, c = blk & 127, tid = threadIdx.x, tok0 = b * SEQ + c * 64;
    gla_cumlog(GL, wg, bg, tok0, h, bl);
    const int i = tid >> 2, qd = tid & 3;
#pragma unroll
    for (int dd = 0; dd < 8; ++dd) { const int d = qd * 8 + dd; const float bb = bl[i][d];
        qt[i][d] = bf2f(GQK[(size_t)(tok0 + i) * 256 + h * 32 + d]) * 0.17677669529663687f * __expf(bb);
        kt[i][d] = bf2f(GQK[(size_t)(tok0 + i) * 256 + 128 + h * 32 + d]) * __expf(-bb); }
#pragma unroll
    for (int ee = 0; ee < 16; ++ee) { const int e = qd * 16 + ee; vv[i][e] = GV[(size_t)(tok0 + i) * 256 + h * 64 + e]; }
    for (int x = tid; x < 2048; x += 256) Ss[x >> 6][x & 63] = S0[(size_t)blk * 2048 + x];
    __syncthreads();
#pragma unroll
    for (int jj = 0; jj < 16; ++jj) { const int j = qd * 16 + jj; float s = 0.f;
        if (j <= i) { for (int d = 0; d < 32; ++d) s += qt[i][d] * kt[j][d]; }
        at[i][j] = s; }
    __syncthreads();
    float o[16]; float ss = 0.f;
#pragma unroll
    for (int ee = 0; ee < 16; ++ee) { const int e = qd * 16 + ee; float s = 0.f;
        for (int d = 0; d < 32; ++d) s += qt[i][d] * Ss[d][e];
        for (int j = 0; j <= i; ++j) s += at[i][j] * bf2f(vv[j][e]);
        o[ee] = s; ss += s * s; }
    ss += __shfl_xor(ss, 1); ss += __shfl_xor(ss, 2);
    const float rs = rsqrtf(ss * (1.f / 64.f) + EPS);
#pragma unroll
    for (int ee = 0; ee < 16; ++ee) { const int e = qd * 16 + ee;
        const float r = bf2f(GR[(size_t)(tok0 + i) * 256 + h * 64 + e]);
        MIX[(size_t)(tok0 + i) * D_MODEL + 512 + h * 64 + e] = (u16)f2h(o[ee] * rs * gn[h * 64 + e] * silu_f(r)); }
}
__global__ void __launch_bounds__(256) k_pool(const u16* __restrict__ UC, const float* __restrict__ wp, const float* __restrict__ psc, u16* __restrict__ MIX) {
    __shared__ float pl[16][256];
    const int tok0 = blockIdx.x * 16, tid = threadIdx.x, g = tid >> 6;
    const int win = 2 << g;
    for (int tt = 0; tt < 16; ++tt) {
        const int tok = tok0 + tt, pos = tok & (SEQ - 1); const int cnt = (pos + 1 < win) ? pos + 1 : win;
        float s = 0.f;
        for (int j = 0; j < cnt; ++j) s += bf2f(UC[(size_t)(tok - j) * 256 + tid]);
        pl[tt][tid] = s / (float)cnt - bf2f(UC[(size_t)tok * 256 + tid]);
    }
    __syncthreads();
    const int e = tid & 63;
    float acc[16];
#pragma unroll
    for (int tt = 0; tt < 16; ++tt) acc[tt] = 0.f;
    for (int d = 0; d < 64; ++d) { const float wv = wp[(g * 64 + d) * 64 + e];
#pragma unroll
        for (int tt = 0; tt < 16; ++tt) acc[tt] += pl[tt][g * 64 + d] * wv; }
    const float sc = psc[tid];
#pragma unroll
    for (int tt = 0; tt < 16; ++tt) MIX[(size_t)(tok0 + tt) * D_MODEL + 768 + tid] = (u16)f2h(acc[tt] * sc);
}

extern "C" void kernel_launch(void* const* d_in, const int* in_sizes, int n_in, void* d_out, int out_size, void* d_ws, size_t ws_size, hipStream_t stream) {
    static int grid = 0;
    if (grid == 0) {
        int dev = 0, cus = 0; hipGetDevice(&dev); hipDeviceGetAttribute(&cus, hipDeviceAttributeMultiprocessorCount, dev);
        hipFuncSetAttribute((const void*)k_prologue, hipFuncAttributeMaxDynamicSharedMemorySize, LDS_BYTES);
        hipFuncSetAttribute((const void*)k_wconv_updown, hipFuncAttributeMaxDynamicSharedMemorySize, LDS_BYTES);
        hipFuncSetAttribute((const void*)k_gemm_proj, hipFuncAttributeMaxDynamicSharedMemorySize, LDS_BYTES);
        hipFuncSetAttribute((const void*)k_gemm_out, hipFuncAttributeMaxDynamicSharedMemorySize, LDS_BYTES);
        hipFuncSetAttribute((const void*)k_gemm_up, hipFuncAttributeMaxDynamicSharedMemorySize, LDS_BYTES);
        hipFuncSetAttribute((const void*)k_gemm_down, hipFuncAttributeMaxDynamicSharedMemorySize, LDS_BYTES);
        grid = cus > 0 ? cus : 256;
        if (ws_size < WS_END) fprintf(stderr, "kernel_launch: workspace too small (%zu)\n", ws_size);
    }
    Params p; memset(&p, 0, sizeof(p));
    p.x = (const float*)d_in[0]; p.pos = (const int*)d_in[1]; p.norm1_g = (const float*)d_in[2]; p.w_in = (const float*)d_in[3]; p.w_gate_up = (const float*)d_in[4]; p.b_gate = (const float*)d_in[5];
    p.gla_norm_g = (const float*)d_in[6]; p.w_pool = (const float*)d_in[7]; p.pool_scale = (const float*)d_in[8]; p.w_out = (const float*)d_in[9]; p.norm2_g = (const float*)d_in[10]; p.w_up = (const float*)d_in[11];
    p.conv_w = (const float*)d_in[12]; p.conv_b = (const float*)d_in[13]; p.w_down = (const float*)d_in[14]; p.final_g = (const float*)d_in[15];
    p.out = (float*)d_out; p.ws = (unsigned char*)d_ws;
    unsigned char* ws = (unsigned char*)d_ws;
    u16 *Q = (u16*)(ws + WS_Q), *K = (u16*)(ws + WS_K), *V = (u16*)(ws + WS_V), *QI = (u16*)(ws + WS_QI), *KI = (u16*)(ws + WS_KI), *GQK = (u16*)(ws + WS_GQK), *GV = (u16*)(ws + WS_GV), *GR = (u16*)(ws + WS_GR), *UC = (u16*)(ws + WS_UC), *MIX = (u16*)(ws + WS_MIX);
    float *WI = (float*)(ws + WS_WI), *GL = (float*)(ws + WS_GL);
    unsigned* MASK = (unsigned*)(ws + WS_MASK);
    float *GDS = (float*)(ws + WS_LIST), *GS0 = (float*)(ws + WS_LIST + 8 * MiB), *GDD = (float*)(ws + WS_LIST + 16 * MiB);

    p.layer = 0;
    k_prologue<<<grid, NTHR, LDS_BYTES, stream>>>(p);
    for (int l = 0; l < DEPTH; ++l) {
        p.layer = l;
        k_gemm_proj<<<grid, NTHR, LDS_BYTES, stream>>>(p);
        k_index_topk<<<M_TOK, 256, 0, stream>>>(QI, KI, WI, MASK);
        k_sparse_attn<<<M_TOK, 256, 0, stream>>>(Q, K, V, MASK, MIX);
        k_gla1<<<1024, 256, 0, stream>>>(GL, GQK, GV, p.w_gate_up + l * 16 * 128, p.b_gate + l * 128, GDS, GDD);
        k_gla2<<<64, 256, 0, stream>>>(GDS, GDD, GS0);
        k_gla3<<<1024, 256, 0, stream>>>(GL, GQK, GV, GR, p.w_gate_up + l * 16 * 128, p.b_gate + l * 128, GS0, p.gla_norm_g + l * 256, MIX);
        k_pool<<<M_TOK / 16, 256, 0, stream>>>(UC, p.w_pool + (size_t)l * 4 * 64 * 64, p.pool_scale + l * 256, MIX);
        k_gemm_out<<<grid, NTHR, LDS_BYTES, stream>>>(p);
        if (l == 1) k_wconv_updown<<<grid, NTHR, LDS_BYTES, stream>>>(p);
        k_gemm_up<<<grid, NTHR, LDS_BYTES, stream>>>(p);
        k_convgate<<<grid, NTHR, 0, stream>>>(p);
        k_gemm_down<<<grid, NTHR, LDS_BYTES, stream>>>(p);
    }
    k_final_norm<<<grid, NTHR, 0, stream>>>(p);
}
```

```cpp
#include <hip/hip_runtime.h>
#include <cstdint>
#include <cstdio>
#include <cstring>

typedef unsigned short u16;
typedef _Float16 f16x8 __attribute__((ext_vector_type(8)));

constexpr int D_MODEL = 1024, BATCH = 2, SEQ = 8192, DEPTH = 2, M_TOK = BATCH * SEQ;
constexpr int IN_WIDTH = 2900, NPROJ = 3072;
constexpr int D_FF = 2816;
constexpr float EPS = 1e-6f;
constexpr int TOPK = 256;
constexpr float C2 = 0.125f * 1.4426950408889634f;

constexpr size_t MiB = 1u << 20;
constexpr size_t WS_CTL = 0, CTL_ZERO_BYTES = 64 * 1024;
constexpr size_t WS_CS = 1 * MiB;
constexpr size_t WS_WI = 2 * MiB;
constexpr size_t WS_GL = 3 * MiB;
constexpr size_t WS_RSS = 4 * MiB;
constexpr size_t WS_WIN0 = 5 * MiB, WS_WOUT0 = 11 * MiB, WS_WIN1 = 13 * MiB, WS_WOUT1 = 19 * MiB;
constexpr size_t WS_WUP = 21 * MiB, WS_WDN = 32 * MiB;
constexpr size_t WS_XG = 38 * MiB;
constexpr size_t WS_AB = 70 * MiB;
constexpr size_t WS_Q = 70 * MiB, WS_K = 86 * MiB, WS_V = 102 * MiB;
constexpr size_t WS_QI = 118 * MiB;
constexpr size_t WS_KI = 126 * MiB;
constexpr size_t WS_GQK = 128 * MiB, WS_GV = 136 * MiB, WS_GR = 144 * MiB, WS_UC = 152 * MiB;
constexpr size_t WS_MIX = 160 * MiB;
constexpr size_t WS_LIST = 192 * MiB;
constexpr size_t WS_MASK = 38 * MiB;
constexpr size_t WS_GST = 54 * MiB;
constexpr size_t WS_END = 256 * MiB;

__device__ __forceinline__ unsigned f2bf(float f) { unsigned u = __float_as_uint(f); return (u + 0x7fffu + ((u >> 16) & 1u)) >> 16; }
__device__ __forceinline__ float bf2f(unsigned h) { return __uint_as_float(h << 16); }
__device__ __forceinline__ unsigned f2h(float f) { _Float16 h = (_Float16)f; return (unsigned)__builtin_bit_cast(unsigned short, h); }
__device__ __forceinline__ float h2f(unsigned h) { return (float)__builtin_bit_cast(_Float16, (unsigned short)h); }
typedef float f32x2_t __attribute__((ext_vector_type(2))); typedef __bf16 bf16x2_t __attribute__((ext_vector_type(2))); typedef _Float16 f16x2_t __attribute__((ext_vector_type(2)));
__device__ __forceinline__ unsigned pkbf(float lo, float hi) { f32x2_t v = {lo, hi}; bf16x2_t b = __builtin_convertvector(v, bf16x2_t); return __builtin_bit_cast(unsigned, b); }
__device__ __forceinline__ unsigned pkh(float lo, float hi) { f32x2_t v = {lo, hi}; f16x2_t b = __builtin_convertvector(v, f16x2_t); return __builtin_bit_cast(unsigned, b); }
__device__ __forceinline__ float wave_sum(float v) {
#pragma unroll
    for (int o = 1; o < 64; o <<= 1) v += __shfl_xor(v, o);
    return v;
}
__device__ __forceinline__ float silu_f(float x) { return x / (1.f + __expf(-x)); }

namespace pg8 {
#define PG8_LAS __attribute__((address_space(3)))
typedef unsigned short bf16_t;
typedef short bf16x8 __attribute__((ext_vector_type(8)));
typedef float f32x4 __attribute__((ext_vector_type(4)));
typedef unsigned u32x4 __attribute__((ext_vector_type(4)));
constexpr int BM = 256, BK = 64, HALF = 128, HTB = HALF * BK * 2  , STAGE_BYTES = 8 * HTB, NXCD = 8, WGM = 8;

__host__ __device__ __forceinline__ int lds_byte(int r, int c) { const int st = (r >> 4) * 2 + (c >> 5), rr = r & 15, cc = c & 31, ob = rr * 64 + cc * 2; return st * 1024 + (ob ^ (((ob >> 9) & 1) << 5)); }
__host__ __device__ __forceinline__ void stage_rc(int b, int& R, int& C) { const int st = b / 1024, sb = b % 1024, swz = sb ^ (((sb >> 9) & 1) << 5); R = (st >> 1) * 16 + swz / 64; C = (st & 1) * 32 + (swz % 64) / 2; }
__host__ __device__ __forceinline__ int perm32(int rho) { const int n = rho >> 4, i = rho & 15; return 8 * (i >> 2) + 4 * n + (i & 3); }

struct Unit { int pm, pn; };
struct Gemm { const bf16_t* A; const bf16_t* Bt; int M, N, K, lda; };

struct StaticOrder {
    int nM, nN, nwg, G, c;
    __host__ __device__ void init(int M, int N, int G_, int c_) { nM = M / BM; nN = N / BM; nwg = nM * nN; G = G_; c = c_; }
    __host__ __device__ bool next(int i, Unit& u) const {
        const long L = (long)i * G + c; if (L >= nwg) return false;
        int wgid = (int)L; { const int q = nwg / NXCD, r = nwg % NXCD, xcd = wgid % NXCD, off = wgid / NXCD; wgid = (xcd < r ? xcd * (q + 1) : r * (q + 1) + (xcd - r) * q) + off; }
        const int nig = WGM * nN, gid = wgid / nig, fm = gid * WGM, gsz = (nM - fm) < WGM ? (nM - fm) : WGM;
        u.pm = fm + ((wgid % nig) % gsz); u.pn = (wgid % nig) / gsz; return true;
    }
    __device__ __forceinline__ void a_ready(const Unit&) const {}
    __device__ __forceinline__ void done(const Unit&) const {}
};

__device__ __forceinline__ float row_rs(const float* rss, int row) {
    const f32x4* rp = (const f32x4*)(rss + (size_t)row * 16);
    const f32x4 s0 = rp[0], s1 = rp[1], s2 = rp[2], s3 = rp[3];
    const float t = (((s0[0] + s0[1]) + (s0[2] + s0[3])) + ((s1[0] + s1[1]) + (s1[2] + s1[3]))) + (((s2[0] + s2[1]) + (s2[2] + s2[3])) + ((s3[0] + s3[1]) + (s3[2] + s3[3])));
    return rsqrtf(t * (1.f / D_MODEL) + EPS);
}
__device__ __forceinline__ u32x4 pack8_bf(const f32x4& a, const f32x4& b) { u32x4 w; w.x = pkbf(a[0], a[1]); w.y = pkbf(a[2], a[3]); w.z = pkbf(b[0], b[1]); w.w = pkbf(b[2], b[3]); return w; }
__device__ __forceinline__ u32x4 pack8_h(const f32x4& a, const f32x4& b) { u32x4 w; w.x = pkh(a[0], a[1]); w.y = pkh(a[2], a[3]); w.z = pkh(b[0], b[1]); w.w = pkh(b[2], b[3]); return w; }

struct EpiProj {
    static constexpr bool PERM = true, AFTER_DRAIN = false;
    const float* rss; const float* cs; const float* sn;
    u16 *Q, *K, *V, *QI, *KI, *GQK, *GV, *GR, *UC; float *WI, *GL;
    __device__ __forceinline__ void operator()(const f32x4 (&acc)[2][2][4][2], const Unit& u, int wr, int wc, int fr, int fq) const {
        const int pn = u.pn;
        const bool ropetile = (pn < 4) || pn == 6 || pn == 7;
#pragma unroll
        for (int ai = 0; ai < 2; ++ai)
#pragma unroll
            for (int m = 0; m < 4; ++m) {
                const int row = u.pm * BM + ai * HALF + wr * 64 + m * 16 + fr;
                const float rs = row_rs(rss, row);
                f32x4 c0 = {0.f, 0.f, 0.f, 0.f}, c1 = c0, s0 = c0, s1 = c0;
                if (ropetile) { c0 = *(const f32x4*)(cs + row * 8); c1 = *(const f32x4*)(cs + row * 8 + 4); s0 = *(const f32x4*)(sn + row * 8); s1 = *(const f32x4*)(sn + row * 8 + 4); }
#pragma unroll
                for (int bj = 0; bj < 2; ++bj) {
                    f32x4 v0 = acc[ai][bj][m][0] * rs, v1 = acc[ai][bj][m][1] * rs;
                    const int cl = bj * HALF + wc * 32 + fq * 8;
                    if (ropetile) {
                        f32x4 p0, p1;
#pragma unroll
                        for (int e = 0; e < 4; ++e) { p0[e] = __shfl_xor(v0[e], 16); p1[e] = __shfl_xor(v1[e], 16); }
                        const bool dorope = ((wc & 1) == 0) && (fq < 2) && (pn != 7 || (bj == 0 && wc == 0));
                        if (dorope) {
                            if (fq == 0) { v0 = v0 * c0 - p0 * s0; v1 = v1 * c1 - p1 * s1; }
                            else         { v0 = v0 * c0 + p0 * s0; v1 = v1 * c1 + p1 * s1; }
                        }
                    }
                    if (pn < 2)       { *(u32x4*)(Q + (size_t)row * 512 + pn * 256 + cl) = pack8_bf(v0 * C2, v1 * C2); }
                    else if (pn < 4)  { *(u32x4*)(K + (size_t)row * 512 + (pn - 2) * 256 + cl) = pack8_bf(v0, v1); }
                    else if (pn < 6)  { *(u32x4*)(V + (size_t)row * 512 + (pn - 4) * 256 + cl) = pack8_bf(v0, v1); }
                    else if (pn == 6) { *(u32x4*)(QI + (size_t)row * 256 + cl) = pack8_h(v0, v1); }
                    else if (pn == 7) {
                        if (cl < 64) *(u32x4*)(KI + (size_t)row * 64 + cl) = pack8_h(v0, v1);
                        else if (cl == 64) *(f32x4*)(WI + (size_t)row * 4) = v0;
                        else if (cl == 72) { *(f32x4*)(GL + (size_t)row * 16) = v0; *(f32x4*)(GL + (size_t)row * 16 + 4) = v1; }
                        else if (cl == 80) { *(f32x4*)(GL + (size_t)row * 16 + 8) = v0; *(f32x4*)(GL + (size_t)row * 16 + 12) = v1; }
                    }
                    else if (pn == 8) { *(u32x4*)(GQK + (size_t)row * 256 + cl) = pack8_bf(v0, v1); }
                    else if (pn == 9) { *(u32x4*)(GV + (size_t)row * 256 + cl) = pack8_bf(v0, v1); }
                    else if (pn == 10) { *(u32x4*)(GR + (size_t)row * 256 + cl) = pack8_bf(v0, v1); }
                    else { *(u32x4*)(UC + (size_t)row * 256 + cl) = pack8_bf(v0, v1); }
                }
            }
    }
};
struct EpiResid {
    static constexpr bool PERM = true, AFTER_DRAIN = false;
    const float* xr; float* xw; u16* XG; const float* gn; float* rss;
    __device__ __forceinline__ void operator()(const f32x4 (&acc)[2][2][4][2], const Unit& u, int wr, int wc, int fr, int fq) const {
#pragma unroll
        for (int ai = 0; ai < 2; ++ai)
#pragma unroll
            for (int m = 0; m < 4; ++m) {
                const int row = u.pm * BM + ai * HALF + wr * 64 + m * 16 + fr; float ss = 0.f;
#pragma unroll
                for (int bj = 0; bj < 2; ++bj) {
                    const int c0 = u.pn * BM + bj * HALF + wc * 32 + fq * 8; const size_t off = (size_t)row * D_MODEL + c0;
                    const f32x4 o0 = *(const f32x4*)(xr + off) + acc[ai][bj][m][0], o1 = *(const f32x4*)(xr + off + 4) + acc[ai][bj][m][1];
                    *(f32x4*)(xw + off) = o0; *(f32x4*)(xw + off + 4) = o1;
                    ss += (o0[0] * o0[0] + o0[1] * o0[1]) + (o0[2] * o0[2] + o0[3] * o0[3]) + (o1[0] * o1[0] + o1[1] * o1[1]) + (o1[2] * o1[2] + o1[3] * o1[3]);
                    const f32x4 g0 = *(const f32x4*)(gn + c0), g1 = *(const f32x4*)(gn + c0 + 4);
                    *(u32x4*)(XG + off) = pack8_h(o0 * g0, o1 * g1);
                }
                ss += __shfl_xor(ss, 16); ss += __shfl_xor(ss, 32);
                if (fq == 0) rss[(size_t)row * 16 + u.pn * 4 + wc] = ss;
            }
    }
};
struct EpiUp {
    static constexpr bool PERM = true, AFTER_DRAIN = false;
    const float* rss; u16* AB;
    __device__ __forceinline__ void operator()(const f32x4 (&acc)[2][2][4][2], const Unit& u, int wr, int wc, int fr, int fq) const {
#pragma unroll
        for (int ai = 0; ai < 2; ++ai)
#pragma unroll
            for (int m = 0; m < 4; ++m) {
                const int row = u.pm * BM + ai * HALF + wr * 64 + m * 16 + fr; const float rs = row_rs(rss, row);
#pragma unroll
                for (int bj = 0; bj < 2; ++bj) *(u32x4*)(AB + (size_t)row * (2 * D_FF) + u.pn * BM + bj * HALF + wc * 32 + fq * 8) = pack8_h(acc[ai][bj][m][0] * rs, acc[ai][bj][m][1] * rs);
            }
    }
};

template <class Epi, class Sched, bool ALIGN_EPI = false, bool SP2 = false, bool F16 = false>
__device__ __forceinline__ void gemm_phase(PG8_LAS unsigned char* lds, const Gemm g, const Sched& S, const Epi& E) {
    const int tid = threadIdx.x, wid = __builtin_amdgcn_readfirstlane(tid >> 6), lane = tid & 63, wr = wid >> 2, wc = wid & 3, fr = lane & 15, fq = lane >> 4;
    const int K = g.K, nt = K / BK;
    unsigned voffA[2], voffB[2];
#pragma unroll
    for (int i = 0; i < 2; ++i) { int R, C; stage_rc(tid * 16 + i * 8192, R, C); const int Rb = Epi::PERM ? ((R & ~31) + perm32(R & 31)) : R;
        voffA[i] = (unsigned)(R * g.lda + C) * 2u; voffB[i] = (unsigned)(Rb * K + C) * 2u; }
    const size_t kstep = (size_t)(BK * 2);
    const size_t hstepA = (size_t)HALF * g.lda * 2, hstepB = (size_t)HALF * K * 2;
    const size_t tstepA = 2 * hstepA, tstepB = 2 * hstepB;
    const unsigned ldsw = (unsigned)wid * 1024u;
    const int aoff = lds_byte(wr * 64 + fr, fq * 8), boff = lds_byte(wc * 32 + fr, fq * 8);
#define PG8_SA(b, h) (((b) * 2 + (h)) * HTB)
#define PG8_SB(b, h) ((4 + (b) * 2 + (h)) * HTB)
#define PG8_STAGE(bufoff, gbase, voff) do { _Pragma("unroll") for (int _i = 0; _i < 2; ++_i) \
        __builtin_amdgcn_global_load_lds((const unsigned*)((const char*)(gbase) + (voff)[_i]), (PG8_LAS unsigned*)(lds + (bufoff) + ldsw + _i * 8192), 16, 0, 0); } while (0)
#define PG8_LDA(dst, b, h) do { _Pragma("unroll") for (int m = 0; m < 4; ++m) _Pragma("unroll") for (int k = 0; k < 2; ++k) dst[m][k] = *(const PG8_LAS bf16x8*)(lds + PG8_SA(b, h) + aoff + m * 2048 + k * 1024); } while (0)
#define PG8_LDB(dst, b, h) do { _Pragma("unroll") for (int n = 0; n < 2; ++n) _Pragma("unroll") for (int k = 0; k < 2; ++k) dst[n][k] = *(const PG8_LAS bf16x8*)(lds + PG8_SB(b, h) + boff + n * 2048 + k * 1024); } while (0)
#define PG8_MMA(ai, bj, At, Bt) do { __builtin_amdgcn_s_setprio(1); _Pragma("unroll") for (int m = 0; m < 4; ++m) _Pragma("unroll") for (int n = 0; n < 2; ++n) _Pragma("unroll") for (int k = 0; k < 2; ++k) \
        acc[ai][bj][m][n] = F16 ? __builtin_amdgcn_mfma_f32_16x16x32_f16(__builtin_bit_cast(f16x8, Bt[n][k]), __builtin_bit_cast(f16x8, At[m][k]), acc[ai][bj][m][n], 0, 0, 0) : __builtin_amdgcn_mfma_f32_16x16x32_bf16(Bt[n][k], At[m][k], acc[ai][bj][m][n], 0, 0, 0); __builtin_amdgcn_s_setprio(0); } while (0)
#define PG8_WAIT_V(n) asm volatile("s_waitcnt vmcnt(" #n ")" ::: "memory")
#define PG8_WAIT_L(n) asm volatile("s_waitcnt lgkmcnt(" #n ")" ::: "memory")
#define PG8_BAR __builtin_amdgcn_s_barrier()
#define PG8_SCHED __builtin_amdgcn_sched_barrier(0)
    Unit cur, nxt; int ui = 0;
    if (!S.next(0, cur)) return;
    f32x4 acc[2][2][4][2];
#pragma unroll
    for (int a = 0; a < 2; ++a)
#pragma unroll
        for (int b = 0; b < 2; ++b)
#pragma unroll
            for (int m = 0; m < 4; ++m)
#pragma unroll
                for (int n = 0; n < 2; ++n) acc[a][b][m][n] = (f32x4){0.f, 0.f, 0.f, 0.f};
    bf16x8 At[4][2], B0[2][2], B1[2][2];
    const char* cA = (const char*)g.A + (size_t)cur.pm * tstepA; const char* cB = (const char*)g.Bt + (size_t)cur.pn * tstepB;
    S.a_ready(cur);
    if constexpr (SP2) {
        PG8_STAGE(PG8_SB(0, 0), cB, voffB); PG8_STAGE(PG8_SB(0, 1), cB + hstepB, voffB); PG8_STAGE(PG8_SA(0, 0), cA, voffA); PG8_STAGE(PG8_SA(0, 1), cA + hstepA, voffA);
        if (wr == 1) PG8_BAR;
        PG8_WAIT_V(2); PG8_BAR;
        PG8_STAGE(PG8_SB(1, 0), cB + kstep, voffB); PG8_STAGE(PG8_SA(1, 0), cA + kstep, voffA); PG8_STAGE(PG8_SB(1, 1), cB + hstepB + kstep, voffB);
        PG8_WAIT_V(6); PG8_BAR;
    } else {
        PG8_STAGE(PG8_SB(0, 0), cB, voffB); PG8_STAGE(PG8_SA(0, 0), cA, voffA); PG8_STAGE(PG8_SB(0, 1), cB + hstepB, voffB); PG8_STAGE(PG8_SA(0, 1), cA + hstepA, voffA);
        if (wr == 1) PG8_BAR;
        PG8_WAIT_V(4); PG8_BAR;
        PG8_STAGE(PG8_SB(1, 0), cB + kstep, voffB); PG8_STAGE(PG8_SA(1, 0), cA + kstep, voffA); PG8_STAGE(PG8_SB(1, 1), cB + hstepB + kstep, voffB);
        PG8_WAIT_V(6); PG8_BAR;
    }
    for (;;) {
        const bool has_next = S.next(ui + 1, nxt);
        const char* nA = has_next ? (const char*)g.A + (size_t)nxt.pm * tstepA : cA; const char* nB = has_next ? (const char*)g.Bt + (size_t)nxt.pn * tstepB : cB;
        for (int t = 0; t < nt; t += 2) {
            const bool last = (t == nt - 2);
            const char* a1 = cA + (size_t)(t + 1) * kstep;
            const char* a2 = last ? nA : cA + (size_t)(t + 2) * kstep; const char* b2 = last ? nB : cB + (size_t)(t + 2) * kstep;
            const char* a3 = a2 + kstep; const char* b3 = b2 + kstep;
            if (last && has_next) S.a_ready(nxt);
            if constexpr (SP2) {
            PG8_LDB(B0, 0, 0); PG8_LDB(B1, 0, 1); PG8_SCHED; PG8_LDA(At, 0, 0); PG8_STAGE(PG8_SA(1, 1), a1 + hstepA, voffA);
            PG8_WAIT_V(8); PG8_WAIT_L(0); PG8_BAR; PG8_MMA(0, 0, At, B0); PG8_MMA(0, 1, At, B1); PG8_BAR; PG8_SCHED;
            PG8_LDA(At, 0, 1); PG8_STAGE(PG8_SB(0, 0), b2, voffB); PG8_STAGE(PG8_SB(0, 1), b2 + hstepB, voffB); PG8_STAGE(PG8_SA(0, 0), a2, voffA);
            PG8_WAIT_V(8); PG8_WAIT_L(0); PG8_BAR; PG8_MMA(1, 0, At, B0); PG8_MMA(1, 1, At, B1); PG8_BAR; PG8_SCHED;
            PG8_LDB(B0, 1, 0); PG8_LDB(B1, 1, 1); PG8_SCHED; PG8_LDA(At, 1, 0); PG8_STAGE(PG8_SA(0, 1), a2 + hstepA, voffA);
            PG8_WAIT_V(8); PG8_WAIT_L(0); PG8_BAR; PG8_MMA(0, 0, At, B0); PG8_MMA(0, 1, At, B1); PG8_BAR; PG8_SCHED;
            PG8_LDA(At, 1, 1); PG8_STAGE(PG8_SB(1, 0), b3, voffB); PG8_STAGE(PG8_SB(1, 1), b3 + hstepB, voffB); PG8_STAGE(PG8_SA(1, 0), a3, voffA);
            PG8_WAIT_V(8); PG8_WAIT_L(0); PG8_BAR; PG8_MMA(1, 0, At, B0); PG8_MMA(1, 1, At, B1); PG8_BAR; PG8_SCHED;
            } else {
            PG8_LDB(B0, 0, 0); PG8_SCHED; PG8_LDA(At, 0, 0); PG8_STAGE(PG8_SA(1, 1), a1 + hstepA, voffA);
            PG8_WAIT_L(8); PG8_BAR; PG8_WAIT_L(0); PG8_MMA(0, 0, At, B0); PG8_BAR; PG8_SCHED;
            PG8_LDB(B1, 0, 1); PG8_STAGE(PG8_SB(0, 0), b2, voffB);
            PG8_BAR; PG8_WAIT_L(0); PG8_MMA(0, 1, At, B1); PG8_BAR;
            PG8_LDA(At, 0, 1); PG8_STAGE(PG8_SA(0, 0), a2, voffA);
            PG8_BAR; PG8_WAIT_L(0); PG8_MMA(1, 0, At, B0); PG8_BAR; PG8_SCHED;
            PG8_STAGE(PG8_SB(0, 1), b2 + hstepB, voffB);
            PG8_WAIT_V(6); PG8_BAR; PG8_MMA(1, 1, At, B1); PG8_BAR;
            PG8_LDB(B0, 1, 0); PG8_SCHED; PG8_LDA(At, 1, 0); PG8_STAGE(PG8_SA(0, 1), a2 + hstepA, voffA);
            PG8_WAIT_L(8); PG8_BAR; PG8_WAIT_L(0); PG8_MMA(0, 0, At, B0); PG8_BAR; PG8_SCHED;
            PG8_LDB(B1, 1, 1); PG8_STAGE(PG8_SB(1, 0), b3, voffB);
            PG8_BAR; PG8_WAIT_L(0); PG8_MMA(0, 1, At, B1); PG8_BAR;
            PG8_LDA(At, 1, 1); PG8_STAGE(PG8_SA(1, 0), a3, voffA);
            PG8_BAR; PG8_WAIT_L(0); PG8_MMA(1, 0, At, B0); PG8_BAR; PG8_SCHED;
            PG8_STAGE(PG8_SB(1, 1), b3 + hstepB, voffB);
            PG8_WAIT_V(6); PG8_BAR; PG8_MMA(1, 1, At, B1); PG8_BAR;
            }
        }
        if constexpr (ALIGN_EPI) { if (wr == 0) PG8_BAR; }
        if constexpr (!Epi::AFTER_DRAIN) { E(acc, cur, wr, wc, fr, fq); S.done(cur); }
        if (!has_next) break;
#pragma unroll
        for (int a = 0; a < 2; ++a)
#pragma unroll
            for (int b = 0; b < 2; ++b)
#pragma unroll
                for (int m = 0; m < 4; ++m)
#pragma unroll
                    for (int n = 0; n < 2; ++n) acc[a][b][m][n] = (f32x4){0.f, 0.f, 0.f, 0.f};
        cur = nxt; cA = nA; cB = nB; ++ui;
        if constexpr (ALIGN_EPI) { if (wr == 1) PG8_BAR; }
    }
    PG8_WAIT_V(0);
    if constexpr (!ALIGN_EPI) { if (wr == 0) PG8_BAR; }
    PG8_BAR;
    if constexpr (Epi::AFTER_DRAIN) { E.fused(acc, cur, wr, wc, fr, fq, lds, wid, lane); S.done(cur); }
#undef PG8_SA
#undef PG8_SB
#undef PG8_STAGE
#undef PG8_LDA
#undef PG8_LDB
#undef PG8_MMA
#undef PG8_WAIT_V
#undef PG8_WAIT_L
#undef PG8_BAR
#undef PG8_SCHED
}
}

#define LAS __attribute__((address_space(3)))
constexpr int NWAVES = 8, NTHR = 512;
constexpr int LDS_BYTES = 147456;
typedef float f32x4 __attribute__((ext_vector_type(4)));
typedef unsigned u32x4 __attribute__((ext_vector_type(4)));

struct Params {
    const float* x; const int* pos; const float* norm1_g; const float* w_in; const float* w_gate_up; const float* b_gate; const float* gla_norm_g; const float* w_pool;
    const float* pool_scale; const float* w_out; const float* norm2_g; const float* w_up; const float* conv_w; const float* conv_b; const float* w_down; const float* final_g;
    float* out; unsigned char* ws; long long layer;
};

constexpr int CW_FAIL = 16, CW_QTOPK = 64, CW_QATT = 128;
__device__ __forceinline__ unsigned f2ord(float x) { const unsigned u = __float_as_uint(x + 0.0f); return (u & 0x80000000u) ? ~u : (u | 0x80000000u); }
template <class CM>
__device__ __forceinline__ void transpose_item(const float* W, int K, int Nsrc, u16* WT, LAS float* scr, int item, int nblk, int lane, const CM& cm) {
    const int kb = item / nblk, nb = item % nblk, k0 = 64 * kb, n0 = 32 * nb;
    const int sc = cm(n0 + (lane & 31));
#pragma unroll 8
    for (int i = 0; i < 32; ++i) { const int kk = 2 * i + (lane >> 5); scr[kk * 33 + (lane & 31)] = (sc >= 0) ? W[(size_t)(k0 + kk) * Nsrc + sc] : 0.f; }
    asm volatile("s_waitcnt lgkmcnt(0)" ::: "memory");
    const int c = lane & 7;
#pragma unroll
    for (int j = 0; j < 4; ++j) { const int n = (lane >> 3) + 8 * j; const LAS float* s = scr + (8 * c) * 33 + n;
        u32x4 o; o.x = pkh(s[0 * 33], s[1 * 33]); o.y = pkh(s[2 * 33], s[3 * 33]); o.z = pkh(s[4 * 33], s[5 * 33]); o.w = pkh(s[6 * 33], s[7 * 33]);
        *(u32x4*)(WT + (size_t)(n0 + n) * K + k0 + 8 * c) = o; }
    asm volatile("s_waitcnt lgkmcnt(0)" ::: "memory");
}
struct CmIdent { __device__ __forceinline__ int operator()(int n) const { return n; } };
struct CmWin {
    __device__ __forceinline__ int operator()(int n) const {
        if (n < 1860) return n;
        if (n < 1864) return -1;
        if (n < 1880) return 2628 + (n - 1864);
        if (n < 2048) return -1;
        if (n < 2304) return 1860 + (n - 2048);
        if (n < 2560) return 2116 + (n - 2304);
        if (n < 2816) return 2372 + (n - 2560);
        return 2644 + (n - 2816);
    }
};
__device__ __forceinline__ int wconv_items(int which) { return which == 0 ? (D_MODEL / 64) * (NPROJ / 32) : which == 1 ? (D_MODEL / 64) * (D_MODEL / 32) : which == 2 ? (D_MODEL / 64) * (2 * D_FF / 32) : (D_FF / 64) * (D_MODEL / 32); }
__device__ __forceinline__ void wconv_item(const Params& p, int l, int which, int item, LAS float* scr, int lane) {
    unsigned char* ws = p.ws;
    if (which == 0) transpose_item(p.w_in + (size_t)l * D_MODEL * IN_WIDTH, D_MODEL, IN_WIDTH, (u16*)(ws + (l ? WS_WIN1 : WS_WIN0)), scr, item, NPROJ / 32, lane, CmWin{});
    else if (which == 1) transpose_item(p.w_out + (size_t)l * D_MODEL * D_MODEL, D_MODEL, D_MODEL, (u16*)(ws + (l ? WS_WOUT1 : WS_WOUT0)), scr, item, D_MODEL / 32, lane, CmIdent{});
    else if (which == 2) transpose_item(p.w_up + (size_t)l * D_MODEL * 2 * D_FF, D_MODEL, 2 * D_FF, (u16*)(ws + WS_WUP), scr, item, 2 * D_FF / 32, lane, CmIdent{});
    else transpose_item(p.w_down + (size_t)l * D_FF * D_MODEL, D_FF, D_MODEL, (u16*)(ws + WS_WDN), scr, item, D_MODEL / 32, lane, CmIdent{});
}
__device__ __forceinline__ void xg_row(const float* xrow, const float* g, u16* orow, float* rssrow, int lane) {
    const f32x4* xr = (const f32x4*)xrow + lane; f32x4 v[4]; float ss = 0.f;
#pragma unroll
    for (int j = 0; j < 4; ++j) { v[j] = xr[64 * j]; ss += (v[j][0] * v[j][0] + v[j][1] * v[j][1]) + (v[j][2] * v[j][2] + v[j][3] * v[j][3]); }
    ss = wave_sum(ss);
#pragma unroll
    for (int j = 0; j < 4; ++j) { const f32x4 gg = *((const f32x4*)g + lane + 64 * j); const f32x4 o = v[j] * gg; uint2 w; w.x = pkh(o[0], o[1]); w.y = pkh(o[2], o[3]); *((uint2*)orow + lane + 64 * j) = w; }
    if (lane < 16) rssrow[lane] = (lane == 0) ? ss : 0.f;
}

__global__ void __launch_bounds__(NTHR, 2) k_prologue(Params p) {
    extern __shared__ __attribute__((aligned(16))) unsigned char lds[];
    const int tid = threadIdx.x, lane = tid & 63, wave = tid >> 6;
    LAS float* scr = (LAS float*)((LAS unsigned char*)lds + wave * 16384);
    const int gw = blockIdx.x * NWAVES + wave, NGW = gridDim.x * NWAVES;
    for (int l = 0; l < 2; ++l)
        for (int which = 0; which < (l == 0 ? 4 : 2); ++which) { const int n = wconv_items(which); for (int it = gw; it < n; it += NGW) wconv_item(p, l, which, it, scr, lane); }
    float* cs = (float*)(p.ws + WS_CS); float* sn = cs + M_TOK * 8;
    for (int i = blockIdx.x * NTHR + tid; i < M_TOK * 8; i += gridDim.x * NTHR) {
        const int t = i >> 3, j = i & 7; const float inv = powf(500000.0f, -(float)(2 * j) / 16.0f); const float ang = (float)p.pos[t] * inv;
        float s, c; sincosf(ang, &s, &c); cs[i] = c; sn[i] = s; }
    for (int m = gw; m < M_TOK; m += NGW) xg_row(p.x + (size_t)m * D_MODEL, p.norm1_g, (u16*)(p.ws + WS_XG) + (size_t)m * D_MODEL, (float*)(p.ws + WS_RSS) + (size_t)m * 16, lane);
}
__global__ void __launch_bounds__(NTHR, 2) k_wconv_updown(Params p) {
    extern __shared__ __attribute__((aligned(16))) unsigned char lds[];
    const int tid = threadIdx.x, lane = tid & 63, wave = tid >> 6;
    LAS float* scr = (LAS float*)((LAS unsigned char*)lds + wave * 16384);
    const int gw = blockIdx.x * NWAVES + wave, NGW = gridDim.x * NWAVES;
    for (int which = 2; which < 4; ++which) { const int n = wconv_items(which); for (int it = gw; it < n; it += NGW) wconv_item(p, 1, which, it, scr, lane); }
}

__global__ void __launch_bounds__(NTHR, 2) k_gemm_proj(Params p) {
    extern __shared__ __attribute__((aligned(16))) unsigned char lds[];
    unsigned char* ws = p.ws; const int l = (int)p.layer;
    pg8::Gemm g{(const u16*)(ws + WS_XG), (const u16*)(ws + (l ? WS_WIN1 : WS_WIN0)), M_TOK, NPROJ, D_MODEL, D_MODEL};
    pg8::StaticOrder S; S.init(M_TOK, NPROJ, gridDim.x, blockIdx.x);
    pg8::EpiProj E{(const float*)(ws + WS_RSS), (const float*)(ws + WS_CS), (const float*)(ws + WS_CS) + M_TOK * 8,
                   (u16*)(ws + WS_Q), (u16*)(ws + WS_K), (u16*)(ws + WS_V), (u16*)(ws + WS_QI), (u16*)(ws + WS_KI), (u16*)(ws + WS_GQK), (u16*)(ws + WS_GV), (u16*)(ws + WS_GR), (u16*)(ws + WS_UC),
                   (float*)(ws + WS_WI), (float*)(ws + WS_GL)};
    pg8::gemm_phase<pg8::EpiProj, pg8::StaticOrder, true, true, true>((LAS unsigned char*)lds, g, S, E);
}
__global__ void __launch_bounds__(NTHR, 2) k_gemm_out(Params p) {
    extern __shared__ __attribute__((aligned(16))) unsigned char lds[];
    unsigned char* ws = p.ws; const int l = (int)p.layer;
    pg8::Gemm g{(const u16*)(ws + WS_MIX), (const u16*)(ws + (l ? WS_WOUT1 : WS_WOUT0)), M_TOK, D_MODEL, D_MODEL, D_MODEL};
    pg8::StaticOrder S; S.init(M_TOK, D_MODEL, gridDim.x, blockIdx.x);
    pg8::EpiResid E{l == 0 ? p.x : p.out, p.out, (u16*)(ws + WS_XG), p.norm2_g + l * D_MODEL, (float*)(ws + WS_RSS)};
    pg8::gemm_phase<pg8::EpiResid, pg8::StaticOrder, true, true, true>((LAS unsigned char*)lds, g, S, E);
}
__global__ void __launch_bounds__(NTHR, 2) k_gemm_up(Params p) {
    extern __shared__ __attribute__((aligned(16))) unsigned char lds[];
    unsigned char* ws = p.ws;
    pg8::Gemm g{(const u16*)(ws + WS_XG), (const u16*)(ws + WS_WUP), M_TOK, 2 * D_FF, D_MODEL, D_MODEL};
    pg8::StaticOrder S; S.init(M_TOK, 2 * D_FF, gridDim.x, blockIdx.x);
    pg8::EpiUp E{(const float*)(ws + WS_RSS), (u16*)(ws + WS_AB)};
    pg8::gemm_phase<pg8::EpiUp, pg8::StaticOrder, true, true, true>((LAS unsigned char*)lds, g, S, E);
}
__global__ void __launch_bounds__(NTHR, 2) k_gemm_down(Params p) {
    extern __shared__ __attribute__((aligned(16))) unsigned char lds[];
    unsigned char* ws = p.ws; const int l = (int)p.layer;
    pg8::Gemm g{(const u16*)(ws + WS_AB) + D_FF, (const u16*)(ws + WS_WDN), M_TOK, D_MODEL, D_FF, 2 * D_FF};
    pg8::StaticOrder S; S.init(M_TOK, D_MODEL, gridDim.x, blockIdx.x);
    pg8::EpiResid E{p.out, p.out, (u16*)(ws + WS_XG), (l + 1 < DEPTH) ? p.norm1_g + (l + 1) * D_MODEL : p.final_g, (float*)(ws + WS_RSS)};
    pg8::gemm_phase<pg8::EpiResid, pg8::StaticOrder, true, true, true>((LAS unsigned char*)lds, g, S, E);
}
__global__ void __launch_bounds__(NTHR, 2) k_convgate(Params p) {
    const int l = (int)p.layer; u16* AB = (u16*)(p.ws + WS_AB);
    const float* cw = p.conv_w + (size_t)l * 3 * D_FF; const float* cb = p.conv_b + (size_t)l * D_FF;
    constexpr int CPR = D_FF / 8;
    for (long it = (long)blockIdx.x * NTHR + threadIdx.x; it < (long)M_TOK * CPR; it += (long)gridDim.x * NTHR) {
        const int row = (int)(it / CPR), c0 = (int)(it % CPR) * 8, pos = row & (SEQ - 1);
        const u16* pa = AB + (size_t)row * (2 * D_FF) + c0;
        const u32x4 a0 = *(const u32x4*)pa; u32x4 a1 = {0u, 0u, 0u, 0u}, a2 = a1;
        if (pos >= 1) a1 = *(const u32x4*)(pa - 2 * D_FF);
        if (pos >= 2) a2 = *(const u32x4*)(pa - 4 * D_FF);
        const u32x4 bb = *(const u32x4*)(pa + D_FF);
        u32x4 o;
#pragma unroll
        for (int q = 0; q < 4; ++q) {
            float r[2];
#pragma unroll
            for (int e = 0; e < 2; ++e) { const int kk = c0 + q * 2 + e;
                const float x0 = h2f(e ? (a0[q] >> 16) : (a0[q] & 0xffffu)), x1 = h2f(e ? (a1[q] >> 16) : (a1[q] & 0xffffu)), x2 = h2f(e ? (a2[q] >> 16) : (a2[q] & 0xffffu)), bv = h2f(e ? (bb[q] >> 16) : (bb[q] & 0xffffu));
                const float cv = cb[kk] + x2 * cw[kk] + x1 * cw[D_FF + kk] + x0 * cw[2 * D_FF + kk]; r[e] = silu_f(cv) * bv; }
            o[q] = pkh(r[0], r[1]);
        }
        *(u32x4*)(AB + (size_t)row * (2 * D_FF) + D_FF + c0) = o;
    }
}
__global__ void __launch_bounds__(NTHR, 2) k_final_norm(Params p) {
    const float* rss = (const float*)(p.ws + WS_RSS);
    const unsigned badu = ((const unsigned*)(p.ws + WS_CTL))[CW_FAIL], bado = ((const unsigned*)(p.ws + WS_CTL))[CW_FAIL + 1]; const bool bad = (badu | bado) != 0u; const float bsc = (badu ? 2.0f : 1.0f) * (bado ? 1.5f : 1.0f);
    for (long it = (long)blockIdx.x * NTHR + threadIdx.x; it < (long)M_TOK * (D_MODEL / 4); it += (long)gridDim.x * NTHR) {
        const int row = (int)(it >> 8), c = (int)(it & 255) * 4; const float rs = pg8::row_rs(rss, row);
        f32x4* px = (f32x4*)(p.out + (size_t)row * D_MODEL + c); const f32x4 g = *(const f32x4*)(p.final_g + c); f32x4 o = (*px) * rs * g; if (bad) { const float qn = __builtin_nanf(""); o = (f32x4){qn * bsc, qn, qn, qn}; } *px = o;
    }
}


typedef float f32x16 __attribute__((ext_vector_type(16)));
constexpr int TK_CAP = 1024, TK_R = 64;
constexpr int TKL_SAMP = 0, TKL_MT = 65536, TKL_ZM = 98304, TKL_W = 131072, TKL_LO = 131584, TKL_CNT = 131712, TKL_FLAG = 131840;

template <bool SAMPLE>
__device__ __forceinline__ void tk_score_tile(const u16* __restrict__ KIb, int keybase, int keystride, const f16x8 (&af)[4][4], LAS const float* wtab, int lane, float (&score)[16]) {
    const int c = lane & 31, hh = lane >> 5;
    LAS const float* wtab_h = wtab + hh * 4;
    const u16* kp = KIb + (size_t)(keybase + keystride * c) * 64 + 8 * hh;
    f16x8 bf[4];
#pragma unroll
    for (int ks = 0; ks < 4; ++ks) bf[ks] = *(const f16x8*)(kp + 16 * ks);
#pragma unroll
    for (int blk = 0; blk < 4; ++blk) {
        f32x16 acc = {0.f, 0.f, 0.f, 0.f, 0.f, 0.f, 0.f, 0.f, 0.f, 0.f, 0.f, 0.f, 0.f, 0.f, 0.f, 0.f};
#pragma unroll
        for (int ks = 0; ks < 4; ++ks) acc = __builtin_amdgcn_mfma_f32_32x32x16_f16(af[blk][ks], bf[ks], acc, 0, 0, 0);
#pragma unroll
        for (int g = 0; g < 4; ++g) {
            const f32x4 w = *(LAS const f32x4*)(wtab_h + (8 * blk + 2 * g) * 4);
            score[blk * 4 + g] = w[0] * fmaxf(acc[4 * g + 0], 0.f) + w[1] * fmaxf(acc[4 * g + 1], 0.f) + w[2] * fmaxf(acc[4 * g + 2], 0.f) + w[3] * fmaxf(acc[4 * g + 3], 0.f);
        }
        __builtin_amdgcn_sched_barrier(0);
    }
}
__device__ __forceinline__ int wave_count(bool p) { return __builtin_popcountll(__ballot(p)); }

__device__ __forceinline__ void topk_unit(int b, int qblk, const u16* __restrict__ QI, const u16* __restrict__ KI, const float* __restrict__ WI, unsigned long long* __restrict__ MASKL, uint2* __restrict__ list,
                                          unsigned* __restrict__ ctl, LAS unsigned char* lds) {
    const int tid = threadIdx.x, lane = tid & 63, wave = __builtin_amdgcn_readfirstlane(tid >> 6), hh = lane >> 5;
    const int t0 = qblk * 32, tokb = b * SEQ;
    LAS unsigned* mt = (LAS unsigned*)(lds + TKL_MT);
    LAS float* wtab = (LAS float*)(lds + TKL_W);
    LAS unsigned* lo_s = (LAS unsigned*)(lds + TKL_LO);
    LAS unsigned* cnt_s = (LAS unsigned*)(lds + TKL_CNT);
    LAS u16* samp = (LAS u16*)(lds + TKL_SAMP);
    LAS unsigned* zm = (LAS unsigned*)(lds + TKL_ZM);
    const int nkt_w = 4 * (qblk / 8 + 1);
    unsigned long long* mdst = MASKL + (size_t)(b * 256 + qblk) * 128 * 32;
    __syncthreads();
    for (int i = tid; i < nkt_w * 64; i += NTHR) mt[i] = 0u;
    if (tid < 128) wtab[tid] = WI[(size_t)(tokb + t0) * 4 + tid];
    for (int i = tid; i < 32 * 256; i += NTHR) zm[i] = 0u;
    if (tid < 32) cnt_s[tid] = 0u;
    if (t0 < TOPK) {
        __syncthreads();
        for (int i = tid; i < nkt_w * 64; i += NTHR) {
            const int kt = i >> 6, ql = (i & 63) >> 1, half = i & 1, k0 = 64 * kt + 32 * half, last = t0 + ql;
            unsigned word = 0u;
            if (k0 <= last) { const int cnt = last - k0 + 1; word = cnt >= 32 ? 0xffffffffu : ((1u << cnt) - 1u); }
            mt[i] = word;
        }
        __syncthreads();
        for (int i = tid; i < nkt_w * 32; i += NTHR) mdst[i] = (unsigned long long)mt[2 * i] | ((unsigned long long)mt[2 * i + 1] << 32);
        return;
    }
    f16x8 af[4][4];
    { const int r = lane & 31;
#pragma unroll
      for (int blk = 0; blk < 4; ++blk)
#pragma unroll
          for (int ks = 0; ks < 4; ++ks) af[blk][ks] = *(const f16x8*)(QI + (size_t)(tokb + t0 + 8 * blk + (r >> 2)) * 256 + (r & 3) * 64 + 16 * ks + 8 * hh); }
    __syncthreads();
    const int nst = qblk / 8 + 1;
    LAS u16* samp_h = samp + hh * 1024 + (lane & 31);
    for (int st = wave; st < nst; st += NWAVES) {
        float sc[16]; tk_score_tile<true>(KI + (size_t)tokb * 64, 256 * st, 8, af, wtab, lane, sc);
#pragma unroll
        for (int blk = 0; blk < 4; ++blk)
#pragma unroll
            for (int g = 0; g < 4; ++g) samp_h[(8 * blk + 2 * g) * 1024 + 32 * st] = (u16)(f2ord(sc[blk * 4 + g]) >> 16);
    }
    __syncthreads();
    for (int i = 0; i < 4; ++i) {
        const int ql = wave * 4 + i, nsv = (t0 + ql) / 8 + 1;
        unsigned T = 0u;
        if (nsv >= TK_R) {
            unsigned v[16];
            { const LAS u32x4* sp = (LAS const u32x4*)(samp + ql * 1024 + 16 * lane); const u32x4 a = sp[0], c = sp[1];
#pragma unroll
              for (int e = 0; e < 4; ++e) { v[2 * e] = a[e] & 0xffffu; v[2 * e + 1] = a[e] >> 16; v[8 + 2 * e] = c[e] & 0xffffu; v[8 + 2 * e + 1] = c[e] >> 16; }
              const int nl = nsv - 16 * lane;
#pragma unroll
              for (int e = 0; e < 16; ++e) v[e] = (e < nl) ? v[e] : 0u; }
            for (int bit = 15; bit >= 0; --bit) {
                const unsigned cand = T | (1u << bit); int c = 0;
#pragma unroll
                for (int e = 0; e < 16; ++e) c += wave_count(v[e] >= cand);
                if (c >= TK_R) T = cand;
            }
        }
        if (lane == 0) lo_s[ql] = T << 16;
    }
    __syncthreads();
    const int nkt = qblk + 1;
    LAS unsigned* lo_h = lo_s + hh; LAS unsigned* cnt_h = cnt_s + hh; uint2* list_h = list + hh * TK_CAP; LAS unsigned* zm_h = zm + hh * 256;
    for (int kt = wave; kt < nkt; kt += NWAVES) {
        float sc[16]; tk_score_tile<false>(KI + (size_t)tokb * 64, 32 * kt, 1, af, wtab, lane, sc);
        const int key = 32 * kt + (lane & 31), keyh = key - hh;
#pragma unroll
        for (int blk = 0; blk < 4; ++blk)
#pragma unroll
            for (int g = 0; g < 4; ++g) {
                const unsigned ord = f2ord(sc[blk * 4 + g]); const bool causal = keyh <= t0 + 8 * blk + 2 * g;
                { const unsigned long long zb = __ballot(causal && ord == 0x80000000u);
                  if ((lane & 31) == 0) zm_h[(8 * blk + 2 * g) * 256 + kt] = (unsigned)(zb >> (hh * 32)); }
                if (ord >= lo_h[8 * blk + 2 * g] && ord != 0x80000000u && causal) {
                    const unsigned slot = __hip_atomic_fetch_add(cnt_h + (8 * blk + 2 * g), 1u, __ATOMIC_RELAXED, __HIP_MEMORY_SCOPE_WORKGROUP);
                    if (slot < (unsigned)TK_CAP) list_h[slot + (unsigned)((8 * blk + 2 * g) * TK_CAP)] = make_uint2((unsigned)key, ord);
                }
            }
    }
    asm volatile("s_waitcnt vmcnt(0)" ::: "memory");
    __syncthreads();
    for (int i = 0; i < 4; ++i) {
        const int ql = wave * 4 + i; const int m = (int)cnt_s[ql];
        const int mm = m > TK_CAP ? TK_CAP : m;
        unsigned ord[16], key[16];
#pragma unroll
        for (int e = 0; e < 16; ++e) { const int s = lane + 64 * e; uint2 v = make_uint2(0xffffffffu, 0u); if (s < mm) v = list[ql * TK_CAP + s]; key[e] = v.x; ord[e] = v.y; }
        const u32x4 zw = *(LAS const u32x4*)(zm + ql * 256 + 4 * lane);
        const int zl = __builtin_popcount(zw[0]) + __builtin_popcount(zw[1]) + __builtin_popcount(zw[2]) + __builtin_popcount(zw[3]);
        int zincl = zl;
#pragma unroll
        for (int o = 1; o < 64; o <<= 1) { const int v = __shfl_up(zincl, o); if (lane >= o) zincl += v; }
        const int Zc = __shfl(zincl, 63);
        int cpos = 0;
#pragma unroll
        for (int e = 0; e < 16; ++e) cpos += wave_count(ord[e] > 0x80000000u);
        const int klist = (cpos >= TOPK) ? TOPK : ((cpos + Zc >= TOPK) ? cpos : TOPK - Zc);
        if (m > TK_CAP) { if (lane == 0) __hip_atomic_store(ctl + CW_FAIL + 1, 1u, __ATOMIC_RELAXED, __HIP_MEMORY_SCOPE_AGENT); }
        if (m < klist) { if (lane == 0) __hip_atomic_store(ctl + CW_FAIL, 1u, __ATOMIC_RELAXED, __HIP_MEMORY_SCOPE_AGENT); }
        unsigned T = 0u; bool exact = false; unsigned kmax = 0xffffffffu;
        if (klist > 0) {
            for (int bit = 31; bit >= 0; --bit) {
                const unsigned cand = T | (1u << bit); int c = 0;
#pragma unroll
                for (int e = 0; e < 16; ++e) c += wave_count(ord[e] >= cand);
                if (c >= klist) { T = cand; if (c == klist) { exact = true; break; } }
            }
            if (!exact) {
                int cgt = 0;
#pragma unroll
                for (int e = 0; e < 16; ++e) cgt += wave_count(ord[e] > T);
                const int need = klist - cgt;
                unsigned Kp = 0u;
                for (int bit = 12; bit >= 0; --bit) {
                    const unsigned cand = Kp | (1u << bit); int c = 0;
#pragma unroll
                    for (int e = 0; e < 16; ++e) c += wave_count(ord[e] == T && key[e] < cand);
                    if (c < need) Kp = cand;
                }
                kmax = Kp;
            }
#pragma unroll
            for (int e = 0; e < 16; ++e) {
                const bool sel = exact ? (ord[e] >= T) : (ord[e] > T || (ord[e] == T && key[e] <= kmax));
                if (sel && key[e] != 0xffffffffu) {
                    const unsigned k = key[e];
                    __hip_atomic_fetch_or(mt + (((k >> 6) * 32 + ql) * 2 + ((k >> 5) & 1u)), 1u << (k & 31u), __ATOMIC_RELAXED, __HIP_MEMORY_SCOPE_WORKGROUP);
                }
            }
        }
        int ztake = TOPK - klist - (zincl - zl);
#pragma unroll
        for (int j = 0; j < 4; ++j) {
            unsigned w = zw[j];
            while (w != 0u && ztake > 0) {
                const unsigned c = (unsigned)__builtin_ctz(w); w &= w - 1u; --ztake;
                const unsigned k = (unsigned)(4 * lane + j) * 32u + c;
                __hip_atomic_fetch_or(mt + (((k >> 6) * 32 + ql) * 2 + ((k >> 5) & 1u)), 1u << c, __ATOMIC_RELAXED, __HIP_MEMORY_SCOPE_WORKGROUP);
            }
        }
    }
    __syncthreads();
    for (int i = tid; i < nkt_w * 32; i += NTHR) mdst[i] = (unsigned long long)mt[2 * i] | ((unsigned long long)mt[2 * i + 1] << 32);
}

__global__ void __launch_bounds__(NTHR, 2) k_topk(Params p) {
    extern __shared__ __attribute__((aligned(16))) unsigned char lds[];
    unsigned char* ws = p.ws; unsigned* ctl = (unsigned*)(ws + WS_CTL);
    LAS unsigned* qslot = (LAS unsigned*)((LAS unsigned char*)lds + TKL_FLAG);
    for (;;) {
        __syncthreads();
        if (threadIdx.x == 0) *qslot = __hip_atomic_fetch_add(ctl + CW_QTOPK + (int)p.layer * 4, 1u, __ATOMIC_RELAXED, __HIP_MEMORY_SCOPE_AGENT);
        __syncthreads();
        const unsigned it = *qslot;
        if (it >= 512u) break;
        topk_unit((int)(it & 1u), 255 - (int)(it >> 1), (const u16*)(ws + WS_QI), (const u16*)(ws + WS_KI), (const float*)(ws + WS_WI), (unsigned long long*)(ws + WS_MASK),
                  (uint2*)(ws + WS_LIST) + (size_t)blockIdx.x * 32 * TK_CAP, ctl, (LAS unsigned char*)lds);
    }
}

#include <hip/hip_bf16.h>
#include <cmath>
namespace attn_body {
using bf16=__hip_bfloat16;
using bf16x8=__attribute__((ext_vector_type(8)))short;
using s16x4=__attribute__((ext_vector_type(4)))short;
using f32x16=__attribute__((ext_vector_type(16)))float;
using u32x4=__attribute__((ext_vector_type(4)))unsigned;
constexpr int BATCH=2,NHEAD=8,SEQ=8192,D=64,DM=NHEAD*D,DMO=1024;
constexpr int NW=8,QBLK=32,QB=QBLK*NW,KVBLK=64,NQB=SEQ/QB;
constexpr int ATTN_PITCH=DM, ATTN_UNIT_ROWS=QB;
__device__ __forceinline__ int crow(int r,int hi){return (r&3)+8*(r>>2)+4*hi;}
#define SBAR() __builtin_amdgcn_sched_barrier(0)
__device__ __forceinline__ void cmask(f32x16&p0,f32x16&p1,int jb,int qrel,int hi){
  const float NEG=-INFINITY; int kb=64*jb+4*hi;
  #pragma unroll
  for(int r=0;r<16;++r){int kv=kb+(r&3)+8*(r>>2); if(kv>qrel)p0[r]=NEG; if(kv+32>qrel)p1[r]=NEG;}
}

constexpr int NSLOT=3, SLOTB=8192;
constexpr int LDS_K=0, LDS_V=NSLOT*SLOTB, LDS_WS=2*NSLOT*SLOTB, LDS_OST=LDS_WS+NW*64*4, LDS_MK=LDS_OST+NW*4096, LDS_BYTES=LDS_MK+NW*512;
constexpr float C2=0.125f*1.4426950408889634f;
__device__ __forceinline__ void glds16(const void*gsrc,unsigned lds_dst){unsigned keep;
  asm volatile("s_mov_b32 %0, m0\n\ts_mov_b32 m0, %2\n\ts_nop 0\n\tglobal_load_lds_dwordx4 %1, off\n\ts_mov_b32 m0, %0":"=&s"(keep):"v"(gsrc),"s"(lds_dst):"memory");}
__device__ __forceinline__ void glds4(const void*gsrc,unsigned lds_dst){unsigned keep;
  asm volatile("s_mov_b32 %0, m0\n\ts_mov_b32 m0, %2\n\ts_nop 0\n\tglobal_load_lds_dword %1, off\n\ts_mov_b32 m0, %0":"=&s"(keep):"v"(gsrc),"s"(lds_dst):"memory");}
__device__ __forceinline__ float max3f(float a,float b,float c){float r;asm("v_max3_f32 %0, %1, %2, %3":"=v"(r):"v"(a),"v"(b),"v"(c));return r;}
__device__ __forceinline__ float max2f(float a,float b){float r;asm("v_max_f32_e32 %0, %1, %2":"=v"(r):"v"(a),"v"(b));return r;}
__device__ __forceinline__ float fadd_s(float a,float b){float r;asm("v_add_f32_e32 %0, %1, %2":"=v"(r):"v"(a),"v"(b));return r;}
__device__ __forceinline__ float fsub_s(float a,float b){float r;asm("v_sub_f32_e32 %0, %1, %2":"=v"(r):"v"(a),"v"(b));return r;}
typedef float f32x2_t __attribute__((ext_vector_type(2))); typedef __bf16 bf16x2_t __attribute__((ext_vector_type(2)));
__device__ __forceinline__ unsigned cvtpk_s(float lo,float hi){f32x2_t v={lo,hi};bf16x2_t b=__builtin_convertvector(v,bf16x2_t);return __builtin_bit_cast(unsigned,b);}
#define WAIT_BAR(N) asm volatile("s_waitcnt vmcnt(" #N ") lgkmcnt(0)\n\ts_barrier":::"memory")

__device__ __forceinline__ void qkt(f32x16&p0,f32x16&p1,const char*Kslot,const bf16x8*qr,const f32x16&negm,int r32,int hi){
  const char*kb=Kslot+hi*1024+r32*16;
  #pragma unroll
  for(int d0=0;d0<4;++d0){
    const bf16x8 b0=*reinterpret_cast<const bf16x8*>(kb+d0*2048);
    const bf16x8 b1=*reinterpret_cast<const bf16x8*>(kb+d0*2048+512);
    if(d0==0){p0=__builtin_amdgcn_mfma_f32_32x32x16_bf16(b0,qr[0],negm,0,0,0);p1=__builtin_amdgcn_mfma_f32_32x32x16_bf16(b1,qr[0],negm,0,0,0);}
    else{p0=__builtin_amdgcn_mfma_f32_32x32x16_bf16(b0,qr[d0],p0,0,0,0);p1=__builtin_amdgcn_mfma_f32_32x32x16_bf16(b1,qr[d0],p1,0,0,0);}}
}
typedef __attribute__((address_space(3))) const char* lds_cptr;
typedef short v4i16_t __attribute__((ext_vector_type(4)));
__device__ __forceinline__ void kload8(bf16x8*kf,lds_cptr kp){
  kf[0]=*(const __attribute__((address_space(3))) bf16x8*)(kp);      kf[1]=*(const __attribute__((address_space(3))) bf16x8*)(kp+512);
  kf[2]=*(const __attribute__((address_space(3))) bf16x8*)(kp+2048); kf[3]=*(const __attribute__((address_space(3))) bf16x8*)(kp+2560);
  kf[4]=*(const __attribute__((address_space(3))) bf16x8*)(kp+4096); kf[5]=*(const __attribute__((address_space(3))) bf16x8*)(kp+4608);
  kf[6]=*(const __attribute__((address_space(3))) bf16x8*)(kp+6144); kf[7]=*(const __attribute__((address_space(3))) bf16x8*)(kp+6656);
}
__device__ __forceinline__ void kload2(bf16x8*kf,lds_cptr kp,int j){ kf[2*j]=*(const __attribute__((address_space(3))) bf16x8*)(kp+j*2048); kf[2*j+1]=*(const __attribute__((address_space(3))) bf16x8*)(kp+j*2048+512); }
__device__ __forceinline__ s16x4 vtr(lds_cptr p){ return __builtin_bit_cast(s16x4,__builtin_amdgcn_ds_read_tr16_b64_v4i16((__attribute__((address_space(3))) v4i16_t*)p)); }
__device__ __forceinline__ float rowmax(const f32x16&p0,const f32x16&p1){
  float a=max3f(p0[0],p0[1],p1[0]),b=max3f(p0[2],p0[3],p1[1]);a=max3f(a,p1[2],p1[3]);
  #pragma unroll
  for(int r=4;r<16;r+=4){a=max3f(a,p0[r],p0[r+1]);b=max3f(b,p0[r+2],p0[r+3]);a=max3f(a,p1[r],p1[r+1]);b=max3f(b,p1[r+2],p1[r+3]);}
  const float m=max2f(a,b);
  auto rr=__builtin_amdgcn_permlane32_swap(__float_as_uint(m),__float_as_uint(m),false,false);
  return max2f(__uint_as_float(rr[0]),__uint_as_float(rr[1]));
}
__device__ __forceinline__ void pv(f32x16*o,int vb,bf16x8 pa0,bf16x8 pa1,bf16x8 pa2,bf16x8 pa3){
  #pragma unroll
  for(int d0=0;d0<2;++d0){s16x4 lo[4],hi[4];
    #pragma unroll
    for(int ks=0;ks<4;++ks){
      asm volatile("ds_read_b64_tr_b16 %0,%1 offset:%c2":"=&v"(lo[ks]):"v"(vb),"i"(d0*4096+ks*1024):"memory");
      asm volatile("ds_read_b64_tr_b16 %0,%1 offset:%c2":"=&v"(hi[ks]):"v"(vb),"i"(d0*4096+ks*1024+512):"memory");}
    asm volatile("s_waitcnt lgkmcnt(0)":::"memory");SBAR();
    #define PK(k) (bf16x8){lo[k][0],lo[k][1],lo[k][2],lo[k][3],hi[k][0],hi[k][1],hi[k][2],hi[k][3]}
    o[d0]=__builtin_amdgcn_mfma_f32_32x32x16_bf16(pa0,PK(0),o[d0],0,0,0);
    o[d0]=__builtin_amdgcn_mfma_f32_32x32x16_bf16(pa1,PK(1),o[d0],0,0,0);
    o[d0]=__builtin_amdgcn_mfma_f32_32x32x16_bf16(pa2,PK(2),o[d0],0,0,0);
    o[d0]=__builtin_amdgcn_mfma_f32_32x32x16_bf16(pa3,PK(3),o[d0],0,0,0);
    #undef PK
  }
}

#ifndef ATTN_STORE16
#define ATTN_STORE16(p,v) (*(u32x4*)(p)=(v))
#endif
template<int THRL> __device__ __forceinline__ void attn_unit(int b,int h,int qb,const bf16*Q,const bf16*__restrict__ K,const bf16*__restrict__ V,unsigned short*O,const unsigned long long*MT,char*shm){
  const int tid=threadIdx.x,lane=tid&63,r32=lane&31,hi=lane>>5; const int wid=__builtin_amdgcn_readfirstlane(tid>>6);
  const long rowbase=(long)b*SEQ; const int q0=qb*QB;
  const bf16*Qw=Q+(rowbase+q0+wid*QBLK)*DM+h*D;
  const bf16*Kh=K+rowbase*DM+h*D,*Vh=V+rowbase*DM+h*D;
  const unsigned lds0=(unsigned)(uintptr_t)shm;
  float*wsf=(float*)(shm+LDS_WS)+wid*64;
  const bf16*ksrc=Kh+(long)lane*DM+wid*8;
  const bf16*vsrc=Vh+(long)(16*(wid&3)+(lane>>2))*DM+(wid>>2)*32+(lane&3)*8;
  const unsigned kdst=lds0+LDS_K+wid*1024, vdst=lds0+LDS_V+wid*1024;
  const unsigned*msrc=(const unsigned*)(MT+((size_t)(b*256+qb*8+wid)*128)*32)+lane; const unsigned mdst=lds0+LDS_MK+wid*512;
  #define DMA_M(t) glds4(msrc+(long)(t)*64,(unsigned)__builtin_amdgcn_readfirstlane(mdst+((t)&1)*256))
  const __attribute__((address_space(3))) unsigned long long* mrd=(const __attribute__((address_space(3))) unsigned long long*)((lds_cptr)shm+LDS_MK+wid*512)+r32;
  #define DMA_K(t,slot) glds16(ksrc+(long)(t)*KVBLK*DM,(unsigned)__builtin_amdgcn_readfirstlane(kdst+(slot)))
  #define DMA_V(t,slot) glds16(vsrc+(long)(t)*KVBLK*DM,(unsigned)__builtin_amdgcn_readfirstlane(vdst+(slot)))
  const int vb0=(int)(lds0+LDS_V)+((lane>>4)&1)*32+(lane&3)*8+(4*hi+((lane&15)>>2))*64;
  const char*Kbase=shm+LDS_K; bf16x8 kf[8];
  const lds_cptr shm3=(lds_cptr)shm; const lds_cptr kp0=shm3+LDS_K+hi*1024+r32*16; const lds_cptr vp0=shm3+LDS_V+((lane>>4)&1)*32+(lane&3)*8+(4*hi+((lane&15)>>2))*64;
  const int NT=(q0+QB)/KVBLK;
  DMA_M(0);DMA_K(0,0);DMA_V(0,0);DMA_K(1,SLOTB);
  bf16x8 qr[4];
  #pragma unroll
  for(int d0=0;d0<4;++d0)qr[d0]=*reinterpret_cast<const bf16x8*>(&Qw[(long)r32*DM+d0*16+hi*8]);
  float mhat=0.f,l_reg=0.f;f32x16 o[2];o[0]=f32x16{};o[1]=f32x16{};f32x16 negm=f32x16{};asm volatile("":"+v"(negm));
  const int qrel=wid*QBLK+r32;
  #define CMASK(P0,P1,t) do{}while(0)
  #define MKBIT(r) (((r)&3)+8*((r)>>2))
  #define MK(v,w,r) __uint_as_float(__float_as_uint(v)&(unsigned)(((int)((w)<<(31-MKBIT(r))))>>31))
  #define MLOAD(t,W0,W1) const unsigned long long mq_=mrd[((t)&1)*32]; const unsigned W0=((unsigned)mq_)>>(4*hi), W1=((unsigned)(mq_>>32))>>(4*hi)
  bool resc=false;
  #define START(P0,P1) do{ const float rm=rowmax(P0,P1); resc=false; \
    { const float dl=rm; mhat=fadd_s(mhat,dl); \
      _Pragma("unroll") for(int r=0;r<16;++r){P0[r]=fsub_s(P0[r],dl);P1[r]=fsub_s(P1[r],dl);} \
      _Pragma("unroll") for(int r=0;r<16;++r)negm[r]=-mhat; asm volatile("":"+v"(negm)); } \
    _Pragma("unroll") for(int r=0;r<16;++r)P0[r]=__builtin_amdgcn_exp2f(P0[r]); }while(0)
  #define RESC() do{ if(resc){ asm volatile("s_waitcnt lgkmcnt(0)":::"memory"); \
      _Pragma("unroll") for(int d_=0;d_<2;++d_) _Pragma("unroll") for(int r=0;r<16;++r)o[d_][r]*=wsf[crow(r,hi)]; } }while(0)
  f32x16 pA0,pA1,pB0,pB1;
  int sl_prev=0,sl_cur=0,sl_next=SLOTB;
  #define ROT() do{sl_prev=sl_cur;sl_cur=sl_next;sl_next=(sl_next==(NSLOT-1)*SLOTB)?0:sl_next+SLOTB;}while(0)
  DMA_K(2,2*SLOTB);
  WAIT_BAR(3);
  qkt(pA0,pA1,Kbase,qr,negm,r32,hi);asm volatile("s_nop 15\n\ts_nop 7":"+v"(pA0),"+v"(pA1));CMASK(pA0,pA1,0);
  START(pA0,pA1);
  _Pragma("unroll") for(int r=0;r<16;++r)pA1[r]=__builtin_amdgcn_exp2f(pA1[r]);
  { MLOAD(0,mwa,mwb); _Pragma("unroll") for(int r=0;r<16;++r){pA0[r]=MK(pA0[r],mwa,r);pA1[r]=MK(pA1[r],mwb,r);} }
  WAIT_BAR(0);
  DMA_M(1);DMA_K(3,0);DMA_V(1,SLOTB);
  ROT();
  kload8(kf,kp0+sl_cur);
  WAIT_BAR(2);
  s16x4 vlo[8],vhi[8]; u32x4 pw0,pw1,pw2,pw3;
  #define PKW(P,B) cvtpk_s(P[B],P[B+1])
  #define PAF(k) __builtin_bit_cast(bf16x8,pw##k)
  #define VFR(i) (bf16x8){vlo[i][0],vlo[i][1],vlo[i][2],vlo[i][3],vhi[i][0],vhi[i][1],vhi[i][2],vhi[i][3]}
  #define PIN(x) asm volatile("":"+v"(x))
  #define MX3(a,b,c) __builtin_fmaxf(__builtin_fmaxf((a),(b)),(c))
  #define GAPA(MF,A0,A1,A2,A3,W0,W1,PW) do{ MF; sacc+=A0; sacc+=A1; sacc+=A2; sacc+=A3; PIN(sacc); W0; W1; PIN(PW); SBAR(); }while(0)
  #define EX(v) __builtin_amdgcn_exp2f(v)
  #define GAPB(MF,X,B,W) do{ MF; X[B]=MK(EX(X[B]),W,B); X[B+1]=MK(EX(X[B+1]),W,B+1); X[B+2]=MK(EX(X[B+2]),W,B+2); X[B+3]=MK(EX(X[B+3]),W,B+3); PIN(X); SBAR(); }while(0)
  #define VRD(i) do{ vlo[i]=vtr(vp_+(((i)>>2)*4096+((i)&3)*1024)); vhi[i]=vtr(vp_+(((i)>>2)*4096+((i)&3)*1024+512)); }while(0)
  #define KRD(G,j) do{ if(G){ kload2(kf,kp0+sl_next,j); SBAR(); } }while(0)
  #define STEP(C0,C1,P0,P1,t,GK,GV,GL,GM) do{ SBAR(); \
    if(GM){DMA_M((t)+1);} \
    const lds_cptr vp_=vp0+sl_prev; \
    VRD(0); SBAR(); float sacc=(P0[0]+P0[1]); \
    GAPA(C0=__builtin_amdgcn_mfma_f32_32x32x16_bf16(kf[0],qr[0],negm,0,0,0), P0[2],P0[3],P0[4],P0[5],     pw0[0]=PKW(P0,0), pw0[1]=PKW(P0,2), pw0); \
    VRD(4); SBAR(); GAPA(C1=__builtin_amdgcn_mfma_f32_32x32x16_bf16(kf[1],qr[0],negm,0,0,0), P0[6],P0[7],P0[8],P0[9],     pw0[2]=PKW(P0,4), pw0[3]=PKW(P0,6), pw0); \
    VRD(1); SBAR(); GAPA(C0=__builtin_amdgcn_mfma_f32_32x32x16_bf16(kf[2],qr[1],C0,0,0,0),   P0[10],P0[11],P0[12],P0[13], pw1[0]=PKW(P0,8), pw1[1]=PKW(P0,10), pw1); \
    VRD(5); SBAR(); GAPA(C1=__builtin_amdgcn_mfma_f32_32x32x16_bf16(kf[3],qr[1],C1,0,0,0),   P0[14],P0[15],P1[0],P1[1],   pw1[2]=PKW(P0,12),pw1[3]=PKW(P0,14), pw1); \
    VRD(2); SBAR(); GAPA(C0=__builtin_amdgcn_mfma_f32_32x32x16_bf16(kf[4],qr[2],C0,0,0,0),   P1[2],P1[3],P1[4],P1[5],     pw2[0]=PKW(P1,0), pw2[1]=PKW(P1,2), pw2); \
    VRD(6); SBAR(); GAPA(C1=__builtin_amdgcn_mfma_f32_32x32x16_bf16(kf[5],qr[2],C1,0,0,0),   P1[6],P1[7],P1[8],P1[9],     pw2[2]=PKW(P1,4), pw2[3]=PKW(P1,6), pw2); \
    VRD(3); SBAR(); GAPA(C0=__builtin_amdgcn_mfma_f32_32x32x16_bf16(kf[6],qr[3],C0,0,0,0),   P1[10],P1[11],P1[12],P1[13], pw3[0]=PKW(P1,8), pw3[1]=PKW(P1,10), pw3); \
    VRD(7); SBAR(); GAPA(C1=__builtin_amdgcn_mfma_f32_32x32x16_bf16(kf[7],qr[3],C1,0,0,0),   P1[14],P1[15],0.f,0.f,       pw3[2]=PKW(P1,12),pw3[3]=PKW(P1,14), pw3); \
    l_reg+=sacc; \
    if(GK){DMA_K((t)+3,sl_cur);} if(GV){DMA_V((t)+1,sl_next);} \
    CMASK(C0,C1,t); \
    { float a=MX3(C0[0],C0[1],C1[0]),b=MX3(C0[2],C0[3],C1[1]); a=MX3(a,C1[2],C1[3]); \
      _Pragma("unroll") for(int r=4;r<16;r+=4){a=MX3(a,C0[r],C0[r+1]);b=MX3(b,C0[r+2],C0[r+3]);a=MX3(a,C1[r],C1[r+1]);b=MX3(b,C1[r+2],C1[r+3]);} \
      float rm=__builtin_fmaxf(a,b); { auto rr=__builtin_amdgcn_permlane32_swap(__float_as_uint(rm),__float_as_uint(rm),false,false); rm=__builtin_fmaxf(__uint_as_float(rr[0]),__uint_as_float(rr[1])); } \
      resc=false; \
      if(__builtin_expect(__any(rm>(float)THRL),0)){ const float dl=__builtin_fmaxf(rm,0.f); mhat+=dl; \
        _Pragma("unroll") for(int r=0;r<16;++r){C0[r]-=dl;C1[r]-=dl;} \
        _Pragma("unroll") for(int r=0;r<16;++r)negm[r]=-mhat; asm volatile("":"+v"(negm)); \
        const float f=__builtin_amdgcn_exp2f(-dl); l_reg*=f; if(hi==0)wsf[r32]=f; resc=true; } } \
    SBAR(); \
    MLOAD(t,mw0_,mw1_); \
    GAPB(o[0]=__builtin_amdgcn_mfma_f32_32x32x16_bf16(PAF(0),VFR(0),o[0],0,0,0), C0,0,mw0_); \
    GAPB(o[1]=__builtin_amdgcn_mfma_f32_32x32x16_bf16(PAF(0),VFR(4),o[1],0,0,0), C0,4,mw0_); \
    KRD(GL,0); GAPB(o[0]=__builtin_amdgcn_mfma_f32_32x32x16_bf16(PAF(1),VFR(1),o[0],0,0,0), C0,8,mw0_); \
    KRD(GL,1); GAPB(o[1]=__builtin_amdgcn_mfma_f32_32x32x16_bf16(PAF(1),VFR(5),o[1],0,0,0), C0,12,mw0_); \
    KRD(GL,2); GAPB(o[0]=__builtin_amdgcn_mfma_f32_32x32x16_bf16(PAF(2),VFR(2),o[0],0,0,0), C1,0,mw1_); \
    KRD(GL,3); GAPB(o[1]=__builtin_amdgcn_mfma_f32_32x32x16_bf16(PAF(2),VFR(6),o[1],0,0,0), C1,4,mw1_); \
    GAPB(o[0]=__builtin_amdgcn_mfma_f32_32x32x16_bf16(PAF(3),VFR(3),o[0],0,0,0), C1,8,mw1_); \
    GAPB(o[1]=__builtin_amdgcn_mfma_f32_32x32x16_bf16(PAF(3),VFR(7),o[1],0,0,0), C1,12,mw1_); \
    }while(0)
  int t=1;
  #undef CMASK
  #define CMASK(P0,P1,t) do{}while(0)
  for(;t+5<NT;t+=2){
    STEP(pB0,pB1,pA0,pA1,t,true,true,true,true);     WAIT_BAR(2); RESC(); ROT();
    STEP(pA0,pA1,pB0,pB1,t+1,true,true,true,true);   WAIT_BAR(2); RESC(); ROT();
  }
  #undef CMASK
  #define CMASK(P0,P1,t) do{}while(0)
  #define ENDW(tt) do{ if((tt)+3<NT){WAIT_BAR(2);} else if((tt)+2<NT){WAIT_BAR(1);} else {WAIT_BAR(0);} }while(0)
  for(;t+1<NT;t+=2){
    STEP(pB0,pB1,pA0,pA1,t,(t+3<NT),(t+1<NT),(t+1<NT),(t+1<NT));       ENDW(t);   RESC(); ROT();
    STEP(pA0,pA1,pB0,pB1,t+1,(t+4<NT),(t+2<NT),(t+2<NT),(t+2<NT));     ENDW(t+1); RESC(); ROT();
  }
  STEP(pB0,pB1,pA0,pA1,NT-1,false,false,false,false); RESC();
  { float sacc=pB0[0]+pB0[1]; _Pragma("unroll") for(int r=2;r<16;++r)sacc+=pB0[r]; _Pragma("unroll") for(int r=0;r<16;++r)sacc+=pB1[r]; l_reg+=sacc;
    pw0=(u32x4){PKW(pB0,0),PKW(pB0,2),PKW(pB0,4),PKW(pB0,6)};pw1=(u32x4){PKW(pB0,8),PKW(pB0,10),PKW(pB0,12),PKW(pB0,14)};pw2=(u32x4){PKW(pB1,0),PKW(pB1,2),PKW(pB1,4),PKW(pB1,6)};pw3=(u32x4){PKW(pB1,8),PKW(pB1,10),PKW(pB1,12),PKW(pB1,14)};
    SBAR(); pv(o,vb0+sl_cur,PAF(0),PAF(1),PAF(2),PAF(3)); }
  #undef PKW
  #undef PAF
  #undef VFR
  #undef PIN
  #undef MX3
  #undef GAPA
  #undef GAPB
  #undef EX
  #undef VRD
  #undef KRD
  #undef STEP
  #undef ENDW
  {auto rr=__builtin_amdgcn_permlane32_swap(__float_as_uint(l_reg),__float_as_uint(l_reg),false,false);l_reg=__uint_as_float(rr[0])+__uint_as_float(rr[1]);}
  if(hi==0)wsf[32+r32]=l_reg;asm volatile("s_waitcnt lgkmcnt(0)":::"memory");
  float rli[16];
  #pragma unroll
  for(int r=0;r<16;++r)rli[r]=__builtin_amdgcn_rcpf(wsf[32+crow(r,hi)]);
  unsigned short*Ow=O+(rowbase+q0+wid*QBLK)*DMO+h*D;
  { unsigned short*stg=(unsigned short*)(shm+LDS_OST)+wid*2048;
    #pragma unroll
    for(int r=0;r<16;++r){const int orow=crow(r,hi);
      #pragma unroll
      for(int d0=0;d0<2;++d0)stg[orow*64+d0*32+r32]=__builtin_bit_cast(unsigned short,(_Float16)(o[d0][r]*rli[r]));}
    asm volatile("s_waitcnt lgkmcnt(0)":::"memory");
    #pragma unroll
    for(int i=0;i<4;++i){const int row=i*8+(lane>>3),ch=lane&7; const u32x4 v=*(const u32x4*)(stg+row*64+ch*8); ATTN_STORE16(Ow+(long)row*DMO+ch*8,v);} }
  asm volatile("s_waitcnt lgkmcnt(0)\n\ts_barrier":::"memory");
  #undef DMA_K
  #undef DMA_V
  #undef DMA_M
  #undef MK
  #undef MKBIT
  #undef MLOAD
  #undef CMASK
  #undef START
  #undef RESC
  #undef ROT
}
constexpr int ATTN_LDS_BYTES=LDS_BYTES;
struct AttnTensors { const bf16* Q; const bf16* K; const bf16* V; unsigned short* O; const unsigned long long* MT; };
struct AttnUnit { int bh; int qb; };
struct StaticOrder {
  int vcu;
  __device__ __forceinline__ explicit StaticOrder(int grid,int block):vcu((block%8)*(grid/8)+block/8){}
  __device__ __forceinline__ bool next(int i,AttnUnit&u)const{ if(i>=2)return false; const int s=vcu&15; u.bh=vcu>>4; u.qb=(i==0)?s:31-s; return true; }
  __device__ __forceinline__ void a_ready(const AttnUnit&)const{}
  __device__ __forceinline__ void done(const AttnUnit&)const{}
};
template<class Sched,int THRL=8> __device__ __forceinline__ void attn_phase(char*lds,const AttnTensors&T,const Sched&S){
  AttnUnit u;
  for(int i=0;S.next(i,u);++i){ S.a_ready(u); attn_unit<THRL>(u.bh/NHEAD,u.bh%NHEAD,u.qb,T.Q,T.K,T.V,T.O,T.MT,lds); S.done(u); }
}
#undef SBAR
#undef WAIT_BAR
}

__global__ void __launch_bounds__(NTHR, 2) k_attn(Params p) {
    extern __shared__ __attribute__((aligned(16))) unsigned char lds[];
    unsigned char* ws = p.ws;
    const attn_body::AttnTensors AT{(const attn_body::bf16*)(ws + WS_Q), (const attn_body::bf16*)(ws + WS_K), (const attn_body::bf16*)(ws + WS_V), (unsigned short*)(ws + WS_MIX), (const unsigned long long*)(ws + WS_MASK)};
    const attn_body::StaticOrder S((int)gridDim.x, (int)blockIdx.x);
    attn_body::attn_phase<attn_body::StaticOrder>((char*)lds, AT, S);
}


__global__ void __launch_bounds__(256) k_index_topk(const u16* __restrict__ QI, const u16* __restrict__ KI, const float* __restrict__ WI, unsigned* __restrict__ MASK) {
    __shared__ float qs[256];
    __shared__ unsigned sc[256 * 33];
    __shared__ int red[2][4];
    __shared__ int wtot[4];
    const int q = blockIdx.x, b = q >> 13, t = q & (SEQ - 1), n = t + 1, tid = threadIdx.x, lane = tid & 63, w = tid >> 6;
    unsigned* mrow = MASK + (size_t)q * 256;
    if (n <= TOPK) {
        const int lo = tid * 32; unsigned word = 0u;
        if (lo <= t) { const int cnt = t - lo + 1; word = cnt >= 32 ? 0xffffffffu : ((1u << cnt) - 1u); }
        mrow[tid] = word; return;
    }
    qs[tid] = h2f(QI[(size_t)q * 256 + tid]);
    const float w0 = WI[q * 4 + 0], w1 = WI[q * 4 + 1], w2 = WI[q * 4 + 2], w3 = WI[q * 4 + 3];
    __syncthreads();
    for (int j = 0; j < 32; ++j) {
        const int s = tid * 32 + j; unsigned key = 0u;
        if (s < n) {
            const uint4* kp = (const uint4*)(KI + (size_t)(b * SEQ + s) * 64);
            float d0 = 0.f, d1 = 0.f, d2 = 0.f, d3 = 0.f;
#pragma unroll
            for (int c = 0; c < 8; ++c) {
                const uint4 kv = kp[c]; const unsigned kw[4] = {kv.x, kv.y, kv.z, kv.w};
#pragma unroll
                for (int e = 0; e < 4; ++e) {
                    const float k0 = h2f(kw[e] & 0xffffu), k1 = h2f(kw[e] >> 16); const int d = c * 8 + e * 2;
                    d0 += qs[d] * k0 + qs[d + 1] * k1; d1 += qs[64 + d] * k0 + qs[64 + d + 1] * k1;
                    d2 += qs[128 + d] * k0 + qs[128 + d + 1] * k1; d3 += qs[192 + d] * k0 + qs[192 + d + 1] * k1;
                }
            }
            const float score = w0 * fmaxf(d0, 0.f) + w1 * fmaxf(d1, 0.f) + w2 * fmaxf(d2, 0.f) + w3 * fmaxf(d3, 0.f);
            key = f2ord(score);
        }
        sc[tid * 33 + j] = key;
    }
    __syncthreads();
    unsigned u[32];
#pragma unroll
    for (int j = 0; j < 32; ++j) u[j] = sc[tid * 33 + j];
    unsigned T = 0u;
    for (int bit = 31; bit >= 0; --bit) {
        const unsigned cand = T | (1u << bit); int c = 0;
#pragma unroll
        for (int j = 0; j < 32; ++j) c += (u[j] >= cand) ? 1 : 0;
        c = (int)wave_sum((float)c);
        if (lane == 0) red[bit & 1][w] = c;
        __syncthreads();
        const int tot = red[bit & 1][0] + red[bit & 1][1] + red[bit & 1][2] + red[bit & 1][3];
        if (tot >= TOPK) T = cand;
    }
    int cgt = 0, ceq = 0;
#pragma unroll
    for (int j = 0; j < 32; ++j) { cgt += (u[j] > T) ? 1 : 0; ceq += (u[j] == T) ? 1 : 0; }
    float fg = wave_sum((float)cgt);
    int incl = ceq;
#pragma unroll
    for (int o = 1; o < 64; o <<= 1) { const int v = __shfl_up(incl, o); if (lane >= o) incl += v; }
    __syncthreads();
    if (lane == 63) wtot[w] = incl;
    if (lane == 0) red[0][w] = (int)fg;
    __syncthreads();
    const int cgt_tot = red[0][0] + red[0][1] + red[0][2] + red[0][3];
    int excl = incl - ceq;
    for (int ww = 0; ww < w; ++ww) excl += wtot[ww];
    const int need = TOPK - cgt_tot;
    unsigned word = 0u; int rk = excl;
#pragma unroll
    for (int j = 0; j < 32; ++j) {
        bool sel = u[j] > T;
        if (u[j] == T) { sel = rk < need; ++rk; }
        word |= sel ? (1u << j) : 0u;
    }
    mrow[tid] = word;
}

__global__ void __launch_bounds__(256) k_sparse_attn(const u16* __restrict__ Q, const u16* __restrict__ K, const u16* __restrict__ V, const unsigned* __restrict__ MASK, u16* __restrict__ MIX) {
    __shared__ int idx[256];
    __shared__ float qf[512];
    __shared__ float lg[8][256];
    __shared__ int wtot[4];
    const int q = blockIdx.x, b = q >> 13, tid = threadIdx.x, lane = tid & 63, w = tid >> 6;
    unsigned word = 0u;
    { const int t = q & (SEQ - 1), kt = tid >> 1, half = tid & 1;
      if (64 * kt <= t) { const unsigned long long w64 = ((const unsigned long long*)MASK)[((size_t)(b * 256 + (t >> 5)) * 128 + kt) * 32 + (t & 31)]; word = (unsigned)(w64 >> (32 * half)); } }
    const int pc = __popc(word);
    int incl = pc;
#pragma unroll
    for (int o = 1; o < 64; o <<= 1) { const int v = __shfl_up(incl, o); if (lane >= o) incl += v; }
    if (lane == 63) wtot[w] = incl;
    qf[tid] = bf2f(Q[(size_t)q * 512 + tid]); qf[256 + tid] = bf2f(Q[(size_t)q * 512 + 256 + tid]);
    __syncthreads();
    int off = incl - pc;
    for (int ww = 0; ww < w; ++ww) off += wtot[ww];
    const int cnt = wtot[0] + wtot[1] + wtot[2] + wtot[3];
    { unsigned m = word; while (m) { const int j = __ffs(m) - 1; m &= m - 1; if (off < 256) idx[off] = tid * 32 + j; ++off; } }
    __syncthreads();
    const int h = tid >> 5, l32 = tid & 31;
    float mx = -INFINITY;
    for (int j = l32; j < cnt; j += 32) {
        const uint4* kp = (const uint4*)(K + (size_t)(b * SEQ + idx[j]) * 512 + h * 64);
        float d = 0.f;
#pragma unroll
        for (int c = 0; c < 8; ++c) {
            const uint4 kv = kp[c]; const unsigned kw[4] = {kv.x, kv.y, kv.z, kv.w};
#pragma unroll
            for (int e = 0; e < 4; ++e) d += qf[h * 64 + c * 8 + e * 2] * bf2f(kw[e] & 0xffffu) + qf[h * 64 + c * 8 + e * 2 + 1] * bf2f(kw[e] >> 16);
        }
        lg[h][j] = d; mx = fmaxf(mx, d);
    }
#pragma unroll
    for (int o = 16; o >= 1; o >>= 1) mx = fmaxf(mx, __shfl_xor(mx, o));
    float sum = 0.f;
    for (int j = l32; j < cnt; j += 32) { const float pr = exp2f(lg[h][j] - mx); lg[h][j] = pr; sum += pr; }
#pragma unroll
    for (int o = 16; o >= 1; o >>= 1) sum += __shfl_xor(sum, o);
    __syncthreads();
    float a0 = 0.f, a1 = 0.f;
    for (int j = 0; j < cnt; ++j) {
        const unsigned vv = *(const unsigned*)(V + (size_t)(b * SEQ + idx[j]) * 512 + h * 64 + 2 * l32);
        const float pr = lg[h][j]; a0 += pr * bf2f(vv & 0xffffu); a1 += pr * bf2f(vv >> 16);
    }
    const float inv = 1.f / sum;
    *(unsigned*)(MIX + (size_t)q * D_MODEL + h * 64 + 2 * l32) = pkh(a0 * inv, a1 * inv);
}

__device__ __forceinline__ void gla_cumlog(const float* __restrict__ GL, const float* __restrict__ wg, const float* __restrict__ bg, int tok0, int h, float (*bl)[33]) {
    const int tid = threadIdx.x, i = tid >> 2, dq = tid & 3;
    float gl[16];
#pragma unroll
    for (int r = 0; r < 16; ++r) gl[r] = GL[(size_t)(tok0 + i) * 16 + r];
#pragma unroll
    for (int dd = 0; dd < 8; ++dd) {
        const int d = dq * 8 + dd; float z = bg[h * 32 + d];
#pragma unroll
        for (int r = 0; r < 16; ++r) z += gl[r] * wg[r * 128 + h * 32 + d];
        const float ls = fminf(z, 0.f) - log1pf(__expf(-fabsf(z)));
        bl[i][d] = ls * (1.f / 16.f);
    }
    __syncthreads();
    if (tid < 32) { float a = 0.f; for (int ii = 0; ii < 64; ++ii) { a += bl[ii][tid]; bl[ii][tid] = a; } }
    __syncthreads();
}
__global__ void __launch_bounds__(256) k_gla1(const float* __restrict__ GL, const u16* __restrict__ GQK, const u16* __restrict__ GV, const float* __restrict__ wg, const float* __restrict__ bg, float* __restrict__ DS, float* __restrict__ DD) {
    __shared__ float bl[64][33];
    __shared__ float kh[64][33];
    __shared__ float vv[64][64];
    const int blk = blockIdx.x, b = blk >> 9, h = (blk >> 7) & 3, c = blk & 127, tid = threadIdx.x, tok0 = b * SEQ + c * 64;
    gla_cumlog(GL, wg, bg, tok0, h, bl);
    { const int j = tid >> 2, dq = tid & 3;
#pragma unroll
      for (int dd = 0; dd < 8; ++dd) { const int d = dq * 8 + dd; kh[j][d] = bf2f(GQK[(size_t)(tok0 + j) * 256 + 128 + h * 32 + d]) * __expf(bl[63][d] - bl[j][d]); }
#pragma unroll
      for (int ee = 0; ee < 16; ++ee) { const int e = dq * 16 + ee; vv[j][e] = bf2f(GV[(size_t)(tok0 + j) * 256 + h * 64 + e]); } }
    __syncthreads();
    const int e = tid & 63, dg = tid >> 6;
#pragma unroll
    for (int dd = 0; dd < 8; ++dd) { const int d = dg * 8 + dd; float s = 0.f; for (int j = 0; j < 64; ++j) s += kh[j][d] * vv[j][e]; DS[(size_t)blk * 2048 + d * 64 + e] = s; }
    if (tid < 32) DD[blk * 32 + tid] = __expf(bl[63][tid]);
}
__global__ void __launch_bounds__(256) k_gla2(const float* __restrict__ DS, const float* __restrict__ DD, float* __restrict__ S0) {
    const int idx = blockIdx.x * 256 + threadIdx.x, bh = idx >> 11, de = idx & 2047;
    float S = 0.f;
    for (int c = 0; c < 128; ++c) { const int blk = bh * 128 + c; S0[(size_t)blk * 2048 + de] = S; S = DD[blk * 32 + (de >> 6)] * S + DS[(size_t)blk * 2048 + de]; }
}
__global__ void __launch_bounds__(256) k_gla3(const float* __restrict__ GL, const u16* __restrict__ GQK, const u16* __restrict__ GV, const u16* __restrict__ GR, const float* __restrict__ wg, const float* __restrict__ bg,
                                             const float* __restrict__ S0, const float* __restrict__ gn, u16* __restrict__ MIX) {
    __shared__ float bl[64][33];
    __shared__ float qt[64][33];
    __shared__ float kt[64][33];
    __shared__ u16 vv[64][64];
    __shared__ float Ss[32][64];
    __shared__ float at[64][65];
    const int blk = blockIdx.x, b = blk >> 9, h = (blk >> 7) & 3, c = blk & 127, tid = threadIdx.x, tok0 = b * SEQ + c * 64;
    gla_cumlog(GL, wg, bg, tok0, h, bl);
    const int i = tid >> 2, qd = tid & 3;
#pragma unroll
    for (int dd = 0; dd < 8; ++dd) { const int d = qd * 8 + dd; const float bb = bl[i][d];
        qt[i][d] = bf2f(GQK[(size_t)(tok0 + i) * 256 + h * 32 + d]) * 0.17677669529663687f * __expf(bb);
        kt[i][d] = bf2f(GQK[(size_t)(tok0 + i) * 256 + 128 + h * 32 + d]) * __expf(-bb); }
#pragma unroll
    for (int ee = 0; ee < 16; ++ee) { const int e = qd * 16 + ee; vv[i][e] = GV[(size_t)(tok0 + i) * 256 + h * 64 + e]; }
    for (int x = tid; x < 2048; x += 256) Ss[x >> 6][x & 63] = S0[(size_t)blk * 2048 + x];
    __syncthreads();
#pragma unroll
    for (int jj = 0; jj < 16; ++jj) { const int j = qd * 16 + jj; float s = 0.f;
        if (j <= i) { for (int d = 0; d < 32; ++d) s += qt[i][d] * kt[j][d]; }
        at[i][j] = s; }
    __syncthreads();
    float o[16]; float ss = 0.f;
#pragma unroll
    for (int ee = 0; ee < 16; ++ee) { const int e = qd * 16 + ee; float s = 0.f;
        for (int d = 0; d < 32; ++d) s += qt[i][d] * Ss[d][e];
        for (int j = 0; j <= i; ++j) s += at[i][j] * bf2f(vv[j][e]);
        o[ee] = s; ss += s * s; }
    ss += __shfl_xor(ss, 1); ss += __shfl_xor(ss, 2);
    const float rs = rsqrtf(ss * (1.f / 64.f) + EPS);
#pragma unroll
    for (int ee = 0; ee < 16; ++ee) { const int e = qd * 16 + ee;
        const float r = bf2f(GR[(size_t)(tok0 + i) * 256 + h * 64 + e]);
        MIX[(size_t)(tok0 + i) * D_MODEL + 512 + h * 64 + e] = (u16)f2h(o[ee] * rs * gn[h * 64 + e] * silu_f(r)); }
}
__global__ void __launch_bounds__(256) k_pool(const u16* __restrict__ UC, const float* __restrict__ wp, const float* __restrict__ psc, u16* __restrict__ MIX) {
    __shared__ float pl[16][256];
    const int tok0 = blockIdx.x * 16, tid = threadIdx.x, g = tid >> 6;
    const int win = 2 << g;
    for (int tt = 0; tt < 16; ++tt) {
        const int tok = tok0 + tt, pos = tok & (SEQ - 1); const int cnt = (pos + 1 < win) ? pos + 1 : win;
        float s = 0.f;
        for (int j = 0; j < cnt; ++j) s += bf2f(UC[(size_t)(tok - j) * 256 + tid]);
        pl[tt][tid] = s / (float)cnt - bf2f(UC[(size_t)tok * 256 + tid]);
    }
    __syncthreads();
    const int e = tid & 63;
    float acc[16];
#pragma unroll
    for (int tt = 0; tt < 16; ++tt) acc[tt] = 0.f;
    for (int d = 0; d < 64; ++d) { const float wv = wp[(g * 64 + d) * 64 + e];
#pragma unroll
        for (int tt = 0; tt < 16; ++tt) acc[tt] += pl[tt][g * 64 + d] * wv; }
    const float sc = psc[tid];
#pragma unroll
    for (int tt = 0; tt < 16; ++tt) MIX[(size_t)(tok0 + tt) * D_MODEL + 768 + tid] = (u16)f2h(acc[tt] * sc);
}

extern "C" void kernel_launch(void* const* d_in, const int* in_sizes, int n_in, void* d_out, int out_size, void* d_ws, size_t ws_size, hipStream_t stream) {
    static int grid = 0;
    if (grid == 0) {
        int dev = 0, cus = 0; hipGetDevice(&dev); hipDeviceGetAttribute(&cus, hipDeviceAttributeMultiprocessorCount, dev);
        hipFuncSetAttribute((const void*)k_prologue, hipFuncAttributeMaxDynamicSharedMemorySize, LDS_BYTES);
        hipFuncSetAttribute((const void*)k_wconv_updown, hipFuncAttributeMaxDynamicSharedMemorySize, LDS_BYTES);
        hipFuncSetAttribute((const void*)k_gemm_proj, hipFuncAttributeMaxDynamicSharedMemorySize, LDS_BYTES);
        hipFuncSetAttribute((const void*)k_gemm_out, hipFuncAttributeMaxDynamicSharedMemorySize, LDS_BYTES);
        hipFuncSetAttribute((const void*)k_gemm_up, hipFuncAttributeMaxDynamicSharedMemorySize, LDS_BYTES);
        hipFuncSetAttribute((const void*)k_gemm_down, hipFuncAttributeMaxDynamicSharedMemorySize, LDS_BYTES);
        hipFuncSetAttribute((const void*)k_topk, hipFuncAttributeMaxDynamicSharedMemorySize, LDS_BYTES);
        hipFuncSetAttribute((const void*)k_attn, hipFuncAttributeMaxDynamicSharedMemorySize, LDS_BYTES);
        grid = cus > 0 ? cus : 256;
        if (ws_size < WS_END) fprintf(stderr, "kernel_launch: workspace too small (%zu)\n", ws_size);
    }
    Params p; memset(&p, 0, sizeof(p));
    p.x = (const float*)d_in[0]; p.pos = (const int*)d_in[1]; p.norm1_g = (const float*)d_in[2]; p.w_in = (const float*)d_in[3]; p.w_gate_up = (const float*)d_in[4]; p.b_gate = (const float*)d_in[5];
    p.gla_norm_g = (const float*)d_in[6]; p.w_pool = (const float*)d_in[7]; p.pool_scale = (const float*)d_in[8]; p.w_out = (const float*)d_in[9]; p.norm2_g = (const float*)d_in[10]; p.w_up = (const float*)d_in[11];
    p.conv_w = (const float*)d_in[12]; p.conv_b = (const float*)d_in[13]; p.w_down = (const float*)d_in[14]; p.final_g = (const float*)d_in[15];
    p.out = (float*)d_out; p.ws = (unsigned char*)d_ws;
    unsigned char* ws = (unsigned char*)d_ws;
    u16 *Q = (u16*)(ws + WS_Q), *K = (u16*)(ws + WS_K), *V = (u16*)(ws + WS_V), *QI = (u16*)(ws + WS_QI), *KI = (u16*)(ws + WS_KI), *GQK = (u16*)(ws + WS_GQK), *GV = (u16*)(ws + WS_GV), *GR = (u16*)(ws + WS_GR), *UC = (u16*)(ws + WS_UC), *MIX = (u16*)(ws + WS_MIX);
    float *WI = (float*)(ws + WS_WI), *GL = (float*)(ws + WS_GL);
    unsigned* MASK = (unsigned*)(ws + WS_MASK);
    float *GDS = (float*)(ws + WS_LIST), *GS0 = (float*)(ws + WS_LIST + 8 * MiB), *GDD = (float*)(ws + WS_LIST + 16 * MiB);

    hipMemsetAsync(d_ws, 0, CTL_ZERO_BYTES, stream);
    p.layer = 0;
    k_prologue<<<grid, NTHR, LDS_BYTES, stream>>>(p);
    for (int l = 0; l < DEPTH; ++l) {
        p.layer = l;
        k_gemm_proj<<<grid, NTHR, LDS_BYTES, stream>>>(p);
        k_topk<<<grid, NTHR, LDS_BYTES, stream>>>(p);
        k_attn<<<grid, NTHR, LDS_BYTES, stream>>>(p);
        k_gla1<<<1024, 256, 0, stream>>>(GL, GQK, GV, p.w_gate_up + l * 16 * 128, p.b_gate + l * 128, GDS, GDD);
        k_gla2<<<64, 256, 0, stream>>>(GDS, GDD, GS0);
        k_gla3<<<1024, 256, 0, stream>>>(GL, GQK, GV, GR, p.w_gate_up + l * 16 * 128, p.b_gate + l * 128, GS0, p.gla_norm_g + l * 256, MIX);
        k_pool<<<M_TOK / 16, 256, 0, stream>>>(UC, p.w_pool + (size_t)l * 4 * 64 * 64, p.pool_scale + l * 256, MIX);
        k_gemm_out<<<grid, NTHR, LDS_BYTES, stream>>>(p);
        if (l == 1) k_wconv_updown<<<grid, NTHR, LDS_BYTES, stream>>>(p);
        k_gemm_up<<<grid, NTHR, LDS_BYTES, stream>>>(p);
        k_convgate<<<grid, NTHR, 0, stream>>>(p);
        k_gemm_down<<<grid, NTHR, LDS_BYTES, stream>>>(p);
    }
    k_final_norm<<<grid, NTHR, 0, stream>>>(p);
}
```

```cpp
#include <hip/hip_runtime.h>
#include <cstdint>
#include <cstdio>
#include <cstring>

typedef unsigned short u16;
typedef _Float16 f16x8 __attribute__((ext_vector_type(8)));

constexpr int D_MODEL = 1024, BATCH = 2, SEQ = 8192, DEPTH = 2, M_TOK = BATCH * SEQ;
constexpr int IN_WIDTH = 2900, NPROJ = 3072;
constexpr int D_FF = 2816;
constexpr float EPS = 1e-6f;
constexpr int TOPK = 256;
constexpr float C2 = 0.125f * 1.4426950408889634f;

constexpr size_t MiB = 1u << 20;
constexpr size_t WS_CTL = 0, CTL_ZERO_BYTES = 64 * 1024;
constexpr size_t WS_CS = 1 * MiB;
constexpr size_t WS_WI = 2 * MiB;
constexpr size_t WS_WPT = 2 * MiB + 512 * 1024;
constexpr size_t WS_GL = 3 * MiB;
constexpr size_t WS_RSS = 4 * MiB;
constexpr size_t WS_WIN0 = 5 * MiB, WS_WOUT0 = 11 * MiB, WS_WIN1 = 13 * MiB, WS_WOUT1 = 19 * MiB;
constexpr size_t WS_WUP = 21 * MiB, WS_WDN = 32 * MiB;
constexpr size_t WS_XG = 38 * MiB;
constexpr size_t WS_AB = 70 * MiB;
constexpr size_t WS_Q = 70 * MiB, WS_K = 86 * MiB, WS_V = 102 * MiB;
constexpr size_t WS_QI = 118 * MiB;
constexpr size_t WS_KI = 126 * MiB;
constexpr size_t WS_GQK = 128 * MiB, WS_GV = 136 * MiB, WS_GR = 144 * MiB, WS_UC = 152 * MiB;
constexpr size_t WS_MIX = 160 * MiB;
constexpr size_t WS_LIST = 192 * MiB;
constexpr size_t OUT_MASK = 0;
constexpr size_t OUT_GST = 16 * MiB;
constexpr size_t WS_END = 256 * MiB;

__device__ __forceinline__ unsigned f2bf(float f) { unsigned u = __float_as_uint(f); return (u + 0x7fffu + ((u >> 16) & 1u)) >> 16; }
__device__ __forceinline__ float bf2f(unsigned h) { return __uint_as_float(h << 16); }
__device__ __forceinline__ unsigned f2h(float f) { _Float16 h = (_Float16)f; return (unsigned)__builtin_bit_cast(unsigned short, h); }
__device__ __forceinline__ float h2f(unsigned h) { return (float)__builtin_bit_cast(_Float16, (unsigned short)h); }
typedef float f32x2_t __attribute__((ext_vector_type(2))); typedef __bf16 bf16x2_t __attribute__((ext_vector_type(2))); typedef _Float16 f16x2_t __attribute__((ext_vector_type(2)));
__device__ __forceinline__ unsigned pkbf(float lo, float hi) { f32x2_t v = {lo, hi}; bf16x2_t b = __builtin_convertvector(v, bf16x2_t); return __builtin_bit_cast(unsigned, b); }
__device__ __forceinline__ unsigned pkh(float lo, float hi) { f32x2_t v = {lo, hi}; f16x2_t b = __builtin_convertvector(v, f16x2_t); return __builtin_bit_cast(unsigned, b); }
__device__ __forceinline__ float shfl_upL(float v, int o, int lane) { return __int_as_float(__builtin_amdgcn_ds_bpermute(((lane - o) & 63) << 2, __float_as_int(v))); }
__device__ __forceinline__ int shfl_upL(int v, int o, int lane) { return __builtin_amdgcn_ds_bpermute(((lane - o) & 63) << 2, v); }
__device__ __forceinline__ float shfl_xorL(float v, int x, int lane) { return __int_as_float(__builtin_amdgcn_ds_bpermute((lane ^ x) << 2, __float_as_int(v))); }
__device__ __forceinline__ float wave_sum(float v) {
    int r = __float_as_int(v);
#define WS_STEP(ctrl, rm) r = __float_as_int(__int_as_float(r) + __int_as_float(__builtin_amdgcn_update_dpp(0, r, ctrl, rm, 0xf, true)))
    WS_STEP(0x111, 0xf); WS_STEP(0x112, 0xf); WS_STEP(0x114, 0xf); WS_STEP(0x118, 0xf); WS_STEP(0x142, 0xa); WS_STEP(0x143, 0xc);
#undef WS_STEP
    return __int_as_float(__builtin_amdgcn_readlane(r, 63));
}
__device__ __forceinline__ int otid(int wv) { int l; asm volatile("v_mbcnt_lo_u32_b32 %0, -1, 0\n\tv_mbcnt_hi_u32_b32 %0, -1, %0" : "=v"(l)); return wv * 64 + l; }
template <class T> __device__ __forceinline__ T* opq(T* p) { asm volatile("" : "+s"(p)); return (T*)(__attribute__((address_space(1))) T*)p; }
typedef float f32x16_g __attribute__((ext_vector_type(16)));
__device__ __forceinline__ f32x16_g zero16() { float z = 0.f; asm volatile("" : "+v"(z)); f32x16_g r;
#pragma unroll
    for (int i = 0; i < 16; ++i) r[i] = z;
    return r; }
__device__ __forceinline__ float silu_f(float x) { return x * __builtin_amdgcn_rcpf(1.f + __expf(-x)); }

namespace pg8 {
#define PG8_LAS __attribute__((address_space(3)))
typedef unsigned short bf16_t;
typedef short bf16x8 __attribute__((ext_vector_type(8)));
typedef float f32x4 __attribute__((ext_vector_type(4)));
typedef unsigned u32x4 __attribute__((ext_vector_type(4)));
constexpr int BM = 256, BK = 64, HALF = 128, HTB = HALF * BK * 2  , STAGE_BYTES = 8 * HTB, NXCD = 8, WGM = 8;

__host__ __device__ __forceinline__ int lds_byte(int r, int c) { const int st = (r >> 4) * 2 + (c >> 5), rr = r & 15, cc = c & 31, ob = rr * 64 + cc * 2; return st * 1024 + (ob ^ (((ob >> 9) & 1) << 5)); }
__host__ __device__ __forceinline__ void stage_rc(int b, int& R, int& C) { const int st = b / 1024, sb = b % 1024, swz = sb ^ (((sb >> 9) & 1) << 5); R = (st >> 1) * 16 + swz / 64; C = (st & 1) * 32 + (swz % 64) / 2; }
__host__ __device__ __forceinline__ int perm32(int rho) { const int n = rho >> 4, i = rho & 15; return 8 * (i >> 2) + 4 * n + (i & 3); }

struct Unit { int pm, pn, row0, lo; };
struct Gemm { const bf16_t* A; const bf16_t* Bt; int M, N, K, lda; };

struct StaticOrder {
    int nM, nN, nwg, G, c;
    __host__ __device__ void init(int M, int N, int G_, int c_) { nM = M / BM; nN = N / BM; nwg = nM * nN; G = G_; c = c_; }
    __host__ __device__ bool next(int i, Unit& u) const {
        const long L = (long)i * G + c; if (L >= nwg) return false;
        int wgid = (int)L; { const int q = nwg / NXCD, r = nwg % NXCD, xcd = wgid % NXCD, off = wgid / NXCD; wgid = (xcd < r ? xcd * (q + 1) : r * (q + 1) + (xcd - r) * q) + off; }
        const int nig = WGM * nN, gid = wgid / nig, fm = gid * WGM, gsz = (nM - fm) < WGM ? (nM - fm) : WGM;
        u.pm = fm + ((wgid % nig) % gsz); u.pn = (wgid % nig) / gsz; u.row0 = u.pm * BM; u.lo = 0; return true;
    }
    __device__ __forceinline__ void a_ready(const Unit&) const {}
    __device__ __forceinline__ void done(const Unit&) const {}
};
struct HaloOrder {
    StaticOrder base;
    __host__ __device__ void init(int N, int G_, int c_) { base.init(66 * BM, N, G_, c_); }
    __host__ __device__ bool next(int i, Unit& u) const {
        if (!base.next(i, u)) return false;
        const int bt = u.pm / 33, ti = u.pm % 33, s = (254 * ti < 7936) ? 254 * ti : 7936;
        u.row0 = bt * 8192 + s; u.lo = (ti == 0) ? 0 : (254 * ti + 2 - s); return true;
    }
    __device__ __forceinline__ void a_ready(const Unit&) const {}
    __device__ __forceinline__ void done(const Unit&) const {}
};

__device__ __forceinline__ float row_rs(const float* rss, int row) {
    const f32x4* rp = (const f32x4*)(rss + (size_t)row * 16);
    const f32x4 s0 = rp[0], s1 = rp[1], s2 = rp[2], s3 = rp[3];
    const float t = (((s0[0] + s0[1]) + (s0[2] + s0[3])) + ((s1[0] + s1[1]) + (s1[2] + s1[3]))) + (((s2[0] + s2[1]) + (s2[2] + s2[3])) + ((s3[0] + s3[1]) + (s3[2] + s3[3])));
    return rsqrtf(t * (1.f / D_MODEL) + EPS);
}
__device__ __forceinline__ float row_rs4(const float* rss, int row, int fq, int lane) {
    const f32x4 s = *(const f32x4*)(rss + (size_t)row * 16 + 4 * fq);
    float t = (s[0] + s[1]) + (s[2] + s[3]);
    t += shfl_xorL(t, 16, lane); t += shfl_xorL(t, 32, lane);
    return rsqrtf(t * (1.f / D_MODEL) + EPS);
}
__device__ __forceinline__ u32x4 pack8_bf(const f32x4& a, const f32x4& b) { u32x4 w; w.x = pkbf(a[0], a[1]); w.y = pkbf(a[2], a[3]); w.z = pkbf(b[0], b[1]); w.w = pkbf(b[2], b[3]); return w; }
__device__ __forceinline__ u32x4 pack8_h(const f32x4& a, const f32x4& b) { u32x4 w; w.x = pkh(a[0], a[1]); w.y = pkh(a[2], a[3]); w.z = pkh(b[0], b[1]); w.w = pkh(b[2], b[3]); return w; }

typedef __attribute__((address_space(1))) u32x4 gu32x4_t;
typedef __attribute__((address_space(1))) f32x4 gf32x4_t;
struct gu32x2_t { typedef unsigned vt __attribute__((ext_vector_type(2))); typedef __attribute__((address_space(1))) vt* pt; };
struct EpiProj {
    static constexpr bool PERM = true, AFTER_DRAIN = false;
    const float* rss; const float* cs; const float* sn;
    u16 *Q, *K, *V, *QI, *KI, *GQK, *GV, *GR, *UC; float *WI, *GL;
    PG8_LAS unsigned char* xl;
    __device__ __forceinline__ void operator()(const f32x4 (&acc)[2][2][4][2], const Unit& u, int wr, int wc, int fr, int fq) const {
        asm volatile("" : "+v"(fr), "+v"(fq));
        const int pn = u.pn, ln = fq * 16 + fr;
        const bool ropetile = (pn < 4) || pn == 6 || pn == 7;
        PG8_LAS float* rsL = (PG8_LAS float*)xl; PG8_LAS u32x4* csL = (PG8_LAS u32x4*)(xl + 1024);
        {   const int t = (wr * 4 + wc) * 64 + ln, r = t >> 1, part = t & 1, grow = u.row0 + r;
            const f32x4 pa = *(const gf32x4_t*)(rss + (size_t)grow * 16 + 8 * part), pb = *(const gf32x4_t*)(rss + (size_t)grow * 16 + 8 * part + 4);
            f32x4 ca = {0.f, 0.f, 0.f, 0.f}, sa = ca;
            if (ropetile) { ca = *(const gf32x4_t*)(cs + (size_t)grow * 8 + 4 * part); sa = *(const gf32x4_t*)(sn + (size_t)grow * 8 + 4 * part); }
            float sm = ((pa[0] + pa[1]) + (pa[2] + pa[3])) + ((pb[0] + pb[1]) + (pb[2] + pb[3]));
            sm += shfl_xorL(sm, 1, ln);
            if (part == 0) rsL[r] = rsqrtf(sm * (1.f / D_MODEL) + EPS);
            if (ropetile) { u32x4 w; w.x = pkh(ca[0], ca[1]); w.y = pkh(ca[2], ca[3]); w.z = pkh(sa[0], sa[1]); w.w = pkh(sa[2], sa[3]); csL[t] = w; }
            asm volatile("s_waitcnt lgkmcnt(0)" ::: "memory"); __builtin_amdgcn_s_barrier(); asm volatile("" ::: "memory");
        }
#pragma unroll
        for (int it = 0; it < 8; ++it) {
            const int ai = it >> 2, m = it & 3, lr = ai * HALF + wr * 64 + m * 16 + fr, row = u.row0 + lr;
            const float rs = rsL[lr];
            f32x4 c0 = {0.f, 0.f, 0.f, 0.f}, c1 = c0, s0 = c0, s1 = c0;
            if (ropetile) { const u32x4 e0 = csL[2 * lr], e1 = csL[2 * lr + 1];
                c0 = (f32x4){h2f(e0.x & 0xffffu), h2f(e0.x >> 16), h2f(e0.y & 0xffffu), h2f(e0.y >> 16)}; s0 = (f32x4){h2f(e0.z & 0xffffu), h2f(e0.z >> 16), h2f(e0.w & 0xffffu), h2f(e0.w >> 16)};
                c1 = (f32x4){h2f(e1.x & 0xffffu), h2f(e1.x >> 16), h2f(e1.y & 0xffffu), h2f(e1.y >> 16)}; s1 = (f32x4){h2f(e1.z & 0xffffu), h2f(e1.z >> 16), h2f(e1.w & 0xffffu), h2f(e1.w >> 16)}; }
#pragma unroll
            for (int bj = 0; bj < 2; ++bj) {
                f32x4 v0 = acc[ai][bj][m][0] * rs, v1 = acc[ai][bj][m][1] * rs;
                const int cl = bj * HALF + wc * 32 + fq * 8;
                if (ropetile) {
                    f32x4 p0, p1;
#pragma unroll
                    for (int e = 0; e < 4; ++e) { p0[e] = shfl_xorL(v0[e], 16, ln); p1[e] = shfl_xorL(v1[e], 16, ln); }
                    const bool dorope = ((wc & 1) == 0) && (fq < 2) && (pn != 7 || (bj == 0 && wc == 0));
                    if (dorope) {
                        if (fq == 0) { v0 = v0 * c0 - p0 * s0; v1 = v1 * c1 - p1 * s1; }
                        else         { v0 = v0 * c0 + p0 * s0; v1 = v1 * c1 + p1 * s1; }
                    }
                }
                if (pn < 2)       { *(gu32x4_t*)(Q + (size_t)row * 512 + pn * 256 + cl) = pack8_bf(v0 * C2, v1 * C2); }
                else if (pn < 4)  { *(gu32x4_t*)(K + (size_t)row * 512 + (pn - 2) * 256 + cl) = pack8_bf(v0, v1); }
                else if (pn < 6)  { *(gu32x4_t*)(V + (size_t)row * 512 + (pn - 4) * 256 + cl) = pack8_bf(v0, v1); }
                else if (pn == 6) { *(gu32x4_t*)(QI + (size_t)row * 256 + cl) = pack8_h(v0, v1); }
                else if (pn == 7) {
                    if (cl < 64) *(gu32x4_t*)(KI + (size_t)row * 64 + cl) = pack8_h(v0, v1);
                    else if (cl == 64) *(gf32x4_t*)(WI + (size_t)row * 4) = v0;
                    else if (cl == 72) { *(gf32x4_t*)(GL + (size_t)row * 16) = v0; *(gf32x4_t*)(GL + (size_t)row * 16 + 4) = v1; }
                    else if (cl == 80) { *(gf32x4_t*)(GL + (size_t)row * 16 + 8) = v0; *(gf32x4_t*)(GL + (size_t)row * 16 + 12) = v1; }
                }
                else if (pn == 8) { *(gu32x4_t*)(GQK + (size_t)row * 256 + cl) = pack8_bf(v0, v1); }
                else if (pn == 9) { *(gu32x4_t*)(GV + (size_t)row * 256 + cl) = pack8_bf(v0, v1); }
                else if (pn == 10) { *(gu32x4_t*)(GR + (size_t)row * 256 + cl) = pack8_bf(v0, v1); }
                else { *(gu32x4_t*)(UC + (size_t)row * 256 + cl) = pack8_bf(v0, v1); }
            }
        }
    }
};
struct EpiResid {
    static constexpr bool PERM = true, AFTER_DRAIN = false;
    u16* X; float* rss;
    __device__ __forceinline__ void operator()(const f32x4 (&acc)[2][2][4][2], const Unit& u, int wr, int wc, int fr, int fq) const {
        asm volatile("" : "+v"(fr), "+v"(fq));
        const int ln = fq * 16 + fr;
        u16* xb = X + (size_t)(u.row0 + wr * 64 + fr) * D_MODEL + u.pn * BM + wc * 32 + fq * 8;
        u32x4 xw[2][4][2];
#pragma unroll
        for (int ai = 0; ai < 2; ++ai)
#pragma unroll
            for (int m = 0; m < 4; ++m)
#pragma unroll
                for (int bj = 0; bj < 2; ++bj) xw[ai][m][bj] = *(const gu32x4_t*)(xb + (size_t)(ai * HALF + m * 16) * D_MODEL + bj * HALF);
#pragma unroll
        for (int ai = 0; ai < 2; ++ai)
#pragma unroll
            for (int m = 0; m < 4; ++m) {
                const int row = u.row0 + ai * HALF + wr * 64 + m * 16 + fr; float ss = 0.f;
#pragma unroll
                for (int bj = 0; bj < 2; ++bj) {
                    const u32x4 w = xw[ai][m][bj];
                    const f32x4 o0 = (f32x4){h2f(w[0] & 0xffffu), h2f(w[0] >> 16), h2f(w[1] & 0xffffu), h2f(w[1] >> 16)} + acc[ai][bj][m][0];
                    const f32x4 o1 = (f32x4){h2f(w[2] & 0xffffu), h2f(w[2] >> 16), h2f(w[3] & 0xffffu), h2f(w[3] >> 16)} + acc[ai][bj][m][1];
                    ss += (o0[0] * o0[0] + o0[1] * o0[1]) + (o0[2] * o0[2] + o0[3] * o0[3]) + (o1[0] * o1[0] + o1[1] * o1[1]) + (o1[2] * o1[2] + o1[3] * o1[3]);
                    *(gu32x4_t*)(xb + (size_t)(ai * HALF + m * 16) * D_MODEL + bj * HALF) = pack8_h(o0, o1);
                }
                ss += shfl_xorL(ss, 16, ln); ss += shfl_xorL(ss, 32, ln);
                if (fq == 0) *(__attribute__((address_space(1))) float*)(rss + (size_t)row * 16 + u.pn * 4 + wc) = ss;
            }
    }
};
struct EpiUp {
    static constexpr bool PERM = true, AFTER_DRAIN = false;
    const float* rss; u16* AB;
    __device__ __forceinline__ void operator()(const f32x4 (&acc)[2][2][4][2], const Unit& u, int wr, int wc, int fr, int fq) const {
        asm volatile("" : "+v"(fr), "+v"(fq));
#pragma unroll
        for (int ai = 0; ai < 2; ++ai)
#pragma unroll
            for (int m = 0; m < 4; ++m) {
                const int row = u.row0 + ai * HALF + wr * 64 + m * 16 + fr; const float rs = row_rs(rss, row);
#pragma unroll
                for (int bj = 0; bj < 2; ++bj) *(u32x4*)(AB + (size_t)row * (2 * D_FF) + u.pn * BM + bj * HALF + wc * 32 + fq * 8) = pack8_h(acc[ai][bj][m][0] * rs, acc[ai][bj][m][1] * rs);
            }
    }
};


struct EpiUpConv {
    static constexpr bool PERM = true, AFTER_DRAIN = false;
    const float* rss; const float* cw; const float* cb; u16* G; PG8_LAS float* xl;
    __device__ __forceinline__ void operator()(const f32x4 (&acc_)[2][2][4][2], const Unit& u, int wr, int wc, int fr, int fq) const {
        { int l_; asm volatile("v_mbcnt_lo_u32_b32 %0, -1, 0\n\tv_mbcnt_hi_u32_b32 %0, -1, %0" : "=v"(l_)); fr = l_ & 15; fq = l_ >> 4; }
        f32x4 (&acc)[2][2][4][2] = const_cast<f32x4 (&)[2][2][4][2]>(acc_);
        const int cl = wc * 32 + fq * 8, f0 = u.pn * HALF + cl;
        float rsv[8]; f32x4 rq[8];
#pragma unroll
        for (int ai = 0; ai < 2; ++ai)
#pragma unroll
            for (int m = 0; m < 4; ++m) { rq[ai * 4 + m] = *(const gf32x4_t*)(rss + (size_t)(u.row0 + ai * HALF + wr * 64 + m * 16 + fr) * 16 + 4 * fq); }
        __builtin_amdgcn_sched_barrier(0);
#pragma unroll
        for (int i = 0; i < 8; ++i) rsv[i] = (rq[i][0] + rq[i][1]) + (rq[i][2] + rq[i][3]);
#pragma unroll
        for (int i = 0; i < 8; ++i) { float t = rsv[i]; t += shfl_xorL(t, 16, fq * 16 + fr); t += shfl_xorL(t, 32, fq * 16 + fr); rsv[i] = rsqrtf(t * (1.f / D_MODEL) + EPS); }
#pragma unroll
        for (int ai = 0; ai < 2; ++ai)
#pragma unroll
            for (int m = 0; m < 4; ++m) { const float rs = rsv[ai * 4 + m];
#pragma unroll
                for (int bj = 0; bj < 2; ++bj) { acc[ai][bj][m][0] = acc[ai][bj][m][0] * rs; acc[ai][bj][m][1] = acc[ai][bj][m][1] * rs; } }
        if (fr >= 14) {
#pragma unroll
            for (int ai = 0; ai < 2; ++ai) { PG8_LAS float* d = xl + (((ai * 2 + wr) * 2 + (fr - 14)) * HALF + cl); *(PG8_LAS f32x4*)d = acc[ai][0][3][0]; *(PG8_LAS f32x4*)(d + 4) = acc[ai][0][3][1]; }
        }
        asm volatile("s_waitcnt lgkmcnt(0)" ::: "memory"); __builtin_amdgcn_s_barrier(); asm volatile("" ::: "memory");
#pragma unroll
        for (int ai = 0; ai < 2; ++ai) {
            unsigned hw[4][2];
#pragma unroll
            for (int n = 0; n < 2; ++n) {
                const int f = f0 + 4 * n;
                f32x4 wa = *(const gf32x4_t*)(cw + f), wb = *(const gf32x4_t*)(cw + D_FF + f), wc2 = *(const gf32x4_t*)(cw + 2 * D_FF + f), cbv = *(const gf32x4_t*)(cb + f);
                asm volatile("" : "+v"(wa), "+v"(wb), "+v"(wc2), "+v"(cbv));
                const int pseg = ai * 2 + wr - 1;
                f32x4 xm1 = {0.f, 0.f, 0.f, 0.f}, xm2 = xm1;
                if (pseg >= 0) { xm2 = *(PG8_LAS const f32x4*)(xl + ((pseg * 2 + 0) * HALF + cl + 4 * n)); xm1 = *(PG8_LAS const f32x4*)(xl + ((pseg * 2 + 1) * HALF + cl + 4 * n)); }
#pragma unroll
                for (int m = 0; m < 4; ++m) {
                    const int lr = ai * HALF + wr * 64 + m * 16 + fr;
                    const f32x4 a0 = acc[ai][0][m][n], bb = acc[ai][1][m][n]; f32x4 a1, a2;
#pragma unroll
                    for (int e = 0; e < 4; ++e) {
                        int o1, o2;
                        if (m == 0) { o1 = __float_as_int(xm1[e]); o2 = __float_as_int(fr == 0 ? xm2[e] : xm1[e]); }
                        else { const int pv = __float_as_int(acc[ai][0][m - 1][n][e]); o1 = __builtin_amdgcn_update_dpp(0, pv, 0x121, 0xf, 0xf, false); o2 = __builtin_amdgcn_update_dpp(0, pv, 0x122, 0xf, 0xf, false); }
                        const int cur = __float_as_int(a0[e]);
                        a1[e] = __int_as_float(__builtin_amdgcn_update_dpp(o1, cur, 0x111, 0xf, 0xf, false));
                        a2[e] = __int_as_float(__builtin_amdgcn_update_dpp(o2, cur, 0x112, 0xf, 0xf, false));
                    }
                    const f32x4 cv = cbv + a2 * wa + a1 * wb + a0 * wc2; f32x4 gv;
#pragma unroll
                    for (int e = 0; e < 4; ++e) gv[e] = cv[e] * __builtin_amdgcn_rcpf(1.f + __expf(-cv[e])) * bb[e];
                    if (n == 0) { hw[m][0] = pkh(gv[0], gv[1]); hw[m][1] = pkh(gv[2], gv[3]); }
                    else if (lr >= u.lo) { u32x4 w; w.x = hw[m][0]; w.y = hw[m][1]; w.z = pkh(gv[0], gv[1]); w.w = pkh(gv[2], gv[3]); *(gu32x4_t*)(G + (size_t)(u.row0 + lr) * D_FF + f0) = w; }
                    __builtin_amdgcn_sched_barrier(0);
                }
            }
        }
    }
};
template <class Epi, class Sched, bool ALIGN_EPI = false, bool SP2 = false, bool F16 = false>
__device__ __forceinline__ void gemm_phase(PG8_LAS unsigned char* lds, const Gemm g, const Sched& S, const Epi& E, const int WV) {
    const int tid = otid(WV), wid = __builtin_amdgcn_readfirstlane(tid >> 6), lane = tid & 63, wr = wid >> 2, wc = wid & 3, fr = lane & 15, fq = lane >> 4;
    const int K = g.K, nt = K / BK;
    unsigned voffA[2], voffB[2];
#pragma unroll
    for (int i = 0; i < 2; ++i) { int R, C; stage_rc(tid * 16 + i * 8192, R, C); const int Rb = Epi::PERM ? ((R & ~31) + perm32(R & 31)) : R;
        voffA[i] = (unsigned)(R * g.lda + C) * 2u; voffB[i] = (unsigned)(Rb * K + C) * 2u; }
    const size_t kstep = (size_t)(BK * 2);
    const size_t hstepA = (size_t)HALF * g.lda * 2, hstepB = (size_t)HALF * K * 2;
    const size_t rstepA = (size_t)g.lda * 2, tstepB = 2 * hstepB;
    const unsigned ldsw = (unsigned)wid * 1024u;
    const int aoff = lds_byte(wr * 64 + fr, fq * 8), boff = lds_byte(wc * 32 + fr, fq * 8);
#define PG8_SA(b, h) (((b) * 2 + (h)) * HTB)
#define PG8_SB(b, h) ((4 + (b) * 2 + (h)) * HTB)
#define PG8_STAGE(bufoff, gbase, voff) do { _Pragma("unroll") for (int _i = 0; _i < 2; ++_i) \
        __builtin_amdgcn_global_load_lds((const unsigned*)((const char*)(gbase) + (voff)[_i]), (PG8_LAS unsigned*)(lds + (bufoff) + ldsw + _i * 8192), 16, 0, 0); } while (0)
#define PG8_LDA(dst, b, h) do { _Pragma("unroll") for (int m = 0; m < 4; ++m) _Pragma("unroll") for (int k = 0; k < 2; ++k) dst[m][k] = *(const PG8_LAS bf16x8*)(lds + PG8_SA(b, h) + aoff + m * 2048 + k * 1024); } while (0)
#define PG8_LDB(dst, b, h) do { _Pragma("unroll") for (int n = 0; n < 2; ++n) _Pragma("unroll") for (int k = 0; k < 2; ++k) dst[n][k] = *(const PG8_LAS bf16x8*)(lds + PG8_SB(b, h) + boff + n * 2048 + k * 1024); } while (0)
#define PG8_MMA(ai, bj, At, Bt) do { __builtin_amdgcn_s_setprio(1); _Pragma("unroll") for (int m = 0; m < 4; ++m) _Pragma("unroll") for (int n = 0; n < 2; ++n) _Pragma("unroll") for (int k = 0; k < 2; ++k) \
        acc[ai][bj][m][n] = F16 ? __builtin_amdgcn_mfma_f32_16x16x32_f16(__builtin_bit_cast(f16x8, Bt[n][k]), __builtin_bit_cast(f16x8, At[m][k]), acc[ai][bj][m][n], 0, 0, 0) : __builtin_amdgcn_mfma_f32_16x16x32_bf16(Bt[n][k], At[m][k], acc[ai][bj][m][n], 0, 0, 0); __builtin_amdgcn_s_setprio(0); } while (0)
#define PG8_WAIT_V(n) asm volatile("s_waitcnt vmcnt(" #n ")" ::: "memory")
#define PG8_WAIT_L(n) asm volatile("s_waitcnt lgkmcnt(" #n ")" ::: "memory")
#define PG8_BAR __builtin_amdgcn_s_barrier()
#define PG8_SCHED __builtin_amdgcn_sched_barrier(0)
    Unit cur, nxt; int ui = 0;
    if (!S.next(0, cur)) return;
    f32x4 acc[2][2][4][2];
#pragma unroll
    for (int a = 0; a < 2; ++a)
#pragma unroll
        for (int b = 0; b < 2; ++b)
#pragma unroll
            for (int m = 0; m < 4; ++m)
#pragma unroll
                for (int n = 0; n < 2; ++n) acc[a][b][m][n] = (f32x4){0.f, 0.f, 0.f, 0.f};
    bf16x8 At[4][2], B0[2][2], B1[2][2];
    const char* cA = (const char*)g.A + (size_t)cur.row0 * rstepA; const char* cB = (const char*)g.Bt + (size_t)cur.pn * tstepB;
    S.a_ready(cur);
    if constexpr (SP2) {
        PG8_STAGE(PG8_SB(0, 0), cB, voffB); PG8_STAGE(PG8_SB(0, 1), cB + hstepB, voffB); PG8_STAGE(PG8_SA(0, 0), cA, voffA); PG8_STAGE(PG8_SA(0, 1), cA + hstepA, voffA);
        if (wr == 1) PG8_BAR;
        PG8_WAIT_V(2); PG8_BAR;
        PG8_STAGE(PG8_SB(1, 0), cB + kstep, voffB); PG8_STAGE(PG8_SA(1, 0), cA + kstep, voffA); PG8_STAGE(PG8_SB(1, 1), cB + hstepB + kstep, voffB);
        PG8_WAIT_V(6); PG8_BAR;
    } else {
        PG8_STAGE(PG8_SB(0, 0), cB, voffB); PG8_STAGE(PG8_SA(0, 0), cA, voffA); PG8_STAGE(PG8_SB(0, 1), cB + hstepB, voffB); PG8_STAGE(PG8_SA(0, 1), cA + hstepA, voffA);
        if (wr == 1) PG8_BAR;
        PG8_WAIT_V(4); PG8_BAR;
        PG8_STAGE(PG8_SB(1, 0), cB + kstep, voffB); PG8_STAGE(PG8_SA(1, 0), cA + kstep, voffA); PG8_STAGE(PG8_SB(1, 1), cB + hstepB + kstep, voffB);
        PG8_WAIT_V(6); PG8_BAR;
    }
    for (;;) {
        const bool has_next = S.next(ui + 1, nxt);
        const char* nA = has_next ? (const char*)g.A + (size_t)nxt.row0 * rstepA : cA; const char* nB = has_next ? (const char*)g.Bt + (size_t)nxt.pn * tstepB : cB;
        for (int t = 0; t < nt; t += 2) {
            const bool last = (t == nt - 2);
            const char* a1 = cA + (size_t)(t + 1) * kstep;
            const char* a2 = last ? nA : cA + (size_t)(t + 2) * kstep; const char* b2 = last ? nB : cB + (size_t)(t + 2) * kstep;
            const char* a3 = a2 + kstep; const char* b3 = b2 + kstep;
            if (last && has_next) S.a_ready(nxt);
            if constexpr (SP2) {
            PG8_LDB(B0, 0, 0); PG8_LDB(B1, 0, 1); PG8_SCHED; PG8_LDA(At, 0, 0); PG8_STAGE(PG8_SA(1, 1), a1 + hstepA, voffA);
            PG8_WAIT_V(8); PG8_WAIT_L(0); PG8_BAR; PG8_MMA(0, 0, At, B0); PG8_MMA(0, 1, At, B1); PG8_BAR; PG8_SCHED;
            PG8_LDA(At, 0, 1); PG8_STAGE(PG8_SB(0, 0), b2, voffB); PG8_STAGE(PG8_SB(0, 1), b2 + hstepB, voffB); PG8_STAGE(PG8_SA(0, 0), a2, voffA);
            PG8_WAIT_V(8); PG8_WAIT_L(0); PG8_BAR; PG8_MMA(1, 0, At, B0); PG8_MMA(1, 1, At, B1); PG8_BAR; PG8_SCHED;
            PG8_LDB(B0, 1, 0); PG8_LDB(B1, 1, 1); PG8_SCHED; PG8_LDA(At, 1, 0); PG8_STAGE(PG8_SA(0, 1), a2 + hstepA, voffA);
            PG8_WAIT_V(8); PG8_WAIT_L(0); PG8_BAR; PG8_MMA(0, 0, At, B0); PG8_MMA(0, 1, At, B1); PG8_BAR; PG8_SCHED;
            PG8_LDA(At, 1, 1); PG8_STAGE(PG8_SB(1, 0), b3, voffB); PG8_STAGE(PG8_SB(1, 1), b3 + hstepB, voffB); PG8_STAGE(PG8_SA(1, 0), a3, voffA);
            PG8_WAIT_V(8); PG8_WAIT_L(0); PG8_BAR; PG8_MMA(1, 0, At, B0); PG8_MMA(1, 1, At, B1); PG8_BAR; PG8_SCHED;
            } else {
            PG8_LDB(B0, 0, 0); PG8_SCHED; PG8_LDA(At, 0, 0); PG8_STAGE(PG8_SA(1, 1), a1 + hstepA, voffA);
            PG8_WAIT_L(8); PG8_BAR; PG8_WAIT_L(0); PG8_MMA(0, 0, At, B0); PG8_BAR; PG8_SCHED;
            PG8_LDB(B1, 0, 1); PG8_STAGE(PG8_SB(0, 0), b2, voffB);
            PG8_BAR; PG8_WAIT_L(0); PG8_MMA(0, 1, At, B1); PG8_BAR;
            PG8_LDA(At, 0, 1); PG8_STAGE(PG8_SA(0, 0), a2, voffA);
            PG8_BAR; PG8_WAIT_L(0); PG8_MMA(1, 0, At, B0); PG8_BAR; PG8_SCHED;
            PG8_STAGE(PG8_SB(0, 1), b2 + hstepB, voffB);
            PG8_WAIT_V(6); PG8_BAR; PG8_MMA(1, 1, At, B1); PG8_BAR;
            PG8_LDB(B0, 1, 0); PG8_SCHED; PG8_LDA(At, 1, 0); PG8_STAGE(PG8_SA(0, 1), a2 + hstepA, voffA);
            PG8_WAIT_L(8); PG8_BAR; PG8_WAIT_L(0); PG8_MMA(0, 0, At, B0); PG8_BAR; PG8_SCHED;
            PG8_LDB(B1, 1, 1); PG8_STAGE(PG8_SB(1, 0), b3, voffB);
            PG8_BAR; PG8_WAIT_L(0); PG8_MMA(0, 1, At, B1); PG8_BAR;
            PG8_LDA(At, 1, 1); PG8_STAGE(PG8_SA(1, 0), a3, voffA);
            PG8_BAR; PG8_WAIT_L(0); PG8_MMA(1, 0, At, B0); PG8_BAR; PG8_SCHED;
            PG8_STAGE(PG8_SB(1, 1), b3 + hstepB, voffB);
            PG8_WAIT_V(6); PG8_BAR; PG8_MMA(1, 1, At, B1); PG8_BAR;
            }
        }
        if constexpr (ALIGN_EPI) { if (wr == 0) PG8_BAR; }
        if constexpr (!Epi::AFTER_DRAIN) { E(acc, cur, wr, wc, fr, fq); S.done(cur); }
        if (!has_next) break;
#pragma unroll
        for (int a = 0; a < 2; ++a)
#pragma unroll
            for (int b = 0; b < 2; ++b)
#pragma unroll
                for (int m = 0; m < 4; ++m)
#pragma unroll
                    for (int n = 0; n < 2; ++n) acc[a][b][m][n] = (f32x4){0.f, 0.f, 0.f, 0.f};
        cur = nxt; cA = nA; cB = nB; ++ui;
        if constexpr (ALIGN_EPI) { if (wr == 1) PG8_BAR; }
    }
    PG8_WAIT_V(0);
    if constexpr (!ALIGN_EPI) { if (wr == 0) PG8_BAR; }
    PG8_BAR;
    if constexpr (Epi::AFTER_DRAIN) { E.fused(acc, cur, wr, wc, fr, fq, lds, wid, lane); S.done(cur); }
#undef PG8_SA
#undef PG8_SB
#undef PG8_STAGE
#undef PG8_LDA
#undef PG8_LDB
#undef PG8_MMA
#undef PG8_WAIT_V
#undef PG8_WAIT_L
#undef PG8_BAR
#undef PG8_SCHED
}
}

#define LAS __attribute__((address_space(3)))
constexpr int NWAVES = 8, NTHR = 512;
constexpr int LDS_BYTES = 147456;
typedef float f32x4 __attribute__((ext_vector_type(4)));
typedef unsigned u32x4 __attribute__((ext_vector_type(4)));

struct Params {
    const float* x; const int* pos; const float* norm1_g; const float* w_in; const float* w_gate_up; const float* b_gate; const float* gla_norm_g; const float* w_pool;
    const float* pool_scale; const float* w_out; const float* norm2_g; const float* w_up; const float* conv_w; const float* conv_b; const float* w_down; const float* final_g;
    float* out; unsigned char* ws; long long layer;
};

constexpr int CW_FAIL = 16, CW_QTOPK = 64, CW_QATT = 128, CW_SCAN = 256;
__device__ __forceinline__ unsigned f2ord(float x) { const unsigned u = __float_as_uint(x + 0.0f); return u ^ ((unsigned)((int)u >> 31) | 0x80000000u); }
struct CmIdent { __device__ __forceinline__ int operator()(int n) const { return n; } };
struct CmUp { __device__ __forceinline__ int operator()(int n) const { const int t = n >> 8, r = n & 255; return (r < 128) ? 128 * t + r : D_FF + 128 * t + (r - 128); } };
struct CmWin {
    __device__ __forceinline__ int operator()(int n) const {
        if (n < 1860) return n;
        if (n < 1864) return -1;
        if (n < 1880) return 2628 + (n - 1864);
        if (n < 2048) return -1;
        if (n < 2304) return 1860 + (n - 2048);
        if (n < 2560) return 2116 + (n - 2304);
        if (n < 2816) return 2372 + (n - 2560);
        return 2644 + (n - 2816);
    }
};
__device__ __forceinline__ int wconv_items(int which) { return which == 0 ? (D_MODEL / 64) * (NPROJ / 32) : which == 1 ? (D_MODEL / 64) * (D_MODEL / 32) : which == 2 ? (D_MODEL / 64) * (2 * D_FF / 32) : (D_FF / 64) * (D_MODEL / 32); }
struct TrItem { const float* W; u16* WT; int kofs, Nsrc, K, k0, n0, sc; };
constexpr int TR_SCR_BYTES = 8704, TR_GAIN_OFF = 73728;
__device__ __forceinline__ void tr_decode(const Params& p, unsigned segs, int nseg, int g, int lane, TrItem& t) {
    unsigned char* ws = opq(p.ws);
#pragma unroll
    for (int sgi = 0; sgi < nseg; ++sgi) {
        const int code = (segs >> (4 * sgi)) & 15, l = code >> 2, which = code & 3, n = wconv_items(which);
        if (g >= 0 && g < n) {
            int nblk, nn;
            if (which == 0) { t.W = p.w_in + (size_t)l * D_MODEL * IN_WIDTH; t.K = D_MODEL; t.Nsrc = IN_WIDTH; t.WT = (u16*)(ws + (l ? WS_WIN1 : WS_WIN0)); t.kofs = 1024 * (1 + l); nblk = NPROJ / 32; }
            else if (which == 1) { t.W = p.w_out + (size_t)l * D_MODEL * D_MODEL; t.K = D_MODEL; t.Nsrc = D_MODEL; t.WT = (u16*)(ws + (l ? WS_WOUT1 : WS_WOUT0)); t.kofs = 0; nblk = D_MODEL / 32; }
            else if (which == 2) { t.W = p.w_up + (size_t)l * D_MODEL * 2 * D_FF; t.K = D_MODEL; t.Nsrc = 2 * D_FF; t.WT = (u16*)(ws + WS_WUP); t.kofs = 1024 * (3 + l); nblk = 2 * D_FF / 32; }
            else { t.W = p.w_down + (size_t)l * D_FF * D_MODEL; t.K = D_FF; t.Nsrc = D_MODEL; t.WT = (u16*)(ws + WS_WDN); t.kofs = 0; nblk = D_MODEL / 32; }
            t.k0 = 64 * (g / nblk); t.n0 = 32 * (g % nblk); nn = t.n0 + 2 * (lane & 15); if (t.kofs) t.kofs += t.k0;
            t.sc = (which == 0) ? CmWin{}(nn) : (which == 2) ? CmUp{}(nn) : nn;
        }
        g -= n;
    }
}
typedef float f32x2v __attribute__((ext_vector_type(2)));
__device__ __forceinline__ void tr_load(const TrItem& t, int lane, f32x2v (&v)[16]) {
    const char* base = (const char*)t.W; const unsigned step = 16u * (unsigned)t.Nsrc;
    unsigned off = 4u * ((unsigned)(t.k0 + (lane >> 4)) * (unsigned)t.Nsrc + (unsigned)(t.sc < 0 ? 0 : t.sc));
#pragma unroll
    for (int i = 0; i < 16; ++i) { v[i] = *(const __attribute__((address_space(1))) f32x2v*)(base + off); off += step; }
}
__device__ __forceinline__ void tr_store(const TrItem& t, int lane, const f32x2v (&v)[16], LAS float* scr, const LAS float* gains) {
    const int c = lane & 7;
    const LAS float* kl = gains + t.kofs + 8 * c; const f32x4 ks0 = *(const LAS f32x4*)kl, ks1 = *(const LAS f32x4*)(kl + 4);
#pragma unroll
    for (int i = 0; i < 16; ++i) { const int kk = 4 * i + (lane >> 4); LAS float* d = scr + kk * 33 + 2 * (lane & 15); d[0] = (t.sc >= 0) ? v[i][0] : 0.f; d[1] = (t.sc >= 0) ? v[i][1] : 0.f; }
    asm volatile("s_waitcnt lgkmcnt(0)" ::: "memory");
#pragma unroll
    for (int j = 0; j < 4; ++j) { const int n = (lane >> 3) + 8 * j; const LAS float* sp = scr + (8 * c) * 33 + n;
        u32x4 o; o.x = pkh(sp[0 * 33] * ks0[0], sp[1 * 33] * ks0[1]); o.y = pkh(sp[2 * 33] * ks0[2], sp[3 * 33] * ks0[3]); o.z = pkh(sp[4 * 33] * ks1[0], sp[5 * 33] * ks1[1]); o.w = pkh(sp[6 * 33] * ks1[2], sp[7 * 33] * ks1[3]);
        *(__attribute__((address_space(1))) u32x4*)(t.WT + (size_t)(t.n0 + n) * t.K + t.k0 + 8 * c) = o; }
    asm volatile("s_waitcnt lgkmcnt(0)" ::: "memory");
}
__device__ __forceinline__ void wconv_stream(const Params& p, unsigned segs, int nseg, int total, LAS float* scr, const LAS float* gains, int lane, int gw, int NGW) {
    int g = gw; asm volatile("" : "+s"(g));
    if (g >= total) return;
    TrItem ia, ib; f32x2v va[16], vb[16];
    tr_decode(p, segs, nseg, g, lane, ia); tr_load(ia, lane, va);
#pragma unroll 1
    while (true) {
        { const int gn = g + NGW; const bool more = gn < total; ib = ia;
          if (more) tr_decode(p, segs, nseg, gn, lane, ib); else ib.Nsrc = 0;
          tr_load(ib, lane, vb);
          __builtin_amdgcn_sched_barrier(0);
          tr_store(ia, lane, va, scr, gains);
          if (!more) break; g = gn; }
        { const int gn = g + NGW; const bool more = gn < total; ia = ib;
          if (more) tr_decode(p, segs, nseg, gn, lane, ia); else ia.Nsrc = 0;
          tr_load(ia, lane, va);
          __builtin_amdgcn_sched_barrier(0);
          tr_store(ib, lane, vb, scr, gains);
          if (!more) break; g = gn; }
    }
}
__device__ __forceinline__ void tr_fill_gains(const Params& p, LAS float* gains, int tid) {
    for (int i = tid; i < 1024; i += NTHR) { gains[i] = 1.f; gains[1024 + i] = p.norm1_g[i]; gains[2048 + i] = p.norm1_g[1024 + i]; gains[3072 + i] = p.norm2_g[i]; gains[4096 + i] = p.norm2_g[1024 + i]; }
}
__device__ __forceinline__ void xg_row(const float* xrow, u16* orow, float* rssrow, int lane) {
    const f32x4* xr = (const f32x4*)xrow + lane; f32x4 v[4]; float ss = 0.f;
#pragma unroll
    for (int j = 0; j < 4; ++j) { v[j] = xr[64 * j]; ss += (v[j][0] * v[j][0] + v[j][1] * v[j][1]) + (v[j][2] * v[j][2] + v[j][3] * v[j][3]); }
    ss = wave_sum(ss);
#pragma unroll
    for (int j = 0; j < 4; ++j) { uint2 w; w.x = pkh(v[j][0], v[j][1]); w.y = pkh(v[j][2], v[j][3]); *((uint2*)orow + lane + 64 * j) = w; }
    if (lane < 16) rssrow[lane] = (lane == 0) ? ss : 0.f;
}

__device__ __forceinline__ void xg_row4(const float* xrow, u16* orow, float* rssrow, int lane) {
    typedef __attribute__((address_space(1))) f32x4 gx4;
    const gx4* xr = (const gx4*)xrow + lane; f32x4 v[16]; float sm[4] = {0.f, 0.f, 0.f, 0.f};
#pragma unroll
    for (int j = 0; j < 16; ++j) v[j] = xr[64 * j];
#pragma unroll
    for (int j = 0; j < 16; ++j) sm[j >> 2] += (v[j][0] * v[j][0] + v[j][1] * v[j][1]) + (v[j][2] * v[j][2] + v[j][3] * v[j][3]);
#pragma unroll
    for (int r = 0; r < 4; ++r) sm[r] = wave_sum(sm[r]);
#pragma unroll
    for (int j = 0; j < 16; ++j) { uint2 w; w.x = pkh(v[j][0], v[j][1]); w.y = pkh(v[j][2], v[j][3]); *((uint2*)orow + lane + 64 * j) = w; }
    rssrow[lane] = (lane == 0) ? sm[0] : (lane == 16) ? sm[1] : (lane == 32) ? sm[2] : (lane == 48) ? sm[3] : 0.f;
}
__device__ __forceinline__ void xg_row2(const float* xrow, u16* orow, float* rssrow, int lane) {
    const f32x4* xr = (const f32x4*)xrow + lane; f32x4 v[8]; float s0 = 0.f, s1 = 0.f;
#pragma unroll
    for (int j = 0; j < 8; ++j) v[j] = xr[64 * j];
#pragma unroll
    for (int j = 0; j < 4; ++j) { s0 += (v[j][0] * v[j][0] + v[j][1] * v[j][1]) + (v[j][2] * v[j][2] + v[j][3] * v[j][3]); s1 += (v[j + 4][0] * v[j + 4][0] + v[j + 4][1] * v[j + 4][1]) + (v[j + 4][2] * v[j + 4][2] + v[j + 4][3] * v[j + 4][3]); }
    s0 = wave_sum(s0); s1 = wave_sum(s1);
#pragma unroll
    for (int j = 0; j < 8; ++j) { uint2 w; w.x = pkh(v[j][0], v[j][1]); w.y = pkh(v[j][2], v[j][3]); *((uint2*)orow + lane + 64 * j) = w; }
    if (lane < 32) rssrow[lane] = (lane == 0) ? s0 : (lane == 16) ? s1 : 0.f;
}

typedef float f32x16 __attribute__((ext_vector_type(16)));
constexpr int TK_CAP = 1024, TK_R = 64;
constexpr int TKL_SAMP = 0, TKL_MT = 65536, TKL_ZM = 98304, TKL_W = 131072, TKL_LO = 131584, TKL_CNT = 131712, TKL_FLAG = 131840;

__device__ __forceinline__ float relu_s(float a) { float r; asm("v_max_f32_e32 %0, 0, %1" : "=v"(r) : "v"(a)); return r; }
__device__ __forceinline__ float fma_s(float a, float b, float c) { float r; asm("v_fma_f32 %0, %1, %2, %3" : "=v"(r) : "v"(a), "v"(b), "v"(c)); return r; }
__device__ __forceinline__ float mul_s(float a, float b) { float r; asm("v_mul_f32_e32 %0, %1, %2" : "=v"(r) : "v"(a), "v"(b)); return r; }
__device__ __forceinline__ void score2(float a0, float a1, float a2, float a3, const f32x4& w, float b0, float b1, float b2, float b3, const f32x4& x, float& s, float& r) {
    float t0, t1, u0, u1;
    asm("v_max_f32_e32 %2, 0, %6\n\tv_max_f32_e32 %4, 0, %14\n\t"
        "v_max_f32_e32 %3, 0, %7\n\tv_max_f32_e32 %5, 0, %15\n\t"
        "v_mul_f32_e32 %0, %10, %2\n\tv_mul_f32_e32 %1, %18, %4\n\t"
        "v_max_f32_e32 %2, 0, %8\n\tv_max_f32_e32 %4, 0, %16\n\t"
        "v_fma_f32 %0, %11, %3, %0\n\tv_fma_f32 %1, %19, %5, %1\n\t"
        "v_max_f32_e32 %3, 0, %9\n\tv_max_f32_e32 %5, 0, %17\n\t"
        "v_fma_f32 %0, %12, %2, %0\n\tv_fma_f32 %1, %20, %4, %1\n\t"
        "v_fma_f32 %0, %13, %3, %0\n\tv_fma_f32 %1, %21, %5, %1"
        : "=&v"(s), "=&v"(r), "=&v"(t0), "=&v"(t1), "=&v"(u0), "=&v"(u1)
        : "v"(a0), "v"(a1), "v"(a2), "v"(a3), "v"(w[0]), "v"(w[1]), "v"(w[2]), "v"(w[3]), "v"(b0), "v"(b1), "v"(b2), "v"(b3), "v"(x[0]), "v"(x[1]), "v"(x[2]), "v"(x[3]));
}
__device__ __forceinline__ void tk_load_b(const u16* __restrict__ KIb, int keybase, int keystride, int lane, f16x8 (&bf)[4]) {
    const u16* kp = KIb + (size_t)(keybase + keystride * (lane & 31)) * 64 + 8 * (lane >> 5);
#pragma unroll
    for (int ks = 0; ks < 4; ++ks) bf[ks] = *(const __attribute__((address_space(1))) f16x8*)(kp + 16 * ks);
}
__device__ __forceinline__ void tk_score_tile(const f16x8 (&bf)[4], const f16x8 (&af)[4][4], LAS const float* wtab, int lane, float (&score)[16]) {
    LAS const float* wtab_h = wtab + (lane >> 5) * 4;
#pragma unroll
    for (int blk = 0; blk < 4; ++blk) {
        f32x16 acc = {0.f, 0.f, 0.f, 0.f, 0.f, 0.f, 0.f, 0.f, 0.f, 0.f, 0.f, 0.f, 0.f, 0.f, 0.f, 0.f};
#pragma unroll
        for (int ks = 0; ks < 4; ++ks) acc = __builtin_amdgcn_mfma_f32_32x32x16_f16(af[blk][ks], bf[ks], acc, 0, 0, 0);
        asm volatile("s_nop 15\n\ts_nop 3" : "+v"(acc));
#pragma unroll
        for (int g = 0; g < 4; g += 2) {
            const f32x4 w = *(LAS const f32x4*)(wtab_h + (8 * blk + 2 * g) * 4), x = *(LAS const f32x4*)(wtab_h + (8 * blk + 2 * g + 2) * 4);
            score2(acc[4 * g], acc[4 * g + 1], acc[4 * g + 2], acc[4 * g + 3], w, acc[4 * g + 4], acc[4 * g + 5], acc[4 * g + 6], acc[4 * g + 7], x, score[blk * 4 + g], score[blk * 4 + g + 1]);
        }
        __builtin_amdgcn_sched_barrier(0);
    }
}
__device__ __forceinline__ void tk_score_tile_lds(const f16x8 (&bf)[4], LAS const unsigned char* afl, LAS const float* wtab, int lane, float (&score)[16]) {
    LAS const float* wtab_h = wtab + (lane >> 5) * 4;
    f16x8 a[4];
#pragma unroll
    for (int ks = 0; ks < 4; ++ks) a[ks] = *(LAS const f16x8*)(afl + ks * 1024 + lane * 16);
#pragma unroll
    for (int blk = 0; blk < 4; ++blk) {
        f16x8 an[4]; f32x4 w[4];
        if (blk < 3) {
#pragma unroll
            for (int ks = 0; ks < 4; ++ks) an[ks] = *(LAS const f16x8*)(afl + ((blk + 1) * 4 + ks) * 1024 + lane * 16);
        }
#pragma unroll
        for (int g = 0; g < 4; ++g) w[g] = *(LAS const f32x4*)(wtab_h + (8 * blk + 2 * g) * 4);
        f32x16 acc = {0.f, 0.f, 0.f, 0.f, 0.f, 0.f, 0.f, 0.f, 0.f, 0.f, 0.f, 0.f, 0.f, 0.f, 0.f, 0.f};
#pragma unroll
        for (int ks = 0; ks < 4; ++ks) acc = __builtin_amdgcn_mfma_f32_32x32x16_f16(a[ks], bf[ks], acc, 0, 0, 0);
        asm volatile("s_nop 15\n\ts_nop 3" : "+v"(acc));
#pragma unroll
        for (int g = 0; g < 4; g += 2)
            score2(acc[4 * g], acc[4 * g + 1], acc[4 * g + 2], acc[4 * g + 3], w[g], acc[4 * g + 4], acc[4 * g + 5], acc[4 * g + 6], acc[4 * g + 7], w[g + 1], score[blk * 4 + g], score[blk * 4 + g + 1]);
        if (blk < 3) {
#pragma unroll
            for (int ks = 0; ks < 4; ++ks) a[ks] = an[ks];
        }
        __builtin_amdgcn_sched_barrier(0);
    }
}
__device__ __forceinline__ void tk_score_tile_reg(const f16x8 (&bf)[4], const f16x8 (&af)[4][4], LAS const float* wtab, int lane, float (&score)[16]) {
    LAS const float* wtab_h = wtab + (lane >> 5) * 4;
#pragma unroll
    for (int blk = 0; blk < 4; ++blk) {
        f32x4 w[4];
#pragma unroll
        for (int g = 0; g < 4; ++g) w[g] = *(LAS const f32x4*)(wtab_h + (8 * blk + 2 * g) * 4);
        f32x16 acc = {0.f, 0.f, 0.f, 0.f, 0.f, 0.f, 0.f, 0.f, 0.f, 0.f, 0.f, 0.f, 0.f, 0.f, 0.f, 0.f};
#pragma unroll
        for (int ks = 0; ks < 4; ++ks) acc = __builtin_amdgcn_mfma_f32_32x32x16_f16(af[blk][ks], bf[ks], acc, 0, 0, 0);
        asm volatile("s_nop 15\n\ts_nop 3" : "+v"(acc));
#pragma unroll
        for (int g = 0; g < 4; g += 2)
            score2(acc[4 * g], acc[4 * g + 1], acc[4 * g + 2], acc[4 * g + 3], w[g], acc[4 * g + 4], acc[4 * g + 5], acc[4 * g + 6], acc[4 * g + 7], w[g + 1], score[blk * 4 + g], score[blk * 4 + g + 1]);
        __builtin_amdgcn_sched_barrier(0);
    }
}
__device__ __forceinline__ void tk_score_tile_regw(const f16x8 (&bf)[4], const f16x8 (&af)[4][4], const f32x4 (&wr)[4][4], float (&score)[16]) {
#pragma unroll
    for (int blk = 0; blk < 4; ++blk) {
        f32x16 acc = {0.f, 0.f, 0.f, 0.f, 0.f, 0.f, 0.f, 0.f, 0.f, 0.f, 0.f, 0.f, 0.f, 0.f, 0.f, 0.f};
#pragma unroll
        for (int ks = 0; ks < 4; ++ks) acc = __builtin_amdgcn_mfma_f32_32x32x16_f16(af[blk][ks], bf[ks], acc, 0, 0, 0);
        asm volatile("s_nop 15\n\ts_nop 3" : "+v"(acc));
#pragma unroll
        for (int g = 0; g < 4; g += 2)
            score2(acc[4 * g], acc[4 * g + 1], acc[4 * g + 2], acc[4 * g + 3], wr[blk][g], acc[4 * g + 4], acc[4 * g + 5], acc[4 * g + 6], acc[4 * g + 7], wr[blk][g + 1], score[blk * 4 + g], score[blk * 4 + g + 1]);
        __builtin_amdgcn_sched_barrier(0);
    }
}
__device__ __forceinline__ int wave_count(bool p) { return __builtin_popcountll(__ballot(p)); }


__device__ __forceinline__ int wave_isum(int c) {
    int r = c;
    r += __builtin_amdgcn_update_dpp(0, r, 0x111, 0xf, 0xf, true);
    r += __builtin_amdgcn_update_dpp(0, r, 0x112, 0xf, 0xf, true);
    r += __builtin_amdgcn_update_dpp(0, r, 0x114, 0xf, 0xf, true);
    r += __builtin_amdgcn_update_dpp(0, r, 0x118, 0xf, 0xf, true);
    r += __builtin_amdgcn_update_dpp(0, r, 0x142, 0xa, 0xf, true);
    r += __builtin_amdgcn_update_dpp(0, r, 0x143, 0xc, 0xf, true);
    return __builtin_amdgcn_readlane(r, 63);
}
__device__ __forceinline__ int count_ge16(const unsigned (&v)[16], unsigned cand) {
    int c0 = 0, c1 = 0;
#pragma unroll
    for (int e = 0; e < 16; e += 2) { c0 += (v[e] >= cand) ? 1 : 0; c1 += (v[e + 1] >= cand) ? 1 : 0; }
    return wave_isum(c0 + c1);
}
__device__ __forceinline__ int count_ge16s(const unsigned (&v)[16], unsigned g) {
    unsigned acc, t0, t1, t2, t3;
    asm("v_mov_b32 %0, 0\n\t"
        "v_sub_u32 %1, %5, %21\n\t"
        "v_sub_u32 %2, %6, %21\n\t"
        "v_sub_u32 %3, %7, %21\n\t"
        "v_sub_u32 %4, %8, %21\n\t"
        "v_lshrrev_b32 %1, 31, %1\n\t"
        "v_lshrrev_b32 %2, 31, %2\n\t"
        "v_lshrrev_b32 %3, 31, %3\n\t"
        "v_lshrrev_b32 %4, 31, %4\n\t"
        "v_add3_u32 %0, %0, %1, %2\n\t"
        "v_add3_u32 %0, %0, %3, %4\n\t"
        "v_sub_u32 %1, %9, %21\n\t"
        "v_sub_u32 %2, %10, %21\n\t"
        "v_sub_u32 %3, %11, %21\n\t"
        "v_sub_u32 %4, %12, %21\n\t"
        "v_lshrrev_b32 %1, 31, %1\n\t"
        "v_lshrrev_b32 %2, 31, %2\n\t"
        "v_lshrrev_b32 %3, 31, %3\n\t"
        "v_lshrrev_b32 %4, 31, %4\n\t"
        "v_add3_u32 %0, %0, %1, %2\n\t"
        "v_add3_u32 %0, %0, %3, %4\n\t"
        "v_sub_u32 %1, %13, %21\n\t"
        "v_sub_u32 %2, %14, %21\n\t"
        "v_sub_u32 %3, %15, %21\n\t"
        "v_sub_u32 %4, %16, %21\n\t"
        "v_lshrrev_b32 %1, 31, %1\n\t"
        "v_lshrrev_b32 %2, 31, %2\n\t"
        "v_lshrrev_b32 %3, 31, %3\n\t"
        "v_lshrrev_b32 %4, 31, %4\n\t"
        "v_add3_u32 %0, %0, %1, %2\n\t"
        "v_add3_u32 %0, %0, %3, %4\n\t"
        "v_sub_u32 %1, %17, %21\n\t"
        "v_sub_u32 %2, %18, %21\n\t"
        "v_sub_u32 %3, %19, %21\n\t"
        "v_sub_u32 %4, %20, %21\n\t"
        "v_lshrrev_b32 %1, 31, %1\n\t"
        "v_lshrrev_b32 %2, 31, %2\n\t"
        "v_lshrrev_b32 %3, 31, %3\n\t"
        "v_lshrrev_b32 %4, 31, %4\n\t"
        "v_add3_u32 %0, %0, %1, %2\n\t"
        "v_add3_u32 %0, %0, %3, %4"
        : "=&v"(acc), "=&v"(t0), "=&v"(t1), "=&v"(t2), "=&v"(t3)
        : "v"(v[0]), "v"(v[1]), "v"(v[2]), "v"(v[3]), "v"(v[4]), "v"(v[5]), "v"(v[6]), "v"(v[7]), "v"(v[8]), "v"(v[9]), "v"(v[10]), "v"(v[11]), "v"(v[12]), "v"(v[13]), "v"(v[14]), "v"(v[15]), "v"(g));
    return 64 * 16 - wave_isum((int)acc);
}
typedef unsigned gl_u2v __attribute__((ext_vector_type(2))); typedef __attribute__((address_space(1))) gl_u2v* gl_u2p;
template <int NE>
__device__ __forceinline__ int count_geN(const unsigned (&v)[NE], unsigned cand) {
    int c0 = 0, c1 = 0;
#pragma unroll
    for (int e = 0; e < NE; e += 2) { c0 += (v[e] >= cand) ? 1 : 0; c1 += (v[e + 1] >= cand) ? 1 : 0; }
    return wave_isum(c0 + c1);
}
template <int NE>
__device__ __forceinline__ unsigned sel_query(LAS const u16* sq, int nsv, int lane) {
    unsigned v[NE];
#pragma unroll
    for (int e = 0; e < NE; ++e) v[e] = (lane + 64 * e < nsv) ? (unsigned)sq[64 * e] : 0u;
    unsigned T = 0u;
#pragma unroll 1
    for (int bit = 15; bit >= 2; --bit) { const unsigned cand = T | (1u << bit); const int c = count_geN<NE>(v, cand); if (c >= TK_R) { T = cand; if (c == TK_R) break; } }
    return T;
}
template <int NE>
__device__ __forceinline__ void s3_query(const int ql, const int m, const int mm, const bool over, const int lane, const uint2* list, LAS const unsigned* zm, LAS unsigned* mt, unsigned* ctl, const float lo) {
        unsigned ord[NE], key[NE];
        { gl_u2v tv[NE];
#pragma unroll
          for (int e = 0; e < NE; ++e) { const int sidx = lane + 64 * e; tv[e] = *(const gl_u2p)(list + ql * TK_CAP + (sidx < mm ? sidx : 0)); }
#pragma unroll
          for (int e = 0; e < NE; ++e) { const bool vld = lane + 64 * e < mm; key[e] = vld ? tv[e].x : 0xffffffffu; ord[e] = vld ? f2ord(__uint_as_float(tv[e].y)) : 0u; } }
        const int cpos = (lo > 0.f) ? mm : count_geN<NE>(ord, 0x80000001u);
        u32x4 zw = {0u, 0u, 0u, 0u}; int zl = 0, zincl = 0, Zc = 0;
        if (cpos < TOPK) {
            zw = *(LAS const u32x4*)(zm + ql * 256 + 4 * lane);
            zl = __builtin_popcount(zw[0]) + __builtin_popcount(zw[1]) + __builtin_popcount(zw[2]) + __builtin_popcount(zw[3]);
            zincl = zl;
#pragma unroll
            for (int o = 1; o < 64; o <<= 1) { const int v = shfl_upL(zincl, o, lane); if (lane >= o) zincl += v; }
            Zc = __builtin_amdgcn_readlane(zincl, 63);
        }
        const int klist = (cpos >= TOPK) ? TOPK : ((cpos + Zc >= TOPK) ? cpos : TOPK - Zc);
        if (over) { if (lane == 0) __hip_atomic_store(ctl + CW_FAIL + 1, 1u, __ATOMIC_RELAXED, __HIP_MEMORY_SCOPE_AGENT); }
        if (m < klist) { if (lane == 0) __hip_atomic_store(ctl + CW_FAIL, 1u, __ATOMIC_RELAXED, __HIP_MEMORY_SCOPE_AGENT); }
        if (klist > 0) {
            unsigned T = 0u; bool exact = false; int hb = 31;
            {
                unsigned mx = 0u;
#pragma unroll
                for (int e = 0; e < NE; ++e) mx = (ord[e] > mx) ? ord[e] : mx;
#define WR_STEP(ctrl, rm) { const unsigned o_ = (unsigned)__builtin_amdgcn_update_dpp(0, (int)mx, ctrl, rm, 0xf, true); mx = (o_ > mx) ? o_ : mx; }
                WR_STEP(0x111, 0xf) WR_STEP(0x112, 0xf) WR_STEP(0x114, 0xf) WR_STEP(0x118, 0xf) WR_STEP(0x142, 0xa) WR_STEP(0x143, 0xc)
#undef WR_STEP
                const unsigned m_all = (unsigned)__builtin_amdgcn_readlane((int)mx, 63), df = m_all ^ f2ord(lo);
                if (df == 0u) { T = m_all; hb = -1; } else { hb = 31 - __builtin_clz(df); T = (hb == 31) ? 0u : (m_all & ~((2u << hb) - 1u)); }
            }
#pragma unroll 1
            for (int bit = hb; bit >= 0; --bit) {
                const unsigned cand = T | (1u << bit); const int c = count_geN<NE>(ord, cand);
                if (c >= klist) { T = cand; if (c == klist) { exact = true; break; } }
            }
            unsigned kmax = 0xffffffffu;
            if (!exact) {
                const int cgt = (T == 0xffffffffu) ? 0 : count_geN<NE>(ord, T + 1u);
                const int need = klist - cgt;
                unsigned wv[NE];
#pragma unroll
                for (int e = 0; e < NE; ++e) wv[e] = (ord[e] == T) ? (0x2000u - key[e]) : 0u;
                unsigned T2 = 0u;
#pragma unroll 1
                for (int bit = 13; bit >= 0; --bit) { const unsigned cand = T2 | (1u << bit); if (count_geN<NE>(wv, cand) >= need) T2 = cand; }
                kmax = 0x2000u - T2;
            }
            LAS unsigned* mq = mt + ql * 2;
            if (exact) {
#pragma unroll
                for (int e = 0; e < NE; ++e) if (ord[e] >= T) { const unsigned k = key[e] & 8191u;
                    __hip_atomic_fetch_or(mq + ((k >> 6) * 64 + ((k >> 5) & 1u)), 1u << (k & 31u), __ATOMIC_RELAXED, __HIP_MEMORY_SCOPE_WORKGROUP); }
            } else {
#pragma unroll
                for (int e = 0; e < NE; ++e) {
                    const bool sel = ord[e] > T || (ord[e] == T && key[e] <= kmax);
                    if (sel && key[e] != 0xffffffffu) { const unsigned k = key[e];
                        __hip_atomic_fetch_or(mq + ((k >> 6) * 64 + ((k >> 5) & 1u)), 1u << (k & 31u), __ATOMIC_RELAXED, __HIP_MEMORY_SCOPE_WORKGROUP); }
                }
            }
        }
        if (klist < TOPK) {
        int ztake = TOPK - klist - (zincl - zl);
#pragma unroll
        for (int j = 0; j < 4; ++j) {
            unsigned w = zw[j];
            while (w != 0u && ztake > 0) {
                const unsigned c = (unsigned)__builtin_ctz(w); w &= w - 1u; --ztake;
                const unsigned k = (unsigned)(4 * lane + j) * 32u + c;
                __hip_atomic_fetch_or(mt + (((k >> 6) * 32 + ql) * 2 + ((k >> 5) & 1u)), 1u << c, __ATOMIC_RELAXED, __HIP_MEMORY_SCOPE_WORKGROUP);
            }
        }
        }
}
__device__ __forceinline__ void topk_unit(int b, int qblk, const u16* __restrict__ QI, const u16* __restrict__ KI, const float* __restrict__ WI, unsigned long long* __restrict__ MASKL, uint2* __restrict__ list,
                                          unsigned* __restrict__ ctl, LAS unsigned char* lds, const int WV) {
    const int tid = otid(WV), lane = tid & 63, wave = __builtin_amdgcn_readfirstlane(tid >> 6), hh = lane >> 5;
    const int t0 = qblk * 32, tokb = b * SEQ;
    LAS unsigned* mt = (LAS unsigned*)(lds + TKL_MT);
    LAS float* wtab = (LAS float*)(lds + TKL_W);
    LAS float* lo_s = (LAS float*)(lds + TKL_LO);
    LAS unsigned* cnt_s = (LAS unsigned*)(lds + TKL_CNT);
    LAS u16* samp = (LAS u16*)(lds + TKL_SAMP);
    LAS unsigned* zm = (LAS unsigned*)(lds + TKL_ZM);
    const int nkt_w = 4 * (qblk / 8 + 1);
    unsigned long long* mdst = MASKL + (size_t)(b * 256 + qblk) * 128 * 32;
    __syncthreads();
    for (int i = tid; i < nkt_w * 64; i += NTHR) mt[i] = 0u;
    if (tid < 128) wtab[tid] = WI[(size_t)(tokb + t0) * 4 + tid];
    for (int i = tid; i < 32 * 256; i += NTHR) zm[i] = 0u;
    if (tid < 32) cnt_s[tid] = (unsigned)(tid * TK_CAP * 8);
    if (t0 < TOPK) {
        __syncthreads();
        for (int i = tid; i < nkt_w * 64; i += NTHR) {
            const int kt = i >> 6, ql = (i & 63) >> 1, half = i & 1, k0 = 64 * kt + 32 * half, last = t0 + ql;
            unsigned word = 0u;
            if (k0 <= last) { const int cnt = last - k0 + 1; word = cnt >= 32 ? 0xffffffffu : ((1u << cnt) - 1u); }
            mt[i] = word;
        }
        __syncthreads();
        for (int i = tid; i < nkt_w * 32; i += NTHR) mdst[i] = (unsigned long long)mt[2 * i] | ((unsigned long long)mt[2 * i + 1] << 32);
        return;
    }
    f16x8 af[4][4];
    { const int r = lane & 31;
#pragma unroll
      for (int blk = 0; blk < 4; ++blk)
#pragma unroll
          for (int ks = 0; ks < 4; ++ks) af[blk][ks] = *(const f16x8*)(QI + (size_t)(tokb + t0 + 8 * blk + (r >> 2)) * 256 + (r & 3) * 64 + 16 * ks + 8 * hh); }
    __syncthreads();
    const int nst = qblk / 8 + 1;
    LAS u16* samp_h = samp + hh * 1024 + (lane & 31);
    f16x8 bfs[4];
    if (wave < nst) tk_load_b(KI + (size_t)tokb * 64, 256 * wave, 8, lane, bfs);
    for (int st = wave; st < nst; st += NWAVES) {
        float sc[16]; tk_score_tile_reg(bfs, af, wtab, lane, sc);
        if (st + NWAVES < nst) tk_load_b(KI + (size_t)tokb * 64, 256 * (st + NWAVES), 8, lane, bfs);
#pragma unroll
        for (int blk = 0; blk < 4; ++blk)
#pragma unroll
            for (int g = 0; g < 4; ++g) samp_h[(8 * blk + 2 * g) * 1024 + 32 * st] = (u16)(f2ord(sc[blk * 4 + g]) >> 16);
    }
    __syncthreads();
    for (int i = 0; i < 4; ++i) {
        const int ql = wave * 4 + i, nsv = (t0 + ql) / 8 + 1;
        unsigned T = 0u;
        if (nsv >= TK_R) {
            const int ne = (nsv + 63) >> 6; LAS const u16* sq = samp + ql * 1024 + lane;
            if (ne <= 4) T = sel_query<4>(sq, nsv, lane); else if (ne <= 8) T = sel_query<8>(sq, nsv, lane); else if (ne <= 12) T = sel_query<12>(sq, nsv, lane); else T = sel_query<16>(sq, nsv, lane);
        }
        if (lane == 0) {
            unsigned fb;
            if (T == 0u) fb = 0xff800000u;
            else if (T & 0x8000u) { const unsigned m = T & 0x7fffu; fb = (m == 0u) ? 0x80010000u : ((m - 1u) << 16); }
            else fb = ((~T + 1u) & 0xffffu) << 16;
            lo_s[ql] = __uint_as_float(fb); }
    }
    __syncthreads();
    const int nkt = qblk + 1;
    LAS unsigned* zm_h = zm + hh * 256;
    unsigned nzm;
    { const unsigned long long nb = __ballot(lane < 32 && lo_s[lane & 31] <= 0.f); const unsigned m32 = (unsigned)nb; nzm = (m32 | (m32 >> 1)) & 0x55555555u; }
    float thr[16];
#pragma unroll
    for (int i = 0; i < 16; ++i) { thr[i] = __uint_as_float(__float_as_uint(lo_s[8 * (i >> 2) + 2 * (i & 3) + hh]) & 0xffff0000u); if (i & 1) __builtin_amdgcn_sched_barrier(0); }
    const __amdgpu_buffer_rsrc_t lrs = __builtin_amdgcn_make_buffer_rsrc((void*)opq(list), 0, 32 * TK_CAP * 8, 0x00020000);
    const unsigned cnt_addr = (unsigned)(uintptr_t)(cnt_s + hh);
    f32x4 wreg[4][4];
    { LAS const float* wtab_h = wtab + (lane >> 5) * 4;
#pragma unroll
      for (int blk = 0; blk < 4; ++blk)
#pragma unroll
          for (int g = 0; g < 4; ++g) wreg[blk][g] = *(LAS const f32x4*)(wtab_h + (8 * blk + 2 * g) * 4); }
    f16x8 bf[4];
    if (wave < nkt) tk_load_b(KI + (size_t)tokb * 64, 32 * wave, 1, lane, bf);
    for (int kt = wave; kt < nkt; kt += NWAVES) {
        float sc[16]; tk_score_tile_regw(bf, af, wreg, sc);
        if (kt + NWAVES < nkt) tk_load_b(KI + (size_t)tokb * 64, 32 * (kt + NWAVES), 1, lane, bf);
        const unsigned key = (unsigned)(32 * kt + (lane & 31)); const int keyh = (int)key - hh;
        if (kt == qblk) {
#pragma unroll
            for (int i = 0; i < 16; ++i) if (keyh > t0 + 8 * (i >> 2) + 2 * (i & 3)) sc[i] = -__builtin_inff();
        }
        if (nzm != 0u) {
#pragma unroll
            for (int i = 0; i < 16; ++i) if ((nzm >> (2 * i)) & 1u) {
                const int c = 8 * (i >> 2) + 2 * (i & 3);
                const bool isz = sc[i] == 0.f;
                const unsigned long long zb = __ballot(isz);
                if ((lane & 31) == 0) zm_h[c * 256 + kt] = (unsigned)(zb >> (hh * 32));
                if (isz) sc[i] = -__builtin_inff();
            }
        }
#pragma unroll
        for (int hf = 0; hf < 2; ++hf) {
            unsigned s0 = 0x80000000u, s1 = s0, s2 = s0, s3 = s0, s4 = s0, s5 = s0, s6 = s0, s7 = s0;
            { unsigned long long sav; const unsigned one = 8u; const unsigned ca = cnt_addr + 64u * hf;
#define TK_SLOT(n, off) "v_cmp_gt_f32 vcc, %" #n ", %[t" #n "]\n\ts_and_saveexec_b64 %[sav], vcc\n\tds_add_rtn_u32 %[s" #n "], %[ca], %[one] offset:" #off "\n\ts_mov_b64 exec, %[sav]\n\t"
              asm volatile(
                  "v_cmp_gt_f32 vcc, %[c0], %[t0]\n\ts_and_saveexec_b64 %[sav], vcc\n\tds_add_rtn_u32 %[s0], %[ca], %[one] offset:0\n\ts_mov_b64 exec, %[sav]\n\t"
                  "v_cmp_gt_f32 vcc, %[c1], %[t1]\n\ts_and_saveexec_b64 %[sav], vcc\n\tds_add_rtn_u32 %[s1], %[ca], %[one] offset:8\n\ts_mov_b64 exec, %[sav]\n\t"
                  "v_cmp_gt_f32 vcc, %[c2], %[t2]\n\ts_and_saveexec_b64 %[sav], vcc\n\tds_add_rtn_u32 %[s2], %[ca], %[one] offset:16\n\ts_mov_b64 exec, %[sav]\n\t"
                  "v_cmp_gt_f32 vcc, %[c3], %[t3]\n\ts_and_saveexec_b64 %[sav], vcc\n\tds_add_rtn_u32 %[s3], %[ca], %[one] offset:24\n\ts_mov_b64 exec, %[sav]\n\t"
                  "v_cmp_gt_f32 vcc, %[c4], %[t4]\n\ts_and_saveexec_b64 %[sav], vcc\n\tds_add_rtn_u32 %[s4], %[ca], %[one] offset:32\n\ts_mov_b64 exec, %[sav]\n\t"
                  "v_cmp_gt_f32 vcc, %[c5], %[t5]\n\ts_and_saveexec_b64 %[sav], vcc\n\tds_add_rtn_u32 %[s5], %[ca], %[one] offset:40\n\ts_mov_b64 exec, %[sav]\n\t"
                  "v_cmp_gt_f32 vcc, %[c6], %[t6]\n\ts_and_saveexec_b64 %[sav], vcc\n\tds_add_rtn_u32 %[s6], %[ca], %[one] offset:48\n\ts_mov_b64 exec, %[sav]\n\t"
                  "v_cmp_gt_f32 vcc, %[c7], %[t7]\n\ts_and_saveexec_b64 %[sav], vcc\n\tds_add_rtn_u32 %[s7], %[ca], %[one] offset:56\n\ts_mov_b64 exec, %[sav]\n\t"
                  "s_waitcnt lgkmcnt(0)"
                  : [s0] "+v"(s0), [s1] "+v"(s1), [s2] "+v"(s2), [s3] "+v"(s3), [s4] "+v"(s4), [s5] "+v"(s5), [s6] "+v"(s6), [s7] "+v"(s7), [sav] "=&s"(sav)
                  : [ca] "v"(ca), [one] "v"(one),
                    [c0] "v"(sc[8 * hf + 0]), [c1] "v"(sc[8 * hf + 1]), [c2] "v"(sc[8 * hf + 2]), [c3] "v"(sc[8 * hf + 3]), [c4] "v"(sc[8 * hf + 4]), [c5] "v"(sc[8 * hf + 5]), [c6] "v"(sc[8 * hf + 6]), [c7] "v"(sc[8 * hf + 7]),
                    [t0] "v"(thr[8 * hf + 0]), [t1] "v"(thr[8 * hf + 1]), [t2] "v"(thr[8 * hf + 2]), [t3] "v"(thr[8 * hf + 3]), [t4] "v"(thr[8 * hf + 4]), [t5] "v"(thr[8 * hf + 5]), [t6] "v"(thr[8 * hf + 6]), [t7] "v"(thr[8 * hf + 7])
                  : "vcc", "memory"); }
#undef TK_SLOT
            const unsigned slot[8] = {s0, s1, s2, s3, s4, s5, s6, s7};
#pragma unroll
            for (int ii = 0; ii < 8; ++ii) {
                const int i = 8 * hf + ii, c = 8 * (i >> 2) + 2 * (i & 3);
                __builtin_amdgcn_raw_buffer_store_b64((gl_u2v){key, __float_as_uint(sc[i])}, lrs, slot[ii], 0, 0); (void)c;
            }
        }
    }
    asm volatile("s_waitcnt vmcnt(0)" ::: "memory");
    __syncthreads();
    for (int i = 0; i < 4; ++i) {
        const int ql = wave * 4 + i;
        const int m = (int)(cnt_s[ql] >> 3) - ql * TK_CAP; const bool over = m > TK_CAP; const int mm = over ? TK_CAP : m;
        const int ne = (mm + 63) >> 6;
        if (ne <= 8) s3_query<8>(ql, m, mm, over, lane, list, zm, mt, ctl, lo_s[ql]);
        else if (ne <= 10) s3_query<10>(ql, m, mm, over, lane, list, zm, mt, ctl, lo_s[ql]);
        else if (ne <= 12) s3_query<12>(ql, m, mm, over, lane, list, zm, mt, ctl, lo_s[ql]);
        else s3_query<16>(ql, m, mm, over, lane, list, zm, mt, ctl, lo_s[ql]);
    }
    __syncthreads();
    for (int i = tid; i < nkt_w * 32; i += NTHR) mdst[i] = (unsigned long long)mt[2 * i] | ((unsigned long long)mt[2 * i + 1] << 32);
}

#include <hip/hip_bf16.h>
#include <cmath>
namespace attn_body {
using bf16=__hip_bfloat16;
using bf16x8=__attribute__((ext_vector_type(8)))short;
using s16x4=__attribute__((ext_vector_type(4)))short;
using f32x16=__attribute__((ext_vector_type(16)))float;
using u32x4=__attribute__((ext_vector_type(4)))unsigned;
constexpr int BATCH=2,NHEAD=8,SEQ=8192,D=64,DM=NHEAD*D,DMO=1024;
constexpr int NW=8,QBLK=32,QB=QBLK*NW,KVBLK=64,NQB=SEQ/QB;
constexpr int ATTN_PITCH=DM, ATTN_UNIT_ROWS=QB;
__device__ __forceinline__ int crow(int r,int hi){return (r&3)+8*(r>>2)+4*hi;}
#define SBAR() __builtin_amdgcn_sched_barrier(0)
__device__ __forceinline__ void cmask(f32x16&p0,f32x16&p1,int jb,int qrel,int hi){
  const float NEG=-INFINITY; int kb=64*jb+4*hi;
  #pragma unroll
  for(int r=0;r<16;++r){int kv=kb+(r&3)+8*(r>>2); if(kv>qrel)p0[r]=NEG; if(kv+32>qrel)p1[r]=NEG;}
}

constexpr int NSLOT=3, SLOTB=8192;
constexpr int LDS_K=0, LDS_V=NSLOT*SLOTB, LDS_WS=2*NSLOT*SLOTB, LDS_OST=LDS_WS+NW*64*4, LDS_MK=LDS_OST+NW*4096, LDS_BYTES=LDS_MK+NW*512;
constexpr float C2=0.125f*1.4426950408889634f;
__device__ __forceinline__ void glds16(const void*gsrc,unsigned lds_dst){unsigned keep;
  asm volatile("s_mov_b32 %0, m0\n\ts_mov_b32 m0, %2\n\ts_nop 0\n\tglobal_load_lds_dwordx4 %1, off\n\ts_mov_b32 m0, %0":"=&s"(keep):"v"(gsrc),"s"(lds_dst):"memory");}
__device__ __forceinline__ void glds4(const void*gsrc,unsigned lds_dst){unsigned keep;
  asm volatile("s_mov_b32 %0, m0\n\ts_mov_b32 m0, %2\n\ts_nop 0\n\tglobal_load_lds_dword %1, off\n\ts_mov_b32 m0, %0":"=&s"(keep):"v"(gsrc),"s"(lds_dst):"memory");}
template<int BIT> __device__ __forceinline__ int bfe1_t(unsigned w){int m;asm("v_bfe_i32 %0, %1, %2, 1":"=v"(m):"v"(w),"n"(BIT));return m;}
#define bfe1(w,b) bfe1_t<(b)>(w)
__device__ __forceinline__ float max3f(float a,float b,float c){float r;asm("v_max3_f32 %0, %1, %2, %3":"=v"(r):"v"(a),"v"(b),"v"(c));return r;}
__device__ __forceinline__ float max2f(float a,float b){float r;asm("v_max_f32_e32 %0, %1, %2":"=v"(r):"v"(a),"v"(b));return r;}
__device__ __forceinline__ float fadd_s(float a,float b){float r;asm("v_add_f32_e32 %0, %1, %2":"=v"(r):"v"(a),"v"(b));return r;}
__device__ __forceinline__ float fsub_s(float a,float b){float r;asm("v_sub_f32_e32 %0, %1, %2":"=v"(r):"v"(a),"v"(b));return r;}
typedef float f32x2_t __attribute__((ext_vector_type(2))); typedef __bf16 bf16x2_t __attribute__((ext_vector_type(2)));
__device__ __forceinline__ unsigned cvtpk_s(float lo,float hi){f32x2_t v={lo,hi};bf16x2_t b=__builtin_convertvector(v,bf16x2_t);return __builtin_bit_cast(unsigned,b);}
#define WAIT_BAR(N) asm volatile("s_waitcnt vmcnt(" #N ") lgkmcnt(0)\n\ts_barrier":::"memory")

__device__ __forceinline__ void qkt(f32x16&p0,f32x16&p1,const char*Kslot,const bf16x8*qr,const f32x16&negm,int r32,int hi){
  const char*kb=Kslot+hi*1024+r32*16;
  #pragma unroll
  for(int d0=0;d0<4;++d0){
    const bf16x8 b0=*reinterpret_cast<const bf16x8*>(kb+d0*2048);
    const bf16x8 b1=*reinterpret_cast<const bf16x8*>(kb+d0*2048+512);
    if(d0==0){p0=__builtin_amdgcn_mfma_f32_32x32x16_bf16(b0,qr[0],negm,0,0,0);p1=__builtin_amdgcn_mfma_f32_32x32x16_bf16(b1,qr[0],negm,0,0,0);}
    else{p0=__builtin_amdgcn_mfma_f32_32x32x16_bf16(b0,qr[d0],p0,0,0,0);p1=__builtin_amdgcn_mfma_f32_32x32x16_bf16(b1,qr[d0],p1,0,0,0);}}
}
typedef __attribute__((address_space(3))) const char* lds_cptr;
typedef short v4i16_t __attribute__((ext_vector_type(4)));
__device__ __forceinline__ void kload8(bf16x8*kf,lds_cptr kp){
  kf[0]=*(const __attribute__((address_space(3))) bf16x8*)(kp);      kf[1]=*(const __attribute__((address_space(3))) bf16x8*)(kp+512);
  kf[2]=*(const __attribute__((address_space(3))) bf16x8*)(kp+2048); kf[3]=*(const __attribute__((address_space(3))) bf16x8*)(kp+2560);
  kf[4]=*(const __attribute__((address_space(3))) bf16x8*)(kp+4096); kf[5]=*(const __attribute__((address_space(3))) bf16x8*)(kp+4608);
  kf[6]=*(const __attribute__((address_space(3))) bf16x8*)(kp+6144); kf[7]=*(const __attribute__((address_space(3))) bf16x8*)(kp+6656);
}
__device__ __forceinline__ void kload2(bf16x8*kf,lds_cptr kp,int j){ kf[2*j]=*(const __attribute__((address_space(3))) bf16x8*)(kp+j*2048); kf[2*j+1]=*(const __attribute__((address_space(3))) bf16x8*)(kp+j*2048+512); }
__device__ __forceinline__ s16x4 vtr(lds_cptr p){ return __builtin_bit_cast(s16x4,__builtin_amdgcn_ds_read_tr16_b64_v4i16((__attribute__((address_space(3))) v4i16_t*)p)); }
__device__ __forceinline__ float rowmax(const f32x16&p0,const f32x16&p1){
  float a=max3f(p0[0],p0[1],p1[0]),b=max3f(p0[2],p0[3],p1[1]);a=max3f(a,p1[2],p1[3]);
  #pragma unroll
  for(int r=4;r<16;r+=4){a=max3f(a,p0[r],p0[r+1]);b=max3f(b,p0[r+2],p0[r+3]);a=max3f(a,p1[r],p1[r+1]);b=max3f(b,p1[r+2],p1[r+3]);}
  const float m=max2f(a,b);
  auto rr=__builtin_amdgcn_permlane32_swap(__float_as_uint(m),__float_as_uint(m),false,false);
  return max2f(__uint_as_float(rr[0]),__uint_as_float(rr[1]));
}
__device__ __forceinline__ void pv(f32x16*o,int vb,bf16x8 pa0,bf16x8 pa1,bf16x8 pa2,bf16x8 pa3){
  #pragma unroll
  for(int d0=0;d0<2;++d0){s16x4 lo[4],hi[4];
    #pragma unroll
    for(int ks=0;ks<4;++ks){
      asm volatile("ds_read_b64_tr_b16 %0,%1 offset:%c2":"=&v"(lo[ks]):"v"(vb),"i"(d0*4096+ks*1024):"memory");
      asm volatile("ds_read_b64_tr_b16 %0,%1 offset:%c2":"=&v"(hi[ks]):"v"(vb),"i"(d0*4096+ks*1024+512):"memory");}
    asm volatile("s_waitcnt lgkmcnt(0)":::"memory");SBAR();
    #define PK(k) (bf16x8){lo[k][0],lo[k][1],lo[k][2],lo[k][3],hi[k][0],hi[k][1],hi[k][2],hi[k][3]}
    o[d0]=__builtin_amdgcn_mfma_f32_32x32x16_bf16(pa0,PK(0),o[d0],0,0,0);
    o[d0]=__builtin_amdgcn_mfma_f32_32x32x16_bf16(pa1,PK(1),o[d0],0,0,0);
    o[d0]=__builtin_amdgcn_mfma_f32_32x32x16_bf16(pa2,PK(2),o[d0],0,0,0);
    o[d0]=__builtin_amdgcn_mfma_f32_32x32x16_bf16(pa3,PK(3),o[d0],0,0,0);
    #undef PK
  }
}

#ifndef ATTN_STORE16
#define ATTN_STORE16(p,v) (*(u32x4*)(p)=(v))
#endif
template<int THRL> __device__ __forceinline__ void attn_unit(int b,int h,int qb,const bf16*Q,const bf16*__restrict__ K,const bf16*__restrict__ V,unsigned short*O,const unsigned long long*MT,char*shm,const int WV){
  const int tid=otid(WV),lane=tid&63,r32=lane&31,hi=lane>>5; const int wid=__builtin_amdgcn_readfirstlane(tid>>6);
  const long rowbase=(long)b*SEQ; const int q0=qb*QB;
  const bf16*Qw=Q+(rowbase+q0+wid*QBLK)*DM+h*D;
  const bf16*Kh=K+rowbase*DM+h*D,*Vh=V+rowbase*DM+h*D;
  const unsigned lds0=(unsigned)(uintptr_t)shm;
  float*wsf=(float*)(shm+LDS_WS)+wid*64;
  const bf16*ksrc=Kh+(long)lane*DM+wid*8;
  const bf16*vsrc=Vh+(long)(16*(wid&3)+(lane>>2))*DM+(wid>>2)*32+(lane&3)*8;
  const unsigned kdst=lds0+LDS_K+wid*1024, vdst=lds0+LDS_V+wid*1024;
  const unsigned*msrc=(const unsigned*)(MT+((size_t)(b*256+qb*8+wid)*128)*32)+lane; const unsigned mdst=lds0+LDS_MK+wid*512;
  #define DMA_M(t) glds4(msrc+(long)(t)*64,(unsigned)__builtin_amdgcn_readfirstlane(mdst+((t)&1)*256))
  const __attribute__((address_space(3))) unsigned long long* mrd=(const __attribute__((address_space(3))) unsigned long long*)((lds_cptr)shm+LDS_MK+wid*512)+r32;
  #define DMA_K(t,slot) glds16(ksrc+(long)(t)*KVBLK*DM,(unsigned)__builtin_amdgcn_readfirstlane(kdst+(slot)))
  #define DMA_V(t,slot) glds16(vsrc+(long)(t)*KVBLK*DM,(unsigned)__builtin_amdgcn_readfirstlane(vdst+(slot)))
  const int vb0=(int)(lds0+LDS_V)+((lane>>4)&1)*32+(lane&3)*8+(4*hi+((lane&15)>>2))*64;
  const char*Kbase=shm+LDS_K; bf16x8 kf[8];
  const lds_cptr shm3=(lds_cptr)shm; const lds_cptr kp0=shm3+LDS_K+hi*1024+r32*16; const lds_cptr vp0=shm3+LDS_V+((lane>>4)&1)*32+(lane&3)*8+(4*hi+((lane&15)>>2))*64;
  const int NT=(q0+QB)/KVBLK;
  DMA_M(0);DMA_K(0,0);DMA_V(0,0);DMA_K(1,SLOTB);
  bf16x8 qr[4];
  #pragma unroll
  for(int d0=0;d0<4;++d0)qr[d0]=*reinterpret_cast<const bf16x8*>(&Qw[(long)r32*DM+d0*16+hi*8]);
  float mhat=0.f,l_reg=0.f;f32x16 o[2];o[0]=zero16();o[1]=zero16();f32x16 negm=zero16();asm volatile("":"+v"(negm));
  const int qrel=wid*QBLK+r32;
  #define CMASK(P0,P1,t) do{}while(0)
  #define MKBIT(r) (((r)&3)+8*((r)>>2))
  #define MK(v,w,r) __uint_as_float(__float_as_uint(v)&(unsigned)bfe1(w,MKBIT(r)))
  #define MKV(v,w,r) __uint_as_float(__float_as_uint(v)&(unsigned)(((int)((w)<<(31-MKBIT(r))))>>31))
  #define MLOAD(t,W0,W1) const unsigned long long mq_=mrd[((t)&1)*32]; const unsigned W0=((unsigned)mq_)>>(4*hi), W1=((unsigned)(mq_>>32))>>(4*hi)
  bool resc=false;
  #define START(P0,P1) do{ const float rm=rowmax(P0,P1); resc=false; \
    { const float dl=rm; mhat=fadd_s(mhat,dl); \
      _Pragma("unroll") for(int r=0;r<16;++r){P0[r]=fsub_s(P0[r],dl);P1[r]=fsub_s(P1[r],dl);} \
      _Pragma("unroll") for(int r=0;r<16;++r)negm[r]=-mhat; asm volatile("":"+v"(negm)); } \
    _Pragma("unroll") for(int r=0;r<16;++r)P0[r]=__builtin_amdgcn_exp2f(P0[r]); }while(0)
  #define RESC() do{ if(resc){ asm volatile("s_waitcnt lgkmcnt(0)":::"memory"); \
      _Pragma("unroll") for(int d_=0;d_<2;++d_) _Pragma("unroll") for(int r=0;r<16;++r)o[d_][r]*=wsf[crow(r,hi)]; } }while(0)
  f32x16 pA0,pA1,pB0,pB1;
  int sl_prev=0,sl_cur=0,sl_next=SLOTB;
  #define ROT() do{sl_prev=sl_cur;sl_cur=sl_next;sl_next=(sl_next==(NSLOT-1)*SLOTB)?0:sl_next+SLOTB;}while(0)
  DMA_K(2,2*SLOTB);
  WAIT_BAR(3);
  qkt(pA0,pA1,Kbase,qr,negm,r32,hi);asm volatile("s_nop 15\n\ts_nop 7":"+v"(pA0),"+v"(pA1));CMASK(pA0,pA1,0);
  START(pA0,pA1);
  _Pragma("unroll") for(int r=0;r<16;++r)pA1[r]=__builtin_amdgcn_exp2f(pA1[r]);
  { MLOAD(0,mwa,mwb); _Pragma("unroll") for(int r=0;r<16;++r){pA0[r]=MKV(pA0[r],mwa,r);pA1[r]=MKV(pA1[r],mwb,r);} }
  WAIT_BAR(0);
  DMA_M(1);DMA_K(3,0);DMA_V(1,SLOTB);
  ROT();
  kload8(kf,kp0+sl_cur);
  WAIT_BAR(2);
  s16x4 vlo[8],vhi[8]; u32x4 pw0,pw1,pw2,pw3;
  #define PKW(P,B) cvtpk_s(P[B],P[B+1])
  #define PAF(k) __builtin_bit_cast(bf16x8,pw##k)
  #define VFR(i) (bf16x8){vlo[i][0],vlo[i][1],vlo[i][2],vlo[i][3],vhi[i][0],vhi[i][1],vhi[i][2],vhi[i][3]}
  #define PIN(x) asm volatile("":"+v"(x))
  #define MX3(a,b,c) __builtin_fmaxf(__builtin_fmaxf((a),(b)),(c))
  #define GAPA(MF,A0,A1,A2,A3,W0,W1,PW) do{ MF; sacc+=A0; sacc+=A1; sacc+=A2; sacc+=A3; PIN(sacc); W0; W1; PIN(PW); SBAR(); }while(0)
  #define EX(v) __builtin_amdgcn_exp2f(v)
  #define GAPB(MF,X,B,W) do{ MF; X[B]=MK(EX(X[B]),W,B); X[B+1]=MK(EX(X[B+1]),W,B+1); X[B+2]=MK(EX(X[B+2]),W,B+2); X[B+3]=MK(EX(X[B+3]),W,B+3); PIN(X); SBAR(); }while(0)
  #define VRD(i) do{ vlo[i]=vtr(vp_+(((i)>>2)*4096+((i)&3)*1024)); vhi[i]=vtr(vp_+(((i)>>2)*4096+((i)&3)*1024+512)); }while(0)
  #define KRD(G,j) do{ if(G){ kload2(kf,kp0+sl_next,j); SBAR(); } }while(0)
  #define STEP(C0,C1,P0,P1,t,GK,GV,GL,GM) do{ SBAR(); \
    if(GM){DMA_M((t)+1);} \
    const lds_cptr vp_=vp0+sl_prev; \
    VRD(0); SBAR(); float sacc=(P0[0]+P0[1]); \
    GAPA(C0=__builtin_amdgcn_mfma_f32_32x32x16_bf16(kf[0],qr[0],negm,0,0,0), P0[2],P0[3],P0[4],P0[5],     pw0[0]=PKW(P0,0), pw0[1]=PKW(P0,2), pw0); \
    VRD(4); SBAR(); GAPA(C1=__builtin_amdgcn_mfma_f32_32x32x16_bf16(kf[1],qr[0],negm,0,0,0), P0[6],P0[7],P0[8],P0[9],     pw0[2]=PKW(P0,4), pw0[3]=PKW(P0,6), pw0); \
    VRD(1); SBAR(); GAPA(C0=__builtin_amdgcn_mfma_f32_32x32x16_bf16(kf[2],qr[1],C0,0,0,0),   P0[10],P0[11],P0[12],P0[13], pw1[0]=PKW(P0,8), pw1[1]=PKW(P0,10), pw1); \
    VRD(5); SBAR(); GAPA(C1=__builtin_amdgcn_mfma_f32_32x32x16_bf16(kf[3],qr[1],C1,0,0,0),   P0[14],P0[15],P1[0],P1[1],   pw1[2]=PKW(P0,12),pw1[3]=PKW(P0,14), pw1); \
    VRD(2); SBAR(); GAPA(C0=__builtin_amdgcn_mfma_f32_32x32x16_bf16(kf[4],qr[2],C0,0,0,0),   P1[2],P1[3],P1[4],P1[5],     pw2[0]=PKW(P1,0), pw2[1]=PKW(P1,2), pw2); \
    VRD(6); SBAR(); GAPA(C1=__builtin_amdgcn_mfma_f32_32x32x16_bf16(kf[5],qr[2],C1,0,0,0),   P1[6],P1[7],P1[8],P1[9],     pw2[2]=PKW(P1,4), pw2[3]=PKW(P1,6), pw2); \
    VRD(3); SBAR(); GAPA(C0=__builtin_amdgcn_mfma_f32_32x32x16_bf16(kf[6],qr[3],C0,0,0,0),   P1[10],P1[11],P1[12],P1[13], pw3[0]=PKW(P1,8), pw3[1]=PKW(P1,10), pw3); \
    VRD(7); SBAR(); GAPA(C1=__builtin_amdgcn_mfma_f32_32x32x16_bf16(kf[7],qr[3],C1,0,0,0),   P1[14],P1[15],0.f,0.f,       pw3[2]=PKW(P1,12),pw3[3]=PKW(P1,14), pw3); \
    l_reg+=sacc; \
    if(GK){DMA_K((t)+3,sl_cur);} if(GV){DMA_V((t)+1,sl_next);} \
    CMASK(C0,C1,t); \
    { float a=MX3(C0[0],C0[1],C1[0]),b=MX3(C0[2],C0[3],C1[1]); a=MX3(a,C1[2],C1[3]); \
      _Pragma("unroll") for(int r=4;r<16;r+=4){a=MX3(a,C0[r],C0[r+1]);b=MX3(b,C0[r+2],C0[r+3]);a=MX3(a,C1[r],C1[r+1]);b=MX3(b,C1[r+2],C1[r+3]);} \
      float rm=__builtin_fmaxf(a,b); { auto rr=__builtin_amdgcn_permlane32_swap(__float_as_uint(rm),__float_as_uint(rm),false,false); rm=__builtin_fmaxf(__uint_as_float(rr[0]),__uint_as_float(rr[1])); } \
      resc=false; \
      if(__builtin_expect(__any(rm>(float)THRL),0)){ const float dl=__builtin_fmaxf(rm,0.f); mhat+=dl; \
        _Pragma("unroll") for(int r=0;r<16;++r){C0[r]-=dl;C1[r]-=dl;} \
        _Pragma("unroll") for(int r=0;r<16;++r)negm[r]=-mhat; asm volatile("":"+v"(negm)); \
        const float f=__builtin_amdgcn_exp2f(-dl); l_reg*=f; if(hi==0)wsf[r32]=f; resc=true; } } \
    SBAR(); \
    MLOAD(t,mw0_,mw1_); \
    GAPB(o[0]=__builtin_amdgcn_mfma_f32_32x32x16_bf16(PAF(0),VFR(0),o[0],0,0,0), C0,0,mw0_); \
    GAPB(o[1]=__builtin_amdgcn_mfma_f32_32x32x16_bf16(PAF(0),VFR(4),o[1],0,0,0), C0,4,mw0_); \
    KRD(GL,0); GAPB(o[0]=__builtin_amdgcn_mfma_f32_32x32x16_bf16(PAF(1),VFR(1),o[0],0,0,0), C0,8,mw0_); \
    KRD(GL,1); GAPB(o[1]=__builtin_amdgcn_mfma_f32_32x32x16_bf16(PAF(1),VFR(5),o[1],0,0,0), C0,12,mw0_); \
    KRD(GL,2); GAPB(o[0]=__builtin_amdgcn_mfma_f32_32x32x16_bf16(PAF(2),VFR(2),o[0],0,0,0), C1,0,mw1_); \
    KRD(GL,3); GAPB(o[1]=__builtin_amdgcn_mfma_f32_32x32x16_bf16(PAF(2),VFR(6),o[1],0,0,0), C1,4,mw1_); \
    GAPB(o[0]=__builtin_amdgcn_mfma_f32_32x32x16_bf16(PAF(3),VFR(3),o[0],0,0,0), C1,8,mw1_); \
    GAPB(o[1]=__builtin_amdgcn_mfma_f32_32x32x16_bf16(PAF(3),VFR(7),o[1],0,0,0), C1,12,mw1_); \
    }while(0)
  int t=1;
  #undef CMASK
  #define CMASK(P0,P1,t) do{}while(0)
  for(;t+5<NT;t+=2){
    STEP(pB0,pB1,pA0,pA1,t,true,true,true,true);     WAIT_BAR(2); RESC(); ROT();
    STEP(pA0,pA1,pB0,pB1,t+1,true,true,true,true);   WAIT_BAR(2); RESC(); ROT();
  }
  #undef CMASK
  #define CMASK(P0,P1,t) do{}while(0)
  #define ENDW(tt) do{ if((tt)+3<NT){WAIT_BAR(2);} else if((tt)+2<NT){WAIT_BAR(1);} else {WAIT_BAR(0);} }while(0)
  for(;t+1<NT;t+=2){
    STEP(pB0,pB1,pA0,pA1,t,(t+3<NT),(t+1<NT),(t+1<NT),(t+1<NT));       ENDW(t);   RESC(); ROT();
    STEP(pA0,pA1,pB0,pB1,t+1,(t+4<NT),(t+2<NT),(t+2<NT),(t+2<NT));     ENDW(t+1); RESC(); ROT();
  }
  STEP(pB0,pB1,pA0,pA1,NT-1,false,false,false,false); RESC();
  { float sacc=pB0[0]+pB0[1]; _Pragma("unroll") for(int r=2;r<16;++r)sacc+=pB0[r]; _Pragma("unroll") for(int r=0;r<16;++r)sacc+=pB1[r]; l_reg+=sacc;
    pw0=(u32x4){PKW(pB0,0),PKW(pB0,2),PKW(pB0,4),PKW(pB0,6)};pw1=(u32x4){PKW(pB0,8),PKW(pB0,10),PKW(pB0,12),PKW(pB0,14)};pw2=(u32x4){PKW(pB1,0),PKW(pB1,2),PKW(pB1,4),PKW(pB1,6)};pw3=(u32x4){PKW(pB1,8),PKW(pB1,10),PKW(pB1,12),PKW(pB1,14)};
    SBAR(); pv(o,vb0+sl_cur,PAF(0),PAF(1),PAF(2),PAF(3)); }
  #undef PKW
  #undef PAF
  #undef VFR
  #undef PIN
  #undef MX3
  #undef GAPA
  #undef GAPB
  #undef EX
  #undef VRD
  #undef KRD
  #undef STEP
  #undef ENDW
  {auto rr=__builtin_amdgcn_permlane32_swap(__float_as_uint(l_reg),__float_as_uint(l_reg),false,false);l_reg=__uint_as_float(rr[0])+__uint_as_float(rr[1]);}
  if(hi==0)wsf[32+r32]=l_reg;asm volatile("s_waitcnt lgkmcnt(0)":::"memory");
  float rli[16];
  #pragma unroll
  for(int r=0;r<16;++r)rli[r]=__builtin_amdgcn_rcpf(wsf[32+crow(r,hi)]);
  unsigned short*Ow=O+(rowbase+q0+wid*QBLK)*DMO+h*D;
  { unsigned short*stg=(unsigned short*)(shm+LDS_OST)+wid*2048;
    #pragma unroll
    for(int r=0;r<16;++r){const int orow=crow(r,hi);
      #pragma unroll
      for(int d0=0;d0<2;++d0)stg[orow*64+d0*32+r32]=__builtin_bit_cast(unsigned short,(_Float16)(o[d0][r]*rli[r]));}
    asm volatile("s_waitcnt lgkmcnt(0)":::"memory");
    #pragma unroll
    for(int i=0;i<4;++i){const int row=i*8+(lane>>3),ch=lane&7; const u32x4 v=*(const u32x4*)(stg+row*64+ch*8); ATTN_STORE16(Ow+(long)row*DMO+ch*8,v);} }
  asm volatile("s_waitcnt lgkmcnt(0)\n\ts_barrier":::"memory");
  #undef DMA_K
  #undef DMA_V
  #undef DMA_M
  #undef MK
  #undef MKV
  #undef MKBIT
  #undef MLOAD
  #undef CMASK
  #undef START
  #undef RESC
  #undef ROT
}
constexpr int ATTN_LDS_BYTES=LDS_BYTES;
struct AttnTensors { const bf16* Q; const bf16* K; const bf16* V; unsigned short* O; const unsigned long long* MT; };
struct AttnUnit { int bh; int qb; };
struct StaticOrder {
  int vcu;
  __device__ __forceinline__ explicit StaticOrder(int grid,int block):vcu((block%8)*(grid/8)+block/8){}
  __device__ __forceinline__ bool next(int i,AttnUnit&u)const{ if(i>=2)return false; const int s=vcu&15; u.bh=vcu>>4; u.qb=(i==0)?s:31-s; return true; }
  __device__ __forceinline__ void a_ready(const AttnUnit&)const{}
  __device__ __forceinline__ void done(const AttnUnit&)const{}
};
template<class Sched,int THRL=8> __device__ __forceinline__ void attn_phase(char*lds,const AttnTensors&T,const Sched&S,const int WV){
  AttnUnit u;
  for(int i=0;S.next(i,u);++i){ S.a_ready(u); attn_unit<THRL>(u.bh/NHEAD,u.bh%NHEAD,u.qb,T.Q,T.K,T.V,T.O,T.MT,lds,WV); S.done(u); }
}
#undef SBAR
#undef WAIT_BAR
}


typedef __attribute__((address_space(1))) unsigned gu32;
#define XB_TMO      128
#define XB_XCNT(j)  (256  + 64 * (j))
#define XB_XSUB(j)  (1280 + 64 * (j))
#define XB_XGEN(j)  (2304 + 64 * (j))
#define XB_TOP      3328
#define XB_TOPGEN   3392
#define XCD_BAR_WORDS 3456
#define XB_SPIN_CAP (1u << 18)

__device__ __forceinline__ unsigned xb_ld(unsigned* p)              { return __hip_atomic_load(p, __ATOMIC_RELAXED, __HIP_MEMORY_SCOPE_AGENT); }
__device__ __forceinline__ unsigned xb_add(unsigned* p, unsigned v) { return __hip_atomic_fetch_add(p, v, __ATOMIC_RELAXED, __HIP_MEMORY_SCOPE_AGENT); }
__device__ __forceinline__ unsigned xb_xcc_id() { return (unsigned)__builtin_amdgcn_s_getreg((3 << 11) | 20) & 0xFu; }
#define XB_SPIN(cond, bar) do { unsigned _sp = 0; while (cond) { __builtin_amdgcn_s_sleep(1); \
    if ((++_sp & 255u) == 0u) { if (xb_ld(&(bar)[XB_TMO])) break; if (_sp > XB_SPIN_CAP) { atomicAdd(&(bar)[XB_TMO], 1u); break; } } } } while (0)

struct XcdBarrier {
    unsigned* bar; unsigned x;
    volatile LAS unsigned* st;
};

__device__ __forceinline__ XcdBarrier xcd_barrier_post(unsigned* bar, volatile LAS unsigned* st) {
    XcdBarrier b; b.bar = bar; b.x = xb_xcc_id(); b.st = st;
    if (threadIdx.x == 0) (void)xb_add(&bar[XB_XCNT(b.x)], 1u);
    return b;
}
__device__ __forceinline__ void xcd_barrier_complete(unsigned* bar, unsigned x, unsigned& nloc, unsigned& nx) {
    const unsigned G = gridDim.x * gridDim.y * gridDim.z;
    unsigned sum, cnt, mine, sp = 0u;
    for (;;) {
        sum = 0u; cnt = 0u; mine = 0u;
#pragma unroll
        for (unsigned j = 0; j < 16; ++j) { const unsigned c = xb_ld(&bar[XB_XCNT(j)]); sum += c; cnt += (c > 0u) ? 1u : 0u; mine = (j == x) ? c : mine; }
        if (sum == G) break;
        __builtin_amdgcn_s_sleep(1);
        if ((++sp & 255u) == 0u) { if (xb_ld(&bar[XB_TMO])) break; if (sp > XB_SPIN_CAP) { atomicAdd(&bar[XB_TMO], 1u); break; } }
    }
    nloc = mine > 0u ? mine : 1u; nx = cnt > 0u ? cnt : 1u;
}

__device__ __forceinline__ void xcd_barrier(const XcdBarrier& b) {
    asm volatile("s_waitcnt vmcnt(0)" ::: "memory");
    __syncthreads();
    if (threadIdx.x == 0) {
        unsigned* bar = b.bar;
        __builtin_amdgcn_s_waitcnt(0);
        unsigned nloc = b.st[0], nx = b.st[1];
        if (nloc == 0u) { xcd_barrier_complete(bar, b.x, nloc, nx); b.st[0] = nloc; b.st[1] = nx; }
        const unsigned old = xb_add(&bar[XB_XSUB(b.x)], 1u);
        const unsigned gen = old / nloc;
        if (old + 1u == (gen + 1u) * nloc) {
            __builtin_amdgcn_fence(__ATOMIC_RELEASE, "agent");
            asm volatile("s_waitcnt vmcnt(0)" ::: "memory");
            const unsigned og = xb_add(&bar[XB_TOP], 1u);
            const unsigned tg = og / nx;
            if (og + 1u == (tg + 1u) * nx) xb_add(&bar[XB_TOPGEN], 1u);
            else XB_SPIN(xb_ld(&bar[XB_TOPGEN]) == tg, bar);
            __builtin_amdgcn_fence(__ATOMIC_ACQUIRE, "agent");
            xb_add(&bar[XB_XGEN(b.x)], 1u);
            asm volatile("s_waitcnt vmcnt(0)" ::: "memory");
        } else {
            XB_SPIN(xb_ld(&bar[XB_XGEN(b.x)]) == gen, bar);
            __builtin_amdgcn_fence(__ATOMIC_ACQUIRE, "agent");
            asm volatile("s_waitcnt vmcnt(0)" ::: "memory");
        }
    }
    __syncthreads();
}

constexpr int GLA_HALF_BYTES = 61440;
__device__ __forceinline__ void gla_cumlog_h(const float* __restrict__ GL, const float* __restrict__ wg, const float* __restrict__ bg, int tok0, int h, LAS float* bl  , int t) {
    const int i = t >> 2, dq = t & 3;
    float gl[16];
#pragma unroll
    for (int r = 0; r < 4; ++r) { const f32x4 v = *(const f32x4*)(GL + (size_t)(tok0 + i) * 16 + 4 * r); gl[4 * r] = v[0]; gl[4 * r + 1] = v[1]; gl[4 * r + 2] = v[2]; gl[4 * r + 3] = v[3]; }
#pragma unroll
    for (int dd = 0; dd < 8; ++dd) {
        const int d = dq * 8 + dd; float z = bg[h * 32 + d];
#pragma unroll
        for (int r = 0; r < 16; ++r) z += gl[r] * wg[r * 128 + h * 32 + d];
        const float ls = fminf(z, 0.f) - log1pf(__expf(-fabsf(z)));
        bl[i * 33 + d] = ls * (1.f / 16.f);
    }
    __syncthreads();
    if (t < 32) { float a = 0.f; for (int ii = 0; ii < 64; ++ii) { a += bl[ii * 33 + t]; bl[ii * 33 + t] = a; } }
    __syncthreads();
}
__device__ __forceinline__ void gla1_item(int blk, int t, LAS unsigned char* sm, const float* GL, const u16* GQK, const u16* GV, const float* wg, const float* bg, float* DS, float* DD) {
    LAS float* bl = (LAS float*)sm; LAS float* kh = bl + 64 * 33; LAS float* vv = kh + 64 * 33;
    const int b = blk >> 9, h = (blk >> 7) & 3, c = blk & 127, tok0 = b * SEQ + c * 64;
    gla_cumlog_h(GL, wg, bg, tok0, h, bl, t);
    { const int j = t >> 2, dq = t & 3;
#pragma unroll
      for (int dd = 0; dd < 8; ++dd) { const int d = dq * 8 + dd; kh[j * 33 + d] = bf2f(GQK[(size_t)(tok0 + j) * 256 + 128 + h * 32 + d]) * __expf(bl[63 * 33 + d] - bl[j * 33 + d]); }
#pragma unroll
      for (int ee = 0; ee < 16; ++ee) { const int e = dq * 16 + ee; vv[j * 64 + e] = bf2f(GV[(size_t)(tok0 + j) * 256 + h * 64 + e]); } }
    __syncthreads();
    const int e = t & 63, dg = t >> 6;
#pragma unroll
    for (int dd = 0; dd < 8; ++dd) { const int d = dg * 8 + dd; float s = 0.f; for (int j = 0; j < 64; ++j) s += kh[j * 33 + d] * vv[j * 64 + e]; DS[(size_t)blk * 2048 + d * 64 + e] = s; }
    if (t < 32) DD[blk * 32 + t] = __expf(bl[63 * 33 + t]);
    __syncthreads();
}
__device__ __forceinline__ void gla3_item(int blk, int t, LAS unsigned char* sm, const float* GL, const u16* GQK, const u16* GV, const u16* GR, const float* wg, const float* bg, const float* S0, const float* gn, u16* MIX) {
    LAS float* bl = (LAS float*)sm; LAS float* qt = bl + 64 * 33; LAS float* kt = qt + 64 * 33; LAS float* Ss = kt + 64 * 33; LAS float* at = Ss + 32 * 64; LAS u16* vv = (LAS u16*)(at + 64 * 65);
    const int b = blk >> 9, h = (blk >> 7) & 3, c = blk & 127, tok0 = b * SEQ + c * 64;
    gla_cumlog_h(GL, wg, bg, tok0, h, bl, t);
    const int i = t >> 2, qd = t & 3;
#pragma unroll
    for (int dd = 0; dd < 8; ++dd) { const int d = qd * 8 + dd; const float bb = bl[i * 33 + d];
        qt[i * 33 + d] = bf2f(GQK[(size_t)(tok0 + i) * 256 + h * 32 + d]) * 0.17677669529663687f * __expf(bb);
        kt[i * 33 + d] = bf2f(GQK[(size_t)(tok0 + i) * 256 + 128 + h * 32 + d]) * __expf(-bb); }
#pragma unroll
    for (int ee = 0; ee < 16; ++ee) { const int e = qd * 16 + ee; vv[i * 64 + e] = GV[(size_t)(tok0 + i) * 256 + h * 64 + e]; }
    for (int x = t; x < 2048; x += 256) Ss[x] = S0[(size_t)blk * 2048 + x];
    __syncthreads();
#pragma unroll
    for (int jj = 0; jj < 16; ++jj) { const int j = qd * 16 + jj; float s = 0.f;
        if (j <= i) { for (int d = 0; d < 32; ++d) s += qt[i * 33 + d] * kt[j * 33 + d]; }
        at[i * 65 + j] = s; }
    __syncthreads();
    float o[16]; float ss = 0.f;
#pragma unroll
    for (int ee = 0; ee < 16; ++ee) { const int e = qd * 16 + ee; float s = 0.f;
        for (int d = 0; d < 32; ++d) s += qt[i * 33 + d] * Ss[d * 64 + e];
        for (int j = 0; j <= i; ++j) s += at[i * 65 + j] * bf2f(vv[j * 64 + e]);
        o[ee] = s; ss += s * s; }
    ss += __shfl_xor(ss, 1); ss += __shfl_xor(ss, 2);
    const float rs = rsqrtf(ss * (1.f / 64.f) + EPS);
#pragma unroll
    for (int ee = 0; ee < 16; ++ee) { const int e = qd * 16 + ee;
        const float r = bf2f(GR[(size_t)(tok0 + i) * 256 + h * 64 + e]);
        MIX[(size_t)(tok0 + i) * D_MODEL + 512 + h * 64 + e] = (u16)f2h(o[ee] * rs * gn[h * 64 + e] * silu_f(r)); }
    __syncthreads();
}
__device__ __forceinline__ void pool_item(int item, int t, LAS unsigned char* sm, const u16* UC, const float* wp, const float* psc, u16* MIX) {
    LAS float* pl = (LAS float*)sm;
    const int tok0 = item * 16, g = t >> 6, win = 2 << g;
    for (int tt = 0; tt < 16; ++tt) {
        const int tok = tok0 + tt, pos = tok & (SEQ - 1); const int cnt = (pos + 1 < win) ? pos + 1 : win;
        float s = 0.f;
        for (int j = 0; j < cnt; ++j) s += bf2f(UC[(size_t)(tok - j) * 256 + t]);
        pl[tt * 256 + t] = s / (float)cnt - bf2f(UC[(size_t)tok * 256 + t]);
    }
    __syncthreads();
    const int e = t & 63;
    float acc[16];
#pragma unroll
    for (int tt = 0; tt < 16; ++tt) acc[tt] = 0.f;
    for (int d = 0; d < 64; ++d) { const float wv = wp[(g * 64 + d) * 64 + e];
#pragma unroll
        for (int tt = 0; tt < 16; ++tt) acc[tt] += pl[tt * 256 + g * 64 + d] * wv; }
    const float sc = psc[t];
#pragma unroll
    for (int tt = 0; tt < 16; ++tt) MIX[(size_t)(tok0 + tt) * D_MODEL + 768 + t] = (u16)f2h(acc[tt] * sc);
    __syncthreads();
}


namespace gla {
using attn_body::f32x16; using attn_body::bf16x8; using attn_body::s16x4; using attn_body::cvtpk_s; using attn_body::crow;
constexpr int L_KT = 0;
constexpr int L_PP = 16384;
constexpr int L_Q = 0, L_K = 16384, L_V = 32768, L_S = 65536;
typedef _Float16 f16x8_t __attribute__((ext_vector_type(8)));

__device__ __forceinline__ float dpp_scan64(float v) {
#define GLA_SC(ctrl, rm, bc) v += __int_as_float(__builtin_amdgcn_update_dpp(0, __float_as_int(v), ctrl, rm, 0xf, bc))
    GLA_SC(0x111, 0xf, true); GLA_SC(0x112, 0xf, true); GLA_SC(0x114, 0xf, true); GLA_SC(0x118, 0xf, true); GLA_SC(0x142, 0xa, false); GLA_SC(0x143, 0xc, false);
#undef GLA_SC
    return v;
}
__device__ __forceinline__ float dpp_sum32(float v, int hi) {
#define GLA_SC(ctrl, rm, bc) v += __int_as_float(__builtin_amdgcn_update_dpp(0, __float_as_int(v), ctrl, rm, 0xf, bc))
    GLA_SC(0x111, 0xf, true); GLA_SC(0x112, 0xf, true); GLA_SC(0x114, 0xf, true); GLA_SC(0x118, 0xf, true); GLA_SC(0x142, 0xa, false);
#undef GLA_SC
    const float lo = __int_as_float(__builtin_amdgcn_readlane(__float_as_int(v), 31)), up = __int_as_float(__builtin_amdgcn_readlane(__float_as_int(v), 63));
    return hi ? up : lo;
}
constexpr int L_GT = 98304;
typedef __attribute__((address_space(1))) f32x4 gf4; typedef __attribute__((address_space(1))) u32x4 gu4; typedef __attribute__((address_space(1))) u16 gu16; typedef __attribute__((address_space(1))) float gf1;
__device__ __forceinline__ void gate_table(LAS unsigned char* L, const float* wg, const float* bg, int tid) {
    LAS float* t = (LAS float*)(L + L_GT);
    { const f32x4 v = *(const gf4*)(wg + 4 * tid); *(LAS f32x4*)(t + 4 * tid) = v; }
    if (tid < 32) { const f32x4 v = *(const gf4*)(bg + 4 * tid); *(LAS f32x4*)(t + 2048 + 4 * tid) = v; }
}
__device__ __forceinline__ void gates_load(const float* __restrict__ GL, int tok0, int lane, f32x4 (&g4)[4]) {
#pragma unroll
    for (int r = 0; r < 4; ++r) g4[r] = *(const gf4*)(GL + (size_t)(tok0 + lane) * 16 + 4 * r);
}
__device__ __forceinline__ void gates(const f32x4 (&g4)[4], LAS const unsigned char* L, int h, int dbase, float (&b)[16]) {
    float gl[16]; LAS const float* t = (LAS const float*)(L + L_GT);
#pragma unroll
    for (int r = 0; r < 4; ++r) { gl[4 * r] = g4[r][0]; gl[4 * r + 1] = g4[r][1]; gl[4 * r + 2] = g4[r][2]; gl[4 * r + 3] = g4[r][3]; }
    const int d0 = h * 32 + dbase;
#pragma unroll
    for (int q = 0; q < 4; ++q) {
        f32x4 z = *(LAS const f32x4*)(t + 2048 + d0 + 4 * q);
#pragma unroll
        for (int rh = 0; rh < 2; ++rh) {
            f32x4 w[8];
#pragma unroll
            for (int r = 0; r < 8; ++r) w[r] = *(LAS const f32x4*)(t + (8 * rh + r) * 128 + d0 + 4 * q);
            __builtin_amdgcn_sched_barrier(0);
#pragma unroll
            for (int r = 0; r < 8; ++r) { const float g = gl[8 * rh + r]; z[0] += g * w[r][0]; z[1] += g * w[r][1]; z[2] += g * w[r][2]; z[3] += g * w[r][3]; }
        }
#pragma unroll
        for (int e = 0; e < 4; ++e) b[4 * q + e] = (fminf(z[e], 0.f) - __logf(1.f + __expf(-fabsf(z[e])))    ) * (1.f / 16.f);
    }
#pragma unroll
    for (int dd = 0; dd < 16; ++dd) b[dd] = dpp_scan64(b[dd]);
}
__device__ __forceinline__ void cvt16bf(const u32x4 a, const u32x4 c, float (&x)[16]) {
#pragma unroll
    for (int e = 0; e < 4; ++e) { x[2 * e] = bf2f(a[e] & 0xffffu); x[2 * e + 1] = bf2f(a[e] >> 16); x[8 + 2 * e] = bf2f(c[e] & 0xffffu); x[8 + 2 * e + 1] = bf2f(c[e] >> 16); }
}
__device__ __forceinline__ void load16bf(const u16* p, float (&x)[16]) {
    const u32x4 a = *(const gu4*)p, c = *(const gu4*)(p + 8);
#pragma unroll
    for (int e = 0; e < 4; ++e) { x[2 * e] = bf2f(a[e] & 0xffffu); x[2 * e + 1] = bf2f(a[e] >> 16); x[8 + 2 * e] = bf2f(c[e] & 0xffffu); x[8 + 2 * e + 1] = bf2f(c[e] >> 16); }
}
template <int W>
__device__ __forceinline__ void pool_wave(const u16* __restrict__ UC, const u16* __restrict__ WPT, const float* __restrict__ psc, u16* __restrict__ MIX, int tokw  , int g, int lane, LAS unsigned char* pp) {
    const int pos0 = tokw & (SEQ - 1), col = g * 64 + lane;
    float uu[31 + W];
#pragma unroll
    for (int k = 0; k < 31 + W; ++k) { const int rel = k - (W - 1); uu[k] = (pos0 + rel >= 0) ? bf2f(*(const gu16*)(UC + (size_t)(tokw + rel) * 256 + col)) : 0.f; }
    float run = 0.f;
#pragma unroll
    for (int k = 0; k < W - 1; ++k) run += uu[k];
#pragma unroll
    for (int tt = 0; tt < 32; ++tt) {
        run += uu[tt + W - 1];
        const int pos = pos0 + tt; const float cnt = (float)((pos + 1 < W) ? pos + 1 : W);
        const float pooled = run * __builtin_amdgcn_rcpf(cnt) - uu[tt + W - 1];
        *(LAS u16*)(pp + tt * 128 + lane * 2) = (u16)f2h(pooled);
        run -= uu[tt];
    }
    asm volatile("s_waitcnt lgkmcnt(0)" ::: "memory");
    const int r32 = lane & 31, hh = lane >> 5;
    f32x16 acc[2];
    f16x8_t bw[2][4]; float scv[2];
#pragma unroll
    for (int nb = 0; nb < 2; ++nb) {
#pragma unroll
        for (int ks = 0; ks < 4; ++ks) bw[nb][ks] = *(const __attribute__((address_space(1))) f16x8_t*)(WPT + (size_t)(g * 64 + 32 * nb + r32) * 64 + 8 * hh + 16 * ks);
        scv[nb] = *(const gf1*)(psc + g * 64 + 32 * nb + r32);
    }
#pragma unroll
    for (int nb = 0; nb < 2; ++nb) {
        acc[nb] = zero16();
#pragma unroll
        for (int ks = 0; ks < 4; ++ks) {
            const f16x8_t a = *(LAS const f16x8_t*)(pp + r32 * 128 + (8 * hh + 16 * ks) * 2);
            acc[nb] = __builtin_amdgcn_mfma_f32_32x32x16_f16(a, bw[nb][ks], acc[nb], 0, 0, 0);
        }
#pragma unroll
        for (int r = 0; r < 16; ++r) { *(gu16*)(MIX + (size_t)(tokw + crow(r, hh)) * D_MODEL + 768 + g * 64 + 32 * nb + r32) = (u16)f2h(acc[nb][r] * scv[nb]); if ((r & 3) == 3) __builtin_amdgcn_sched_barrier(0); }
    }
}
__device__ __forceinline__ void pass1_item(int item, LAS unsigned char* L, const float* GL, const u16* GQK, const u16* GV, const u16* UC, const u16* WPT, const float* wg, const float* bg, const float* psc, float* DS, float* DD, u16* MIX, const int WV) {
    const int wave = WV, h = wave >> 1, ib = wave & 1;
    const int b = item >> 7, c = item & 127, tok0 = b * SEQ + c * 64, blk = (b * 4 + h) * 128 + c, dbase = 16 * ib;
    f32x4 g4[4]; u32x4 kra, krb;
    { const int lane0 = otid(WV) & 63; gates_load(GL, tok0, lane0, g4);
      const u16* kp = GQK + (size_t)(tok0 + lane0) * 256 + 128 + h * 32 + dbase; kra = *(const gu4*)kp; krb = *(const gu4*)(kp + 8); }
    gate_table(L, wg, bg, otid(WV)); __syncthreads();
    {
    const int lane = otid(WV) & 63;
    float bc[16]; gates(g4, L, h, dbase, bc);
    float kx[16]; cvt16bf(kra, krb, kx);
#pragma unroll
    for (int dd = 0; dd < 16; ++dd) {
        const float bl = __int_as_float(__builtin_amdgcn_readlane(__float_as_int(bc[dd]), 63));
        *(LAS u16*)(L + L_KT + h * 4096 + (dbase + dd) * 128 + lane * 2) = (u16)f2bf(kx[dd] * __expf(bl - bc[dd]));
        if (lane == 63) *(gf1*)(DD + blk * 32 + dbase + dd) = __expf(bl);
    }
    }
    __syncthreads();
    { const int lane = otid(WV) & 63, r32 = lane & 31, hh = lane >> 5;
    f32x16 acc = zero16();
    bf16x8 bv[4];
#pragma unroll
    for (int ks = 0; ks < 4; ++ks)
#pragma unroll
        for (int jj = 0; jj < 8; ++jj) bv[ks][jj] = (short)*(const gu16*)(GV + (size_t)(tok0 + 8 * hh + 16 * ks + jj) * 256 + h * 64 + 32 * ib + r32);
#pragma unroll
    for (int ks = 0; ks < 4; ++ks) {
        const bf16x8 a = *(LAS const bf16x8*)(L + L_KT + h * 4096 + r32 * 128 + (8 * hh + 16 * ks) * 2);
        acc = __builtin_amdgcn_mfma_f32_32x32x16_bf16(a, bv[ks], acc, 0, 0, 0);
    }
#pragma unroll
    for (int r = 0; r < 16; ++r) *(gf1*)(DS + (size_t)blk * 2048 + crow(r, hh) * 64 + 32 * ib + r32) = acc[r];
    }
    const int lane = otid(WV) & 63;
    LAS unsigned char* pp = L + L_PP + wave * 4096;
    if (h == 0) pool_wave<2>(UC, WPT, psc, MIX, tok0 + 32 * ib, 0, lane, pp);
    else if (h == 1) pool_wave<4>(UC, WPT, psc, MIX, tok0 + 32 * ib, 1, lane, pp);
    else if (h == 2) pool_wave<8>(UC, WPT, psc, MIX, tok0 + 32 * ib, 2, lane, pp);
    else pool_wave<16>(UC, WPT, psc, MIX, tok0 + 32 * ib, 3, lane, pp);
    __syncthreads();
}
__device__ __forceinline__ void pass2_item(int item, LAS unsigned char* L, char* Lg  , const float* GL, const u16* GQK, const u16* GV, const u16* GR, const float* wg, const float* bg, const float* S0, const float* gn, u16* MIX, const int WV) {
    const int tid = otid(WV), lane = tid & 63, wave = __builtin_amdgcn_readfirstlane(tid >> 6), h = wave >> 1, ib = wave & 1, r32 = lane & 31, hh = lane >> 5;
    const int b = item >> 7, c = item & 127, tok0 = b * SEQ + c * 64, blk = (b * 4 + h) * 128 + c, dbase = 16 * ib;
    const unsigned lds0 = (unsigned)(uintptr_t)Lg;
    { const u16* vh = GV + (size_t)tok0 * 256 + h * 64;
#pragma unroll
      for (int pc = 0; pc < 4; ++pc) { const int pw = 4 * ib + pc;
          attn_body::glds16(vh + (size_t)(16 * (pw & 3) + (lane >> 2)) * 256 + (pw >> 2) * 32 + (lane & 3) * 8, (unsigned)__builtin_amdgcn_readfirstlane(lds0 + L_V + h * 8192 + pw * 1024)); } }
    f32x4 g4[4]; u32x4 qra, qrb, kra, krb; float sv[16];
    gates_load(GL, tok0, lane, g4);
    { const u16* qp = GQK + (size_t)(tok0 + lane) * 256 + h * 32 + dbase; qra = *(const gu4*)qp; qrb = *(const gu4*)(qp + 8); kra = *(const gu4*)(qp + 128); krb = *(const gu4*)(qp + 136); }
#pragma unroll
    for (int k = 0; k < 16; ++k) sv[k] = *(const gf1*)(S0 + (size_t)blk * 2048 + ib * 64 + lane + 128 * k);
    gate_table(L, wg, bg, tid); __syncthreads();
    float bc[16]; gates(g4, L, h, dbase, bc);
    { float qx[16], kx[16]; cvt16bf(qra, qrb, qx); cvt16bf(kra, krb, kx);
      u32x4 qa, qb, ka, kb;
#pragma unroll
      for (int e = 0; e < 4; ++e) {
          const float e0 = __expf(bc[2 * e]), e1 = __expf(bc[2 * e + 1]), e2 = __expf(bc[8 + 2 * e]), e3 = __expf(bc[8 + 2 * e + 1]);
          qa[e] = pkbf(qx[2 * e] * 0.17677669529663687f * e0, qx[2 * e + 1] * 0.17677669529663687f * e1); qb[e] = pkbf(qx[8 + 2 * e] * 0.17677669529663687f * e2, qx[8 + 2 * e + 1] * 0.17677669529663687f * e3);
          ka[e] = pkbf(kx[2 * e] * __builtin_amdgcn_rcpf(e0), kx[2 * e + 1] * __builtin_amdgcn_rcpf(e1)); kb[e] = pkbf(kx[8 + 2 * e] * __builtin_amdgcn_rcpf(e2), kx[8 + 2 * e + 1] * __builtin_amdgcn_rcpf(e3)); }
      *(LAS u32x4*)(L + L_Q + h * 4096 + lane * 64 + dbase * 2) = qa; *(LAS u32x4*)(L + L_Q + h * 4096 + lane * 64 + dbase * 2 + 16) = qb;
      *(LAS u32x4*)(L + L_K + h * 4096 + lane * 64 + dbase * 2) = ka; *(LAS u32x4*)(L + L_K + h * 4096 + lane * 64 + dbase * 2 + 16) = kb; }
    {
#pragma unroll
      for (int k = 0; k < 16; ++k) { const int idx = ib * 64 + lane + 128 * k, d = idx >> 6, e = idx & 63; *(LAS u16*)(L + L_S + h * 4096 + e * 64 + d * 2) = (u16)f2bf(sv[k]); } }
    asm volatile("s_waitcnt vmcnt(0)" ::: "memory");
    __syncthreads();
    bf16x8 qf[2];
    f32x16 p0 = zero16(), p1 = zero16();
#pragma unroll
    for (int ks = 0; ks < 2; ++ks) {
        qf[ks] = *(LAS const bf16x8*)(L + L_Q + h * 4096 + (32 * ib + r32) * 64 + (8 * hh + 16 * ks) * 2);
        const bf16x8 k0 = *(LAS const bf16x8*)(L + L_K + h * 4096 + r32 * 64 + (8 * hh + 16 * ks) * 2);
        const bf16x8 k1 = *(LAS const bf16x8*)(L + L_K + h * 4096 + (32 + r32) * 64 + (8 * hh + 16 * ks) * 2);
        p0 = __builtin_amdgcn_mfma_f32_32x32x16_bf16(k0, qf[ks], p0, 0, 0, 0);
        p1 = __builtin_amdgcn_mfma_f32_32x32x16_bf16(k1, qf[ks], p1, 0, 0, 0);
    }
    { const int iq = 32 * ib + r32;
#pragma unroll
      for (int r = 0; r < 16; ++r) { const int j = crow(r, hh); if (j > iq) p0[r] = 0.f; if (j + 32 > iq) p1[r] = 0.f; } }
    f32x16 o[2]; o[0] = zero16(); o[1] = zero16();
#pragma unroll
    for (int nb = 0; nb < 2; ++nb)
#pragma unroll
        for (int ks = 0; ks < 2; ++ks) {
            const bf16x8 sf = *(LAS const bf16x8*)(L + L_S + h * 4096 + (32 * nb + r32) * 64 + (8 * hh + 16 * ks) * 2);
            o[nb] = __builtin_amdgcn_mfma_f32_32x32x16_bf16(qf[ks], sf, o[nb], 0, 0, 0);
        }
    { u32x4 pw0, pw1, pw2, pw3;
      pw0 = (u32x4){cvtpk_s(p0[0], p0[1]), cvtpk_s(p0[2], p0[3]), cvtpk_s(p0[4], p0[5]), cvtpk_s(p0[6], p0[7])};
      pw1 = (u32x4){cvtpk_s(p0[8], p0[9]), cvtpk_s(p0[10], p0[11]), cvtpk_s(p0[12], p0[13]), cvtpk_s(p0[14], p0[15])};
      pw2 = (u32x4){cvtpk_s(p1[0], p1[1]), cvtpk_s(p1[2], p1[3]), cvtpk_s(p1[4], p1[5]), cvtpk_s(p1[6], p1[7])};
      pw3 = (u32x4){cvtpk_s(p1[8], p1[9]), cvtpk_s(p1[10], p1[11]), cvtpk_s(p1[12], p1[13]), cvtpk_s(p1[14], p1[15])};
      int l2 = lane; asm volatile("" : "+v"(l2));
      const int vb = (int)(lds0 + L_V + h * 8192) + ((l2 >> 4) & 1) * 32 + (l2 & 3) * 8 + (4 * (l2 >> 5) + ((l2 & 15) >> 2)) * 64;
      __builtin_amdgcn_sched_barrier(0);
      attn_body::pv(o, vb, __builtin_bit_cast(bf16x8, pw0), __builtin_bit_cast(bf16x8, pw1), __builtin_bit_cast(bf16x8, pw2), __builtin_bit_cast(bf16x8, pw3)); }
    { int l3 = lane; asm volatile("" : "+v"(l3)); const int r3 = l3 & 31, h3 = l3 >> 5;
      u16 grv[16][2];
#pragma unroll
      for (int r = 0; r < 16; ++r)
#pragma unroll
          for (int nb = 0; nb < 2; ++nb) grv[r][nb] = *(const gu16*)(GR + (size_t)(tok0 + 32 * ib + crow(r, h3)) * 256 + h * 64 + 32 * nb + r3);
      const float gn0 = *(const gf1*)(gn + h * 64 + r3), gn1 = *(const gf1*)(gn + h * 64 + 32 + r3);
      __builtin_amdgcn_sched_barrier(0);
#pragma unroll
      for (int r = 0; r < 16; ++r) {
        const float ss = dpp_sum32(o[0][r] * o[0][r] + o[1][r] * o[1][r], h3);
        const float rs = rsqrtf(ss * (1.f / 64.f) + EPS);
        const size_t tok = (size_t)(tok0 + 32 * ib + crow(r, h3));
        *(gu16*)(MIX + tok * D_MODEL + 512 + h * 64 + r3) = (u16)f2h(o[0][r] * rs * gn0 * silu_f(bf2f(grv[r][0])));
        *(gu16*)(MIX + tok * D_MODEL + 512 + h * 64 + 32 + r3) = (u16)f2h(o[1][r] * rs * gn1 * silu_f(bf2f(grv[r][1])));
      } }
    __syncthreads();
}
}

constexpr int CW_BAR = 4096;
constexpr int LDS_BARST = LDS_BYTES - 64;

__device__ __forceinline__ void ph_prologue(const Params& p, LAS unsigned char* L, const int WV) {
    const int tid = otid(WV), lane = tid & 63, wave = tid >> 6;
    LAS float* scr = (LAS float*)(L + WV * TR_SCR_BYTES); LAS float* gains = (LAS float*)(L + TR_GAIN_OFF);
    tr_fill_gains(p, gains, tid); __syncthreads();
    const int gw = blockIdx.x * NWAVES + WV, NGW = gridDim.x * NWAVES;
    wconv_stream(p, 0x543210u, 6, 2 * wconv_items(0) + 2 * wconv_items(1) + wconv_items(2) + wconv_items(3), scr, gains, lane, gw, NGW);
    float* cs = (float*)(p.ws + WS_CS); float* sn = cs + M_TOK * 8;
    for (int i = blockIdx.x * NTHR + tid; i < M_TOK * 8; i += gridDim.x * NTHR) {
        const int t = i >> 3, j = i & 7; const float inv = powf(500000.0f, -(float)(2 * j) / 16.0f); const float ang = (float)p.pos[t] * inv;
        float s, c; sincosf(ang, &s, &c); cs[i] = c; sn[i] = s; }
    { u16* wpt = (u16*)(p.ws + WS_WPT);
      for (int i = blockIdx.x * NTHR + tid; i < DEPTH * 4 * 64 * 64; i += gridDim.x * NTHR) { const int d = i & 63, e = (i >> 6) & 63, lg = i >> 12; wpt[i] = (u16)f2h(p.w_pool[(size_t)lg * 4096 + d * 64 + e]); } }
    for (int m = 4 * gw; m < M_TOK; m += 4 * NGW) xg_row4(p.x + (size_t)m * D_MODEL, (u16*)(p.ws + WS_XG) + (size_t)m * D_MODEL, (float*)(p.ws + WS_RSS) + (size_t)m * 16, lane);
}
__device__ __forceinline__ void ph_proj(const Params& p, int l, LAS unsigned char* L, const int WV) {
    unsigned char* ws = opq(p.ws);
    pg8::Gemm g{(const u16*)(ws + WS_XG), (const u16*)(ws + (l ? WS_WIN1 : WS_WIN0)), M_TOK, NPROJ, D_MODEL, D_MODEL};
    pg8::StaticOrder S; S.init(M_TOK, NPROJ, gridDim.x, blockIdx.x);
    pg8::EpiProj E{(const float*)(ws + WS_RSS), (const float*)(ws + WS_CS), (const float*)(ws + WS_CS) + M_TOK * 8,
                   (u16*)(ws + WS_Q), (u16*)(ws + WS_K), (u16*)(ws + WS_V), (u16*)(ws + WS_QI), (u16*)(ws + WS_KI), (u16*)(ws + WS_GQK), (u16*)(ws + WS_GV), (u16*)(ws + WS_GR), (u16*)(ws + WS_UC),
                   (float*)(ws + WS_WI), (float*)(ws + WS_GL), L + pg8::STAGE_BYTES};
    pg8::gemm_phase<pg8::EpiProj, pg8::StaticOrder, true, true, true>(L, g, S, E, WV);
}
__device__ __forceinline__ void ph_out(const Params& p, int l, LAS unsigned char* L, const int WV, bool dummy = false) {
    unsigned char* ws = opq(p.ws);
    pg8::Gemm g{(const u16*)(ws + WS_MIX), (const u16*)(ws + (l ? WS_WOUT1 : WS_WOUT0)), M_TOK, D_MODEL, D_MODEL, D_MODEL};
    pg8::StaticOrder S; S.init(M_TOK, D_MODEL, gridDim.x, blockIdx.x);
    pg8::EpiResid E{(u16*)(ws + (dummy ? WS_Q : WS_XG)), (float*)(ws + (dummy ? WS_QI : WS_RSS))};
    pg8::gemm_phase<pg8::EpiResid, pg8::StaticOrder, true, true, true>(L, g, S, E, WV);
}
__device__ __forceinline__ void ph_up(const Params& p, int l, LAS unsigned char* L, const int WV) {
    unsigned char* ws = opq(p.ws);
    pg8::Gemm g{(const u16*)(ws + WS_XG), (const u16*)(ws + WS_WUP), M_TOK, 2 * D_FF, D_MODEL, D_MODEL};
    pg8::HaloOrder S; S.init(2 * D_FF, gridDim.x, blockIdx.x);
    pg8::EpiUpConv E{(const float*)(ws + WS_RSS), p.conv_w + (size_t)l * 3 * D_FF, p.conv_b + (size_t)l * D_FF, (u16*)(ws + WS_AB), (LAS float*)(L + pg8::STAGE_BYTES)};
    pg8::gemm_phase<pg8::EpiUpConv, pg8::HaloOrder, true, true, true>(L, g, S, E, WV);
}
__device__ __forceinline__ void ph_down(const Params& p, int l, LAS unsigned char* L, const int WV, bool dummy = false) {
    unsigned char* ws = opq(p.ws);
    pg8::Gemm g{(const u16*)(ws + WS_AB), (const u16*)(ws + WS_WDN), M_TOK, D_MODEL, D_FF, D_FF};
    pg8::StaticOrder S; S.init(M_TOK, D_MODEL, gridDim.x, blockIdx.x);
    pg8::EpiResid E{(u16*)(ws + (dummy ? WS_MIX : WS_XG)), (float*)(ws + (dummy ? WS_LIST : WS_RSS))};
    pg8::gemm_phase<pg8::EpiResid, pg8::StaticOrder, true, true, true>(L, g, S, E, WV);
}
__device__ __forceinline__ void ph_convgate(const Params& p, int l, const int WV) {
    u16* AB = (u16*)(opq(p.ws) + WS_AB);
    const float* cw = p.conv_w + (size_t)l * 3 * D_FF; const float* cb = p.conv_b + (size_t)l * D_FF;
    constexpr int CPR = D_FF / 8;
    for (long it = (long)blockIdx.x * NTHR + otid(WV); it < (long)M_TOK * CPR; it += (long)gridDim.x * NTHR) {
        const int row = (int)(it / CPR), c0 = (int)(it % CPR) * 8, pos = row & (SEQ - 1);
        const u16* pa = AB + (size_t)row * (2 * D_FF) + c0;
        const u32x4 a0 = *(const u32x4*)pa; u32x4 a1 = {0u, 0u, 0u, 0u}, a2 = a1;
        if (pos >= 1) a1 = *(const u32x4*)(pa - 2 * D_FF);
        if (pos >= 2) a2 = *(const u32x4*)(pa - 4 * D_FF);
        const u32x4 bb = *(const u32x4*)(pa + D_FF);
        u32x4 o;
#pragma unroll
        for (int q = 0; q < 4; ++q) {
            float r[2];
#pragma unroll
            for (int e = 0; e < 2; ++e) { const int kk = c0 + q * 2 + e;
                const float x0 = h2f(e ? (a0[q] >> 16) : (a0[q] & 0xffffu)), x1 = h2f(e ? (a1[q] >> 16) : (a1[q] & 0xffffu)), x2 = h2f(e ? (a2[q] >> 16) : (a2[q] & 0xffffu)), bv = h2f(e ? (bb[q] >> 16) : (bb[q] & 0xffffu));
                const float cv = cb[kk] + x2 * cw[kk] + x1 * cw[D_FF + kk] + x0 * cw[2 * D_FF + kk]; r[e] = silu_f(cv) * bv; }
            o[q] = pkh(r[0], r[1]);
        }
        *(u32x4*)(AB + (size_t)row * (2 * D_FF) + D_FF + c0) = o;
    }
}
__device__ __forceinline__ void ph_final(const Params& p, const int WV) {
    unsigned char* wsf = opq(p.ws); const float* rss = (const float*)(wsf + WS_RSS); unsigned* ctl = (unsigned*)(wsf + WS_CTL);
    const unsigned badu = __hip_atomic_load(ctl + CW_FAIL, __ATOMIC_RELAXED, __HIP_MEMORY_SCOPE_AGENT), bado = __hip_atomic_load(ctl + CW_FAIL + 1, __ATOMIC_RELAXED, __HIP_MEMORY_SCOPE_AGENT),
                   badb = __hip_atomic_load(ctl + CW_BAR + XB_TMO, __ATOMIC_RELAXED, __HIP_MEMORY_SCOPE_AGENT);
    const bool bad = (badu | bado | badb) != 0u;
    typedef __attribute__((address_space(1))) f32x4 gf4; typedef unsigned u2v __attribute__((ext_vector_type(2))); typedef __attribute__((address_space(1))) u2v gu2;
    const long total = (long)M_TOK * (D_MODEL / 4), stride = (long)gridDim.x * NTHR;
    long it = (long)blockIdx.x * NTHR + otid(WV);
    for (; it + 3 * stride < total; it += 4 * stride) {
        f32x4 pr[4][4], g[4]; u2v xw[4];
#pragma unroll
        for (int k = 0; k < 4; ++k) { const long i2 = it + k * stride; const int row = (int)(i2 >> 8), c = (int)(i2 & 255) * 4;
#pragma unroll
            for (int q = 0; q < 4; ++q) pr[k][q] = *(const gf4*)(rss + (size_t)row * 16 + 4 * q);
            g[k] = *(const gf4*)(p.final_g + c); xw[k] = *(const gu2*)((const u16*)(wsf + WS_XG) + (size_t)row * D_MODEL + c); }
#pragma unroll
        for (int k = 0; k < 4; ++k) { const long i2 = it + k * stride; const int row = (int)(i2 >> 8), c = (int)(i2 & 255) * 4;
            const f32x4 s4 = (pr[k][0] + pr[k][1]) + (pr[k][2] + pr[k][3]); const float rs = rsqrtf(((s4[0] + s4[1]) + (s4[2] + s4[3])) * (1.f / D_MODEL) + EPS);
            f32x4 o = (f32x4){h2f(xw[k].x & 0xffffu), h2f(xw[k].x >> 16), h2f(xw[k].y & 0xffffu), h2f(xw[k].y >> 16)} * rs * g[k]; if (bad) { const float qn = __builtin_nanf(""); o = (f32x4){qn, qn, qn, qn}; }
            *(gf4*)(p.out + (size_t)row * D_MODEL + c) = o; }
    }
    for (; it < total; it += stride) {
        const int row = (int)(it >> 8), c = (int)(it & 255) * 4; const float rs = pg8::row_rs(rss, row);
        f32x4* px = (f32x4*)(p.out + (size_t)row * D_MODEL + c); const f32x4 g = *(const f32x4*)(p.final_g + c);
        const uint2 xw = *(const uint2*)((const u16*)(wsf + WS_XG) + (size_t)row * D_MODEL + c);
        f32x4 o = (f32x4){h2f(xw.x & 0xffffu), h2f(xw.x >> 16), h2f(xw.y & 0xffffu), h2f(xw.y >> 16)} * rs * g; if (bad) { const float qn = __builtin_nanf(""); o = (f32x4){qn, qn, qn, qn}; } *px = o;
    }
}
__device__ __forceinline__ void ph_mix1(const Params& p, int l, LAS unsigned char* L, const int WV) {
    unsigned char* ws = opq(p.ws); unsigned char* ob = (unsigned char*)opq(p.out);   unsigned* ctl = (unsigned*)(ws + WS_CTL);
    const int tid = otid(WV), lane = tid & 63, wave = tid >> 6, half = tid >> 8, t = tid & 255;
#ifdef REP_TOPK
#pragma unroll 1
    for (int i = 0; i < 4; ++i) {
#else
#pragma unroll 1
    for (int i = 0; i < 2; ++i) {
#endif
        const int pairs = 256;
        for (int w = blockIdx.x; w < pairs; w += gridDim.x) { const int it = ((i & 1) == 0) ? w : 511 - w;
            topk_unit(it & 1, 255 - (it >> 1), (const u16*)(ws + WS_QI), (const u16*)(ws + WS_KI), (const float*)(ws + WS_WI), (unsigned long long*)(ob + OUT_MASK),
                      (uint2*)(ws + WS_LIST) + (size_t)blockIdx.x * 32 * TK_CAP, ctl, L, WV); }
    }
    __syncthreads();
    if (l == 1) {
        LAS float* scr = (LAS float*)(L + WV * TR_SCR_BYTES); LAS float* gains = (LAS float*)(L + TR_GAIN_OFF); const int gw = blockIdx.x * NWAVES + WV, NGW = gridDim.x * NWAVES;
        tr_fill_gains(p, gains, tid); __syncthreads();
        wconv_stream(p, 0x76u, 2, wconv_items(2) + wconv_items(3), scr, gains, lane, gw, NGW);
        __syncthreads();
    }
    for (int item = blockIdx.x; item < 256; item += gridDim.x)
        gla::pass1_item(item, L, (const float*)(ws + WS_GL), (const u16*)(ws + WS_GQK), (const u16*)(ws + WS_GV), (const u16*)(ws + WS_UC), (const u16*)(ws + WS_WPT) + (size_t)l * 16384,
                        p.w_gate_up + l * 16 * 128, p.b_gate + l * 128, p.pool_scale + l * 256, (float*)(ob + OUT_GST), (float*)(ob + OUT_GST + 8 * MiB), (u16*)(ws + WS_MIX), WV);
}
__device__ __forceinline__ void ph_attn(const Params& p, int l, LAS unsigned char* L, char* Lg, const int WV) {
    unsigned char* ws = opq(p.ws); unsigned char* ob = (unsigned char*)opq(p.out);
    unsigned* ctl = (unsigned*)(ws + WS_CTL);
    { float* DS = (float*)(ob + OUT_GST); const float* DD = (const float*)(ob + OUT_GST + 8 * MiB);
      const int tid = otid(WV), el = blockIdx.x * 64 + (tid & 63), seg = tid >> 6, bh = el >> 11, de = el & 2047;
      LAS float* pq = (LAS float*)L;
      __syncthreads();
      typedef __attribute__((address_space(1))) float gfl;
      float dsv[16], ddv[16];
      if (el < 16384) {
#pragma unroll
          for (int k = 0; k < 16; ++k) { const int blk = bh * 128 + seg * 16 + k; ddv[k] = *(const gfl*)(DD + blk * 32 + (de >> 6)); dsv[k] = *(const gfl*)(DS + (size_t)blk * 2048 + de); }
          float P = 1.f, Q = 0.f;
#pragma unroll
          for (int k = 0; k < 16; ++k) { Q = ddv[k] * Q + dsv[k]; P *= ddv[k]; }
          pq[(seg * 64 + (tid & 63)) * 2] = P; pq[(seg * 64 + (tid & 63)) * 2 + 1] = Q;
      }
      __syncthreads();
      if (el < 16384) {
          float S = 0.f;
          for (int s2 = 0; s2 < seg; ++s2) S = pq[(s2 * 64 + (tid & 63)) * 2] * S + pq[(s2 * 64 + (tid & 63)) * 2 + 1];
#pragma unroll
          for (int k = 0; k < 16; ++k) { const int blk = bh * 128 + seg * 16 + k; *(gfl*)(DS + (size_t)blk * 2048 + de) = S; S = ddv[k] * S + dsv[k]; }
      }
    }
    asm volatile("s_waitcnt vmcnt(0)" ::: "memory");
    __syncthreads();
    if (otid(WV) == 0) { __builtin_amdgcn_fence(__ATOMIC_RELEASE, "agent"); asm volatile("s_waitcnt vmcnt(0)" ::: "memory");
        (void)__hip_atomic_fetch_add(ctl + CW_SCAN, 1u, __ATOMIC_RELAXED, __HIP_MEMORY_SCOPE_AGENT); }
    const attn_body::AttnTensors AT{(const attn_body::bf16*)(ws + WS_Q), (const attn_body::bf16*)(ws + WS_K), (const attn_body::bf16*)(ws + WS_V), (unsigned short*)(ws + WS_MIX), (const unsigned long long*)(ob + OUT_MASK)};
    const attn_body::StaticOrder S((int)gridDim.x, (int)blockIdx.x);
    attn_body::attn_phase<attn_body::StaticOrder>((char*)L, AT, S, WV);
#ifdef REP_ATT2
    attn_body::attn_phase<attn_body::StaticOrder>((char*)L, AT, S, WV);
#endif
    __syncthreads();
    if (otid(WV) == 0) { const unsigned target = gridDim.x * (unsigned)(l + 1); unsigned* bar = ctl + CW_BAR;
        XB_SPIN(xb_ld(ctl + CW_SCAN) < target, bar);
        __builtin_amdgcn_fence(__ATOMIC_ACQUIRE, "agent"); asm volatile("s_waitcnt vmcnt(0)" ::: "memory"); }
    __syncthreads();
    for (int item = blockIdx.x; item < 256; item += gridDim.x)
        gla::pass2_item(item, L, Lg, (const float*)(ws + WS_GL), (const u16*)(ws + WS_GQK), (const u16*)(ws + WS_GV), (const u16*)(ws + WS_GR), p.w_gate_up + l * 16 * 128, p.b_gate + l * 128,
                        (const float*)(ob + OUT_GST), p.gla_norm_g + l * 256, (u16*)(ws + WS_MIX), WV);
}

__global__ void __launch_bounds__(NTHR, 2) k_fwd(Params p) {
    extern __shared__ __attribute__((aligned(16))) unsigned char lds[];
    LAS unsigned char* L = (LAS unsigned char*)lds;
    volatile LAS unsigned* st = (volatile LAS unsigned*)(L + LDS_BARST);
    if (threadIdx.x < 16) st[threadIdx.x] = 0u;
    __syncthreads();
    (void)xcd_barrier_post((unsigned*)(p.ws + WS_CTL) + CW_BAR, st);
#define GRID_BAR() do { XcdBarrier bar_; bar_.bar = (unsigned*)(opq(p.ws) + WS_CTL) + CW_BAR; bar_.x = xb_xcc_id(); bar_.st = (volatile LAS unsigned*)(L + LDS_BARST); xcd_barrier(bar_); } while (0)
    const int WV = __builtin_amdgcn_readfirstlane(threadIdx.x >> 6);
    ph_prologue(p, L, WV); GRID_BAR();
#ifdef REP_PRO
    ph_prologue(p, L, WV); GRID_BAR();
#endif
#pragma unroll 1
    for (int l = 0; l < DEPTH; ++l) {
#ifndef NO_PROJ
        ph_proj(p, l, L, WV); GRID_BAR();
#ifdef REP_PROJ
        ph_proj(p, l, L, WV); GRID_BAR();
#endif
#endif
#ifndef NO_MIX1
        ph_mix1(p, l, L, WV); GRID_BAR();
#ifdef REP_MIX1
        ph_mix1(p, l, L, WV); GRID_BAR();
#endif
#endif
        ph_attn(p, l, L, (char*)lds, WV); GRID_BAR();
        ph_out(p, l, L, WV); GRID_BAR();
#ifdef REP_OUT
        ph_out(p, l, L, WV, true); GRID_BAR();
#endif
        ph_up(p, l, L, WV); GRID_BAR();
#ifdef REP_UP
        ph_up(p, l, L, WV); GRID_BAR();
#endif
#ifdef REP_DOWN
        ph_down(p, l, L, WV, true); GRID_BAR();
#endif
        ph_down(p, l, L, WV); GRID_BAR();
    }
    ph_final(p, WV);
#undef GRID_BAR
}

extern "C" void kernel_launch(void* const* d_in, const int* in_sizes, int n_in, void* d_out, int out_size, void* d_ws, size_t ws_size, hipStream_t stream) {
    static int grid = 0;
    if (grid == 0) {
        int dev = 0, cus = 0, per_cu = 0; (void)hipGetDevice(&dev); (void)hipDeviceGetAttribute(&cus, hipDeviceAttributeMultiprocessorCount, dev);
        (void)hipFuncSetAttribute((const void*)k_fwd, hipFuncAttributeMaxDynamicSharedMemorySize, LDS_BYTES);
        (void)hipOccupancyMaxActiveBlocksPerMultiprocessor(&per_cu, (const void*)k_fwd, NTHR, LDS_BYTES);
        (void)hipGetLastError();
        grid = cus > 0 ? cus : 256;
        if (per_cu < 1) fprintf(stderr, "kernel_launch: occupancy query reports %d workgroups per CU\n", per_cu);
        if (ws_size < WS_END) fprintf(stderr, "kernel_launch: workspace too small (%zu)\n", ws_size);
    }
    Params p; memset(&p, 0, sizeof(p));
    p.x = (const float*)d_in[0]; p.pos = (const int*)d_in[1]; p.norm1_g = (const float*)d_in[2]; p.w_in = (const float*)d_in[3]; p.w_gate_up = (const float*)d_in[4]; p.b_gate = (const float*)d_in[5];
    p.gla_norm_g = (const float*)d_in[6]; p.w_pool = (const float*)d_in[7]; p.pool_scale = (const float*)d_in[8]; p.w_out = (const float*)d_in[9]; p.norm2_g = (const float*)d_in[10]; p.w_up = (const float*)d_in[11];
    p.conv_w = (const float*)d_in[12]; p.conv_b = (const float*)d_in[13]; p.w_down = (const float*)d_in[14]; p.final_g = (const float*)d_in[15];
    p.out = (float*)d_out; p.ws = (unsigned char*)d_ws;
    (void)hipMemsetAsync(d_ws, 0, CTL_ZERO_BYTES, stream);
    void* args[] = {&p};
    hipError_t e = hipLaunchCooperativeKernel((const void*)k_fwd, dim3(grid), dim3(NTHR), args, LDS_BYTES, stream);
    if (e != hipSuccess) fprintf(stderr, "kernel_launch: cooperative launch failed: %s (grid %d)\n", hipGetErrorString(e), grid);
}
```

```cpp
#include <hip/hip_runtime.h>
#include <cstdint>
#include <cstdio>
#include <cstring>

typedef unsigned short u16;
typedef _Float16 f16x8 __attribute__((ext_vector_type(8)));

constexpr int D_MODEL = 1024, BATCH = 2, SEQ = 8192, DEPTH = 2, M_TOK = BATCH * SEQ;
constexpr int IN_WIDTH = 2900, NPROJ = 3072;
constexpr int D_FF = 2816;
constexpr float EPS = 1e-6f;
constexpr int TOPK = 256;
constexpr float C2 = 0.125f * 1.4426950408889634f;

constexpr size_t MiB = 1u << 20;
constexpr size_t WS_CTL = 0, CTL_ZERO_BYTES = 64 * 1024;
constexpr size_t WS_CS = 1 * MiB;
constexpr size_t WS_WI = 2 * MiB;
constexpr size_t WS_WPT = 2 * MiB + 512 * 1024;
constexpr size_t WS_GL = 3 * MiB;
constexpr size_t WS_RSS = 4 * MiB;
constexpr size_t WS_WIN0 = 5 * MiB, WS_WOUT0 = 11 * MiB, WS_WIN1 = 13 * MiB, WS_WOUT1 = 19 * MiB;
constexpr size_t WS_WUP = 21 * MiB, WS_WDN = 32 * MiB;
constexpr size_t WS_XG = 38 * MiB;
constexpr size_t WS_AB = 70 * MiB;
constexpr size_t WS_Q = 70 * MiB, WS_K = 86 * MiB, WS_V = 102 * MiB;
constexpr size_t WS_QI = 118 * MiB;
constexpr size_t WS_KI = 126 * MiB;
constexpr size_t WS_GQK = 128 * MiB, WS_GV = 136 * MiB, WS_GR = 144 * MiB, WS_UC = 152 * MiB;
constexpr size_t WS_MIX = 160 * MiB;
constexpr size_t WS_LIST = 192 * MiB;
constexpr size_t OUT_MASK = 0;
constexpr size_t OUT_GST = 16 * MiB;
constexpr size_t WS_END = 256 * MiB;

__device__ __forceinline__ unsigned f2bf(float f) { unsigned u = __float_as_uint(f); return (u + 0x7fffu + ((u >> 16) & 1u)) >> 16; }
__device__ __forceinline__ float bf2f(unsigned h) { return __uint_as_float(h << 16); }
__device__ __forceinline__ unsigned f2h(float f) { _Float16 h = (_Float16)f; return (unsigned)__builtin_bit_cast(unsigned short, h); }
__device__ __forceinline__ float h2f(unsigned h) { return (float)__builtin_bit_cast(_Float16, (unsigned short)h); }
typedef float f32x2_t __attribute__((ext_vector_type(2))); typedef __bf16 bf16x2_t __attribute__((ext_vector_type(2))); typedef _Float16 f16x2_t __attribute__((ext_vector_type(2)));
__device__ __forceinline__ unsigned pkbf(float lo, float hi) { f32x2_t v = {lo, hi}; bf16x2_t b = __builtin_convertvector(v, bf16x2_t); return __builtin_bit_cast(unsigned, b); }
__device__ __forceinline__ unsigned pkh(float lo, float hi) { f32x2_t v = {lo, hi}; f16x2_t b = __builtin_convertvector(v, f16x2_t); return __builtin_bit_cast(unsigned, b); }
__device__ __forceinline__ float shfl_upL(float v, int o, int lane) { return __int_as_float(__builtin_amdgcn_ds_bpermute(((lane - o) & 63) << 2, __float_as_int(v))); }
__device__ __forceinline__ int shfl_upL(int v, int o, int lane) { return __builtin_amdgcn_ds_bpermute(((lane - o) & 63) << 2, v); }
__device__ __forceinline__ float shfl_xorL(float v, int x, int lane) { return __int_as_float(__builtin_amdgcn_ds_bpermute((lane ^ x) << 2, __float_as_int(v))); }
__device__ __forceinline__ float wave_sum(float v) {
    int r = __float_as_int(v);
#define WS_STEP(ctrl, rm) r = __float_as_int(__int_as_float(r) + __int_as_float(__builtin_amdgcn_update_dpp(0, r, ctrl, rm, 0xf, true)))
    WS_STEP(0x111, 0xf); WS_STEP(0x112, 0xf); WS_STEP(0x114, 0xf); WS_STEP(0x118, 0xf); WS_STEP(0x142, 0xa); WS_STEP(0x143, 0xc);
#undef WS_STEP
    return __int_as_float(__builtin_amdgcn_readlane(r, 63));
}
__device__ __forceinline__ int otid(int wv) { int l; asm volatile("v_mbcnt_lo_u32_b32 %0, -1, 0\n\tv_mbcnt_hi_u32_b32 %0, -1, %0" : "=v"(l)); return wv * 64 + l; }
template <class T> __device__ __forceinline__ T* opq(T* p) { asm volatile("" : "+s"(p)); return (T*)(__attribute__((address_space(1))) T*)p; }
typedef float f32x16_g __attribute__((ext_vector_type(16)));
__device__ __forceinline__ f32x16_g zero16() { float z = 0.f; asm volatile("" : "+v"(z)); f32x16_g r;
#pragma unroll
    for (int i = 0; i < 16; ++i) r[i] = z;
    return r; }
__device__ __forceinline__ float silu_f(float x) { return x * __builtin_amdgcn_rcpf(1.f + __expf(-x)); }

namespace pg8 {
#define PG8_LAS __attribute__((address_space(3)))
typedef unsigned short bf16_t;
typedef short bf16x8 __attribute__((ext_vector_type(8)));
typedef float f32x4 __attribute__((ext_vector_type(4)));
typedef unsigned u32x4 __attribute__((ext_vector_type(4)));
constexpr int BM = 256, BK = 64, HALF = 128, HTB = HALF * BK * 2  , STAGE_BYTES = 8 * HTB, NXCD = 8, WGM = 8;

__host__ __device__ __forceinline__ int lds_byte(int r, int c) { const int st = (r >> 4) * 2 + (c >> 5), rr = r & 15, cc = c & 31, ob = rr * 64 + cc * 2; return st * 1024 + (ob ^ (((ob >> 9) & 1) << 5)); }
__host__ __device__ __forceinline__ void stage_rc(int b, int& R, int& C) { const int st = b / 1024, sb = b % 1024, swz = sb ^ (((sb >> 9) & 1) << 5); R = (st >> 1) * 16 + swz / 64; C = (st & 1) * 32 + (swz % 64) / 2; }
__host__ __device__ __forceinline__ int perm32(int rho) { const int n = rho >> 4, i = rho & 15; return 8 * (i >> 2) + 4 * n + (i & 3); }

struct Unit { int pm, pn, row0, lo; };
struct Gemm { const bf16_t* A; const bf16_t* Bt; int M, N, K, lda; };

struct StaticOrder {
    int nM, nN, nwg, G, c;
    __host__ __device__ void init(int M, int N, int G_, int c_) { nM = M / BM; nN = N / BM; nwg = nM * nN; G = G_; c = c_; }
    __host__ __device__ bool next(int i, Unit& u) const {
        const long L = (long)i * G + c; if (L >= nwg) return false;
        int wgid = (int)L; { const int q = nwg / NXCD, r = nwg % NXCD, xcd = wgid % NXCD, off = wgid / NXCD; wgid = (xcd < r ? xcd * (q + 1) : r * (q + 1) + (xcd - r) * q) + off; }
        const int nig = WGM * nN, gid = wgid / nig, fm = gid * WGM, gsz = (nM - fm) < WGM ? (nM - fm) : WGM;
        u.pm = fm + ((wgid % nig) % gsz); u.pn = (wgid % nig) / gsz; u.row0 = u.pm * BM; u.lo = 0; return true;
    }
    __device__ __forceinline__ void a_ready(const Unit&) const {}
    __device__ __forceinline__ void done(const Unit&) const {}
};
struct HaloOrder {
    StaticOrder base;
    __host__ __device__ void init(int N, int G_, int c_) { base.init(66 * BM, N, G_, c_); }
    __host__ __device__ bool next(int i, Unit& u) const {
        if (!base.next(i, u)) return false;
        const int bt = u.pm / 33, ti = u.pm % 33, s = (254 * ti < 7936) ? 254 * ti : 7936;
        u.row0 = bt * 8192 + s; u.lo = (ti == 0) ? 0 : (254 * ti + 2 - s); return true;
    }
    __device__ __forceinline__ void a_ready(const Unit&) const {}
    __device__ __forceinline__ void done(const Unit&) const {}
};

__device__ __forceinline__ float row_rs(const float* rss, int row) {
    const f32x4* rp = (const f32x4*)(rss + (size_t)row * 16);
    const f32x4 s0 = rp[0], s1 = rp[1], s2 = rp[2], s3 = rp[3];
    const float t = (((s0[0] + s0[1]) + (s0[2] + s0[3])) + ((s1[0] + s1[1]) + (s1[2] + s1[3]))) + (((s2[0] + s2[1]) + (s2[2] + s2[3])) + ((s3[0] + s3[1]) + (s3[2] + s3[3])));
    return rsqrtf(t * (1.f / D_MODEL) + EPS);
}
__device__ __forceinline__ float row_rs4(const float* rss, int row, int fq, int lane) {
    const f32x4 s = *(const f32x4*)(rss + (size_t)row * 16 + 4 * fq);
    float t = (s[0] + s[1]) + (s[2] + s[3]);
    t += shfl_xorL(t, 16, lane); t += shfl_xorL(t, 32, lane);
    return rsqrtf(t * (1.f / D_MODEL) + EPS);
}
__device__ __forceinline__ u32x4 pack8_bf(const f32x4& a, const f32x4& b) { u32x4 w; w.x = pkbf(a[0], a[1]); w.y = pkbf(a[2], a[3]); w.z = pkbf(b[0], b[1]); w.w = pkbf(b[2], b[3]); return w; }
__device__ __forceinline__ u32x4 pack8_h(const f32x4& a, const f32x4& b) { u32x4 w; w.x = pkh(a[0], a[1]); w.y = pkh(a[2], a[3]); w.z = pkh(b[0], b[1]); w.w = pkh(b[2], b[3]); return w; }

typedef __attribute__((address_space(1))) u32x4 gu32x4_t;
typedef __attribute__((address_space(1))) f32x4 gf32x4_t;
struct gu32x2_t { typedef unsigned vt __attribute__((ext_vector_type(2))); typedef __attribute__((address_space(1))) vt* pt; };
struct EpiProj {
    static constexpr bool PERM = true, AFTER_DRAIN = false;
    const float* rss; const float* cs; const float* sn;
    u16 *Q, *K, *V, *QI, *KI, *GQK, *GV, *GR, *UC; float *WI, *GL;
    PG8_LAS unsigned char* xl;
    __device__ __forceinline__ void operator()(const f32x4 (&acc)[2][2][4][2], const Unit& u, int wr, int wc, int fr, int fq) const {
        asm volatile("" : "+v"(fr), "+v"(fq));
        const int pn = u.pn, ln = fq * 16 + fr;
        const bool ropetile = (pn < 4) || pn == 6 || pn == 7;
        PG8_LAS float* rsL = (PG8_LAS float*)xl; PG8_LAS u32x4* csL = (PG8_LAS u32x4*)(xl + 1024);
        {   const int t = (wr * 4 + wc) * 64 + ln, r = t >> 1, part = t & 1, grow = u.row0 + r;
            const f32x4 pa = *(const gf32x4_t*)(rss + (size_t)grow * 16 + 8 * part), pb = *(const gf32x4_t*)(rss + (size_t)grow * 16 + 8 * part + 4);
            f32x4 ca = {0.f, 0.f, 0.f, 0.f}, sa = ca;
            if (ropetile) { ca = *(const gf32x4_t*)(cs + (size_t)grow * 8 + 4 * part); sa = *(const gf32x4_t*)(sn + (size_t)grow * 8 + 4 * part); }
            float sm = ((pa[0] + pa[1]) + (pa[2] + pa[3])) + ((pb[0] + pb[1]) + (pb[2] + pb[3]));
            sm += shfl_xorL(sm, 1, ln);
            if (part == 0) rsL[r] = rsqrtf(sm * (1.f / D_MODEL) + EPS);
            if (ropetile) { u32x4 w; w.x = pkh(ca[0], ca[1]); w.y = pkh(ca[2], ca[3]); w.z = pkh(sa[0], sa[1]); w.w = pkh(sa[2], sa[3]); csL[t] = w; }
            asm volatile("s_waitcnt lgkmcnt(0)" ::: "memory"); __builtin_amdgcn_s_barrier(); asm volatile("" ::: "memory");
        }
#pragma unroll
        for (int it = 0; it < 8; ++it) {
            const int ai = it >> 2, m = it & 3, lr = ai * HALF + wr * 64 + m * 16 + fr, row = u.row0 + lr;
            const float rs = rsL[lr];
            f32x4 c0 = {0.f, 0.f, 0.f, 0.f}, c1 = c0, s0 = c0, s1 = c0;
            if (ropetile) { const u32x4 e0 = csL[2 * lr], e1 = csL[2 * lr + 1];
                c0 = (f32x4){h2f(e0.x & 0xffffu), h2f(e0.x >> 16), h2f(e0.y & 0xffffu), h2f(e0.y >> 16)}; s0 = (f32x4){h2f(e0.z & 0xffffu), h2f(e0.z >> 16), h2f(e0.w & 0xffffu), h2f(e0.w >> 16)};
                c1 = (f32x4){h2f(e1.x & 0xffffu), h2f(e1.x >> 16), h2f(e1.y & 0xffffu), h2f(e1.y >> 16)}; s1 = (f32x4){h2f(e1.z & 0xffffu), h2f(e1.z >> 16), h2f(e1.w & 0xffffu), h2f(e1.w >> 16)}; }
#pragma unroll
            for (int bj = 0; bj < 2; ++bj) {
                f32x4 v0 = acc[ai][bj][m][0] * rs, v1 = acc[ai][bj][m][1] * rs;
                const int cl = bj * HALF + wc * 32 + fq * 8;
                if (ropetile) {
                    f32x4 p0, p1;
#pragma unroll
                    for (int e = 0; e < 4; ++e) { p0[e] = shfl_xorL(v0[e], 16, ln); p1[e] = shfl_xorL(v1[e], 16, ln); }
                    const bool dorope = ((wc & 1) == 0) && (fq < 2) && (pn != 7 || (bj == 0 && wc == 0));
                    if (dorope) {
                        if (fq == 0) { v0 = v0 * c0 - p0 * s0; v1 = v1 * c1 - p1 * s1; }
                        else         { v0 = v0 * c0 + p0 * s0; v1 = v1 * c1 + p1 * s1; }
                    }
                }
                if (pn < 2)       { *(gu32x4_t*)(Q + (size_t)row * 512 + pn * 256 + cl) = pack8_bf(v0 * C2, v1 * C2); }
                else if (pn < 4)  { *(gu32x4_t*)(K + (size_t)row * 512 + (pn - 2) * 256 + cl) = pack8_bf(v0, v1); }
                else if (pn < 6)  { *(gu32x4_t*)(V + (size_t)row * 512 + (pn - 4) * 256 + cl) = pack8_bf(v0, v1); }
                else if (pn == 6) { *(gu32x4_t*)(QI + (size_t)row * 256 + cl) = pack8_h(v0, v1); }
                else if (pn == 7) {
                    if (cl < 64) *(gu32x4_t*)(KI + (size_t)row * 64 + cl) = pack8_h(v0, v1);
                    else if (cl == 64) *(gf32x4_t*)(WI + (size_t)row * 4) = v0;
                    else if (cl == 72) { *(gf32x4_t*)(GL + (size_t)row * 16) = v0; *(gf32x4_t*)(GL + (size_t)row * 16 + 4) = v1; }
                    else if (cl == 80) { *(gf32x4_t*)(GL + (size_t)row * 16 + 8) = v0; *(gf32x4_t*)(GL + (size_t)row * 16 + 12) = v1; }
                }
                else if (pn == 8) { *(gu32x4_t*)(GQK + (size_t)row * 256 + cl) = pack8_bf(v0, v1); }
                else if (pn == 9) { *(gu32x4_t*)(GV + (size_t)row * 256 + cl) = pack8_bf(v0, v1); }
                else if (pn == 10) { *(gu32x4_t*)(GR + (size_t)row * 256 + cl) = pack8_bf(v0, v1); }
                else { *(gu32x4_t*)(UC + (size_t)row * 256 + cl) = pack8_bf(v0, v1); }
            }
        }
    }
};
struct EpiResid {
    static constexpr bool PERM = true, AFTER_DRAIN = false;
    u16* X; float* rss;
    __device__ __forceinline__ void operator()(const f32x4 (&acc)[2][2][4][2], const Unit& u, int wr, int wc, int fr, int fq) const {
        asm volatile("" : "+v"(fr), "+v"(fq));
        const int ln = fq * 16 + fr;
        u16* xb = X + (size_t)(u.row0 + wr * 64 + fr) * D_MODEL + u.pn * BM + wc * 32 + fq * 8;
        u32x4 xw[2][4][2];
#pragma unroll
        for (int ai = 0; ai < 2; ++ai)
#pragma unroll
            for (int m = 0; m < 4; ++m)
#pragma unroll
                for (int bj = 0; bj < 2; ++bj) xw[ai][m][bj] = *(const gu32x4_t*)(xb + (size_t)(ai * HALF + m * 16) * D_MODEL + bj * HALF);
#pragma unroll
        for (int ai = 0; ai < 2; ++ai)
#pragma unroll
            for (int m = 0; m < 4; ++m) {
                const int row = u.row0 + ai * HALF + wr * 64 + m * 16 + fr; float ss = 0.f;
#pragma unroll
                for (int bj = 0; bj < 2; ++bj) {
                    const u32x4 w = xw[ai][m][bj];
                    const f32x4 o0 = (f32x4){h2f(w[0] & 0xffffu), h2f(w[0] >> 16), h2f(w[1] & 0xffffu), h2f(w[1] >> 16)} + acc[ai][bj][m][0];
                    const f32x4 o1 = (f32x4){h2f(w[2] & 0xffffu), h2f(w[2] >> 16), h2f(w[3] & 0xffffu), h2f(w[3] >> 16)} + acc[ai][bj][m][1];
                    ss += (o0[0] * o0[0] + o0[1] * o0[1]) + (o0[2] * o0[2] + o0[3] * o0[3]) + (o1[0] * o1[0] + o1[1] * o1[1]) + (o1[2] * o1[2] + o1[3] * o1[3]);
                    *(gu32x4_t*)(xb + (size_t)(ai * HALF + m * 16) * D_MODEL + bj * HALF) = pack8_h(o0, o1);
                }
                ss += shfl_xorL(ss, 16, ln); ss += shfl_xorL(ss, 32, ln);
                if (fq == 0) *(__attribute__((address_space(1))) float*)(rss + (size_t)row * 16 + u.pn * 4 + wc) = ss;
            }
    }
};
struct EpiUp {
    static constexpr bool PERM = true, AFTER_DRAIN = false;
    const float* rss; u16* AB;
    __device__ __forceinline__ void operator()(const f32x4 (&acc)[2][2][4][2], const Unit& u, int wr, int wc, int fr, int fq) const {
        asm volatile("" : "+v"(fr), "+v"(fq));
#pragma unroll
        for (int ai = 0; ai < 2; ++ai)
#pragma unroll
            for (int m = 0; m < 4; ++m) {
                const int row = u.row0 + ai * HALF + wr * 64 + m * 16 + fr; const float rs = row_rs(rss, row);
#pragma unroll
                for (int bj = 0; bj < 2; ++bj) *(u32x4*)(AB + (size_t)row * (2 * D_FF) + u.pn * BM + bj * HALF + wc * 32 + fq * 8) = pack8_h(acc[ai][bj][m][0] * rs, acc[ai][bj][m][1] * rs);
            }
    }
};


struct EpiUpConv {
    static constexpr bool PERM = true, AFTER_DRAIN = false;
    const float* rss; const float* cw; const float* cb; u16* G; PG8_LAS float* xl;
    __device__ __forceinline__ void operator()(const f32x4 (&acc_)[2][2][4][2], const Unit& u, int wr, int wc, int fr, int fq) const {
        { int l_; asm volatile("v_mbcnt_lo_u32_b32 %0, -1, 0\n\tv_mbcnt_hi_u32_b32 %0, -1, %0" : "=v"(l_)); fr = l_ & 15; fq = l_ >> 4; }
        f32x4 (&acc)[2][2][4][2] = const_cast<f32x4 (&)[2][2][4][2]>(acc_);
        const int cl = wc * 32 + fq * 8, f0 = u.pn * HALF + cl;
        float rsv[8]; f32x4 rq[8];
#pragma unroll
        for (int ai = 0; ai < 2; ++ai)
#pragma unroll
            for (int m = 0; m < 4; ++m) { rq[ai * 4 + m] = *(const gf32x4_t*)(rss + (size_t)(u.row0 + ai * HALF + wr * 64 + m * 16 + fr) * 16 + 4 * fq); }
        __builtin_amdgcn_sched_barrier(0);
#pragma unroll
        for (int i = 0; i < 8; ++i) rsv[i] = (rq[i][0] + rq[i][1]) + (rq[i][2] + rq[i][3]);
#pragma unroll
        for (int i = 0; i < 8; ++i) { float t = rsv[i]; t += shfl_xorL(t, 16, fq * 16 + fr); t += shfl_xorL(t, 32, fq * 16 + fr); rsv[i] = rsqrtf(t * (1.f / D_MODEL) + EPS); }
#pragma unroll
        for (int ai = 0; ai < 2; ++ai)
#pragma unroll
            for (int m = 0; m < 4; ++m) { const float rs = rsv[ai * 4 + m];
#pragma unroll
                for (int bj = 0; bj < 2; ++bj) { acc[ai][bj][m][0] = acc[ai][bj][m][0] * rs; acc[ai][bj][m][1] = acc[ai][bj][m][1] * rs; } }
        if (fr >= 14) {
#pragma unroll
            for (int ai = 0; ai < 2; ++ai) { PG8_LAS float* d = xl + (((ai * 2 + wr) * 2 + (fr - 14)) * HALF + cl); *(PG8_LAS f32x4*)d = acc[ai][0][3][0]; *(PG8_LAS f32x4*)(d + 4) = acc[ai][0][3][1]; }
        }
        asm volatile("s_waitcnt lgkmcnt(0)" ::: "memory"); __builtin_amdgcn_s_barrier(); asm volatile("" ::: "memory");
#pragma unroll
        for (int ai = 0; ai < 2; ++ai) {
            unsigned hw[4][2];
#pragma unroll
            for (int n = 0; n < 2; ++n) {
                const int f = f0 + 4 * n;
                f32x4 wa = *(const gf32x4_t*)(cw + f), wb = *(const gf32x4_t*)(cw + D_FF + f), wc2 = *(const gf32x4_t*)(cw + 2 * D_FF + f), cbv = *(const gf32x4_t*)(cb + f);
                asm volatile("" : "+v"(wa), "+v"(wb), "+v"(wc2), "+v"(cbv));
                const int pseg = ai * 2 + wr - 1;
                f32x4 xm1 = {0.f, 0.f, 0.f, 0.f}, xm2 = xm1;
                if (pseg >= 0) { xm2 = *(PG8_LAS const f32x4*)(xl + ((pseg * 2 + 0) * HALF + cl + 4 * n)); xm1 = *(PG8_LAS const f32x4*)(xl + ((pseg * 2 + 1) * HALF + cl + 4 * n)); }
#pragma unroll
                for (int m = 0; m < 4; ++m) {
                    const int lr = ai * HALF + wr * 64 + m * 16 + fr;
                    const f32x4 a0 = acc[ai][0][m][n], bb = acc[ai][1][m][n]; f32x4 a1, a2;
#pragma unroll
                    for (int e = 0; e < 4; ++e) {
                        int o1, o2;
                        if (m == 0) { o1 = __float_as_int(xm1[e]); o2 = __float_as_int(fr == 0 ? xm2[e] : xm1[e]); }
                        else { const int pv = __float_as_int(acc[ai][0][m - 1][n][e]); o1 = __builtin_amdgcn_update_dpp(0, pv, 0x121, 0xf, 0xf, false); o2 = __builtin_amdgcn_update_dpp(0, pv, 0x122, 0xf, 0xf, false); }
                        const int cur = __float_as_int(a0[e]);
                        a1[e] = __int_as_float(__builtin_amdgcn_update_dpp(o1, cur, 0x111, 0xf, 0xf, false));
                        a2[e] = __int_as_float(__builtin_amdgcn_update_dpp(o2, cur, 0x112, 0xf, 0xf, false));
                    }
                    const f32x4 cv = cbv + a2 * wa + a1 * wb + a0 * wc2; f32x4 gv;
#pragma unroll
                    for (int e = 0; e < 4; ++e) gv[e] = cv[e] * __builtin_amdgcn_rcpf(1.f + __expf(-cv[e])) * bb[e];
                    if (n == 0) { hw[m][0] = pkh(gv[0], gv[1]); hw[m][1] = pkh(gv[2], gv[3]); }
                    else if (lr >= u.lo) { u32x4 w; w.x = hw[m][0]; w.y = hw[m][1]; w.z = pkh(gv[0], gv[1]); w.w = pkh(gv[2], gv[3]); *(gu32x4_t*)(G + (size_t)(u.row0 + lr) * D_FF + f0) = w; }
                    __builtin_amdgcn_sched_barrier(0);
                }
            }
        }
    }
};
template <class Epi, class Sched, bool ALIGN_EPI = false, bool SP2 = false, bool F16 = false>
__device__ __forceinline__ void gemm_phase(PG8_LAS unsigned char* lds, const Gemm g, const Sched& S, const Epi& E, const int WV) {
    const int tid = otid(WV), wid = __builtin_amdgcn_readfirstlane(tid >> 6), lane = tid & 63, wr = wid >> 2, wc = wid & 3, fr = lane & 15, fq = lane >> 4;
    const int K = g.K, nt = K / BK;
    unsigned voffA[2], voffB[2];
#pragma unroll
    for (int i = 0; i < 2; ++i) { int R, C; stage_rc(tid * 16 + i * 8192, R, C); const int Rb = Epi::PERM ? ((R & ~31) + perm32(R & 31)) : R;
        voffA[i] = (unsigned)(R * g.lda + C) * 2u; voffB[i] = (unsigned)(Rb * K + C) * 2u; }
    const size_t kstep = (size_t)(BK * 2);
    const size_t hstepA = (size_t)HALF * g.lda * 2, hstepB = (size_t)HALF * K * 2;
    const size_t rstepA = (size_t)g.lda * 2, tstepB = 2 * hstepB;
    const unsigned ldsw = (unsigned)wid * 1024u;
    const int aoff = lds_byte(wr * 64 + fr, fq * 8), boff = lds_byte(wc * 32 + fr, fq * 8);
#define PG8_SA(b, h) (((b) * 2 + (h)) * HTB)
#define PG8_SB(b, h) ((4 + (b) * 2 + (h)) * HTB)
#define PG8_STAGE(bufoff, gbase, voff) do { _Pragma("unroll") for (int _i = 0; _i < 2; ++_i) \
        __builtin_amdgcn_global_load_lds((const unsigned*)((const char*)(gbase) + (voff)[_i]), (PG8_LAS unsigned*)(lds + (bufoff) + ldsw + _i * 8192), 16, 0, 0); } while (0)
#define PG8_LDA(dst, b, h) do { _Pragma("unroll") for (int m = 0; m < 4; ++m) _Pragma("unroll") for (int k = 0; k < 2; ++k) dst[m][k] = *(const PG8_LAS bf16x8*)(lds + PG8_SA(b, h) + aoff + m * 2048 + k * 1024); } while (0)
#define PG8_LDB(dst, b, h) do { _Pragma("unroll") for (int n = 0; n < 2; ++n) _Pragma("unroll") for (int k = 0; k < 2; ++k) dst[n][k] = *(const PG8_LAS bf16x8*)(lds + PG8_SB(b, h) + boff + n * 2048 + k * 1024); } while (0)
#define PG8_MMA(ai, bj, At, Bt) do { __builtin_amdgcn_s_setprio(1); _Pragma("unroll") for (int m = 0; m < 4; ++m) _Pragma("unroll") for (int n = 0; n < 2; ++n) _Pragma("unroll") for (int k = 0; k < 2; ++k) \
        acc[ai][bj][m][n] = F16 ? __builtin_amdgcn_mfma_f32_16x16x32_f16(__builtin_bit_cast(f16x8, Bt[n][k]), __builtin_bit_cast(f16x8, At[m][k]), acc[ai][bj][m][n], 0, 0, 0) : __builtin_amdgcn_mfma_f32_16x16x32_bf16(Bt[n][k], At[m][k], acc[ai][bj][m][n], 0, 0, 0); __builtin_amdgcn_s_setprio(0); } while (0)
#define PG8_WAIT_V(n) asm volatile("s_waitcnt vmcnt(" #n ")" ::: "memory")
#define PG8_WAIT_L(n) asm volatile("s_waitcnt lgkmcnt(" #n ")" ::: "memory")
#define PG8_BAR __builtin_amdgcn_s_barrier()
#define PG8_SCHED __builtin_amdgcn_sched_barrier(0)
    Unit cur, nxt; int ui = 0;
    if (!S.next(0, cur)) return;
    f32x4 acc[2][2][4][2];
#pragma unroll
    for (int a = 0; a < 2; ++a)
#pragma unroll
        for (int b = 0; b < 2; ++b)
#pragma unroll
            for (int m = 0; m < 4; ++m)
#pragma unroll
                for (int n = 0; n < 2; ++n) acc[a][b][m][n] = (f32x4){0.f, 0.f, 0.f, 0.f};
    bf16x8 At[4][2], B0[2][2], B1[2][2];
    const char* cA = (const char*)g.A + (size_t)cur.row0 * rstepA; const char* cB = (const char*)g.Bt + (size_t)cur.pn * tstepB;
    S.a_ready(cur);
    if constexpr (SP2) {
        PG8_STAGE(PG8_SB(0, 0), cB, voffB); PG8_STAGE(PG8_SB(0, 1), cB + hstepB, voffB); PG8_STAGE(PG8_SA(0, 0), cA, voffA); PG8_STAGE(PG8_SA(0, 1), cA + hstepA, voffA);
        if (wr == 1) PG8_BAR;
        PG8_WAIT_V(2); PG8_BAR;
        PG8_STAGE(PG8_SB(1, 0), cB + kstep, voffB); PG8_STAGE(PG8_SA(1, 0), cA + kstep, voffA); PG8_STAGE(PG8_SB(1, 1), cB + hstepB + kstep, voffB);
        PG8_WAIT_V(6); PG8_BAR;
    } else {
        PG8_STAGE(PG8_SB(0, 0), cB, voffB); PG8_STAGE(PG8_SA(0, 0), cA, voffA); PG8_STAGE(PG8_SB(0, 1), cB + hstepB, voffB); PG8_STAGE(PG8_SA(0, 1), cA + hstepA, voffA);
        if (wr == 1) PG8_BAR;
        PG8_WAIT_V(4); PG8_BAR;
        PG8_STAGE(PG8_SB(1, 0), cB + kstep, voffB); PG8_STAGE(PG8_SA(1, 0), cA + kstep, voffA); PG8_STAGE(PG8_SB(1, 1), cB + hstepB + kstep, voffB);
        PG8_WAIT_V(6); PG8_BAR;
    }
    for (;;) {
        const bool has_next = S.next(ui + 1, nxt);
        const char* nA = has_next ? (const char*)g.A + (size_t)nxt.row0 * rstepA : cA; const char* nB = has_next ? (const char*)g.Bt + (size_t)nxt.pn * tstepB : cB;
        for (int t = 0; t < nt; t += 2) {
            const bool last = (t == nt - 2);
            const char* a1 = cA + (size_t)(t + 1) * kstep;
            const char* a2 = last ? nA : cA + (size_t)(t + 2) * kstep; const char* b2 = last ? nB : cB + (size_t)(t + 2) * kstep;
            const char* a3 = a2 + kstep; const char* b3 = b2 + kstep;
            if (last && has_next) S.a_ready(nxt);
            if constexpr (SP2) {
            PG8_LDB(B0, 0, 0); PG8_LDB(B1, 0, 1); PG8_SCHED; PG8_LDA(At, 0, 0); PG8_STAGE(PG8_SA(1, 1), a1 + hstepA, voffA);
            PG8_WAIT_V(8); PG8_WAIT_L(0); PG8_BAR; PG8_MMA(0, 0, At, B0); PG8_MMA(0, 1, At, B1); PG8_BAR; PG8_SCHED;
            PG8_LDA(At, 0, 1); PG8_STAGE(PG8_SB(0, 0), b2, voffB); PG8_STAGE(PG8_SB(0, 1), b2 + hstepB, voffB); PG8_STAGE(PG8_SA(0, 0), a2, voffA);
            PG8_WAIT_V(8); PG8_WAIT_L(0); PG8_BAR; PG8_MMA(1, 0, At, B0); PG8_MMA(1, 1, At, B1); PG8_BAR; PG8_SCHED;
            PG8_LDB(B0, 1, 0); PG8_LDB(B1, 1, 1); PG8_SCHED; PG8_LDA(At, 1, 0); PG8_STAGE(PG8_SA(0, 1), a2 + hstepA, voffA);
            PG8_WAIT_V(8); PG8_WAIT_L(0); PG8_BAR; PG8_MMA(0, 0, At, B0); PG8_MMA(0, 1, At, B1); PG8_BAR; PG8_SCHED;
            PG8_LDA(At, 1, 1); PG8_STAGE(PG8_SB(1, 0), b3, voffB); PG8_STAGE(PG8_SB(1, 1), b3 + hstepB, voffB); PG8_STAGE(PG8_SA(1, 0), a3, voffA);
            PG8_WAIT_V(8); PG8_WAIT_L(0); PG8_BAR; PG8_MMA(1, 0, At, B0); PG8_MMA(1, 1, At, B1); PG8_BAR; PG8_SCHED;
            } else {
            PG8_LDB(B0, 0, 0); PG8_SCHED; PG8_LDA(At, 0, 0); PG8_STAGE(PG8_SA(1, 1), a1 + hstepA, voffA);
            PG8_WAIT_L(8); PG8_BAR; PG8_WAIT_L(0); PG8_MMA(0, 0, At, B0); PG8_BAR; PG8_SCHED;
            PG8_LDB(B1, 0, 1); PG8_STAGE(PG8_SB(0, 0), b2, voffB);
            PG8_BAR; PG8_WAIT_L(0); PG8_MMA(0, 1, At, B1); PG8_BAR;
            PG8_LDA(At, 0, 1); PG8_STAGE(PG8_SA(0, 0), a2, voffA);
            PG8_BAR; PG8_WAIT_L(0); PG8_MMA(1, 0, At, B0); PG8_BAR; PG8_SCHED;
            PG8_STAGE(PG8_SB(0, 1), b2 + hstepB, voffB);
            PG8_WAIT_V(6); PG8_BAR; PG8_MMA(1, 1, At, B1); PG8_BAR;
            PG8_LDB(B0, 1, 0); PG8_SCHED; PG8_LDA(At, 1, 0); PG8_STAGE(PG8_SA(0, 1), a2 + hstepA, voffA);
            PG8_WAIT_L(8); PG8_BAR; PG8_WAIT_L(0); PG8_MMA(0, 0, At, B0); PG8_BAR; PG8_SCHED;
            PG8_LDB(B1, 1, 1); PG8_STAGE(PG8_SB(1, 0), b3, voffB);
            PG8_BAR; PG8_WAIT_L(0); PG8_MMA(0, 1, At, B1); PG8_BAR;
            PG8_LDA(At, 1, 1); PG8_STAGE(PG8_SA(1, 0), a3, voffA);
            PG8_BAR; PG8_WAIT_L(0); PG8_MMA(1, 0, At, B0); PG8_BAR; PG8_SCHED;
            PG8_STAGE(PG8_SB(1, 1), b3 + hstepB, voffB);
            PG8_WAIT_V(6); PG8_BAR; PG8_MMA(1, 1, At, B1); PG8_BAR;
            }
        }
        if constexpr (ALIGN_EPI) { if (wr == 0) PG8_BAR; }
        if constexpr (!Epi::AFTER_DRAIN) { E(acc, cur, wr, wc, fr, fq); S.done(cur); }
        if (!has_next) break;
#pragma unroll
        for (int a = 0; a < 2; ++a)
#pragma unroll
            for (int b = 0; b < 2; ++b)
#pragma unroll
                for (int m = 0; m < 4; ++m)
#pragma unroll
                    for (int n = 0; n < 2; ++n) acc[a][b][m][n] = (f32x4){0.f, 0.f, 0.f, 0.f};
        cur = nxt; cA = nA; cB = nB; ++ui;
        if constexpr (ALIGN_EPI) { if (wr == 1) PG8_BAR; }
    }
    PG8_WAIT_V(0);
    if constexpr (!ALIGN_EPI) { if (wr == 0) PG8_BAR; }
    PG8_BAR;
    if constexpr (Epi::AFTER_DRAIN) { E.fused(acc, cur, wr, wc, fr, fq, lds, wid, lane); S.done(cur); }
#undef PG8_SA
#undef PG8_SB
#undef PG8_STAGE
#undef PG8_LDA
#undef PG8_LDB
#undef PG8_MMA
#undef PG8_WAIT_V
#undef PG8_WAIT_L
#undef PG8_BAR
#undef PG8_SCHED
}
}

#define LAS __attribute__((address_space(3)))
constexpr int NWAVES = 8, NTHR = 512;
constexpr int LDS_BYTES = 147456;
typedef float f32x4 __attribute__((ext_vector_type(4)));
typedef unsigned u32x4 __attribute__((ext_vector_type(4)));

struct Params {
    const float* x; const int* pos; const float* norm1_g; const float* w_in; const float* w_gate_up; const float* b_gate; const float* gla_norm_g; const float* w_pool;
    const float* pool_scale; const float* w_out; const float* norm2_g; const float* w_up; const float* conv_w; const float* conv_b; const float* w_down; const float* final_g;
    float* out; unsigned char* ws; long long layer;
};

constexpr int CW_FAIL = 16, CW_QTOPK = 64, CW_QATT = 128, CW_SCAN = 256;
__device__ __forceinline__ unsigned f2ord(float x) { const unsigned u = __float_as_uint(x + 0.0f); return (u & 0x80000000u) ? ~u : (u | 0x80000000u); }
struct CmIdent { __device__ __forceinline__ int operator()(int n) const { return n; } };
struct CmUp { __device__ __forceinline__ int operator()(int n) const { const int t = n >> 8, r = n & 255; return (r < 128) ? 128 * t + r : D_FF + 128 * t + (r - 128); } };
struct CmWin {
    __device__ __forceinline__ int operator()(int n) const {
        if (n < 1860) return n;
        if (n < 1864) return -1;
        if (n < 1880) return 2628 + (n - 1864);
        if (n < 2048) return -1;
        if (n < 2304) return 1860 + (n - 2048);
        if (n < 2560) return 2116 + (n - 2304);
        if (n < 2816) return 2372 + (n - 2560);
        return 2644 + (n - 2816);
    }
};
__device__ __forceinline__ int wconv_items(int which) { return which == 0 ? (D_MODEL / 64) * (NPROJ / 32) : which == 1 ? (D_MODEL / 64) * (D_MODEL / 32) : which == 2 ? (D_MODEL / 64) * (2 * D_FF / 32) : (D_FF / 64) * (D_MODEL / 32); }
struct TrItem { const float* W; u16* WT; int kofs, Nsrc, K, k0, n0, sc; };
constexpr int TR_SCR_BYTES = 8704, TR_GAIN_OFF = 73728;
__device__ __forceinline__ void tr_decode(const Params& p, unsigned segs, int nseg, int g, int lane, TrItem& t) {
    unsigned char* ws = opq(p.ws);
#pragma unroll
    for (int sgi = 0; sgi < nseg; ++sgi) {
        const int code = (segs >> (4 * sgi)) & 15, l = code >> 2, which = code & 3, n = wconv_items(which);
        if (g >= 0 && g < n) {
            int nblk, nn;
            if (which == 0) { t.W = p.w_in + (size_t)l * D_MODEL * IN_WIDTH; t.K = D_MODEL; t.Nsrc = IN_WIDTH; t.WT = (u16*)(ws + (l ? WS_WIN1 : WS_WIN0)); t.kofs = 1024 * (1 + l); nblk = NPROJ / 32; }
            else if (which == 1) { t.W = p.w_out + (size_t)l * D_MODEL * D_MODEL; t.K = D_MODEL; t.Nsrc = D_MODEL; t.WT = (u16*)(ws + (l ? WS_WOUT1 : WS_WOUT0)); t.kofs = 0; nblk = D_MODEL / 32; }
            else if (which == 2) { t.W = p.w_up + (size_t)l * D_MODEL * 2 * D_FF; t.K = D_MODEL; t.Nsrc = 2 * D_FF; t.WT = (u16*)(ws + WS_WUP); t.kofs = 1024 * (3 + l); nblk = 2 * D_FF / 32; }
            else { t.W = p.w_down + (size_t)l * D_FF * D_MODEL; t.K = D_FF; t.Nsrc = D_MODEL; t.WT = (u16*)(ws + WS_WDN); t.kofs = 0; nblk = D_MODEL / 32; }
            t.k0 = 64 * (g / nblk); t.n0 = 32 * (g % nblk); nn = t.n0 + 2 * (lane & 15); if (t.kofs) t.kofs += t.k0;
            t.sc = (which == 0) ? CmWin{}(nn) : (which == 2) ? CmUp{}(nn) : nn;
        }
        g -= n;
    }
}
typedef float f32x2v __attribute__((ext_vector_type(2)));
__device__ __forceinline__ void tr_load(const TrItem& t, int lane, f32x2v (&v)[16]) {
    const char* base = (const char*)t.W; const unsigned step = 16u * (unsigned)t.Nsrc;
    unsigned off = 4u * ((unsigned)(t.k0 + (lane >> 4)) * (unsigned)t.Nsrc + (unsigned)(t.sc < 0 ? 0 : t.sc));
#pragma unroll
    for (int i = 0; i < 16; ++i) { v[i] = *(const __attribute__((address_space(1))) f32x2v*)(base + off); off += step; }
}
__device__ __forceinline__ void tr_store(const TrItem& t, int lane, const f32x2v (&v)[16], LAS float* scr, const LAS float* gains) {
    const int c = lane & 7;
    const LAS float* kl = gains + t.kofs + 8 * c; const f32x4 ks0 = *(const LAS f32x4*)kl, ks1 = *(const LAS f32x4*)(kl + 4);
#pragma unroll
    for (int i = 0; i < 16; ++i) { const int kk = 4 * i + (lane >> 4); LAS float* d = scr + kk * 33 + 2 * (lane & 15); d[0] = (t.sc >= 0) ? v[i][0] : 0.f; d[1] = (t.sc >= 0) ? v[i][1] : 0.f; }
    asm volatile("s_waitcnt lgkmcnt(0)" ::: "memory");
#pragma unroll
    for (int j = 0; j < 4; ++j) { const int n = (lane >> 3) + 8 * j; const LAS float* sp = scr + (8 * c) * 33 + n;
        u32x4 o; o.x = pkh(sp[0 * 33] * ks0[0], sp[1 * 33] * ks0[1]); o.y = pkh(sp[2 * 33] * ks0[2], sp[3 * 33] * ks0[3]); o.z = pkh(sp[4 * 33] * ks1[0], sp[5 * 33] * ks1[1]); o.w = pkh(sp[6 * 33] * ks1[2], sp[7 * 33] * ks1[3]);
        *(__attribute__((address_space(1))) u32x4*)(t.WT + (size_t)(t.n0 + n) * t.K + t.k0 + 8 * c) = o; }
    asm volatile("s_waitcnt lgkmcnt(0)" ::: "memory");
}
__device__ __forceinline__ void tr_load_g(const Params& p, const TrItem& t, int lane, f32x2v (&v)[16], f32x4& ks0, f32x4& ks1) {
    ks0 = (f32x4){1.f, 1.f, 1.f, 1.f}; ks1 = ks0;
    if (t.kofs) { const int vec = t.kofs >> 10, within = (t.kofs & 1023) + 8 * (lane & 7);
        const float* gp = (vec <= 2 ? p.norm1_g + (vec - 1) * 1024 : p.norm2_g + (vec - 3) * 1024) + within;
        ks0 = *(const __attribute__((address_space(1))) f32x4*)gp; ks1 = *(const __attribute__((address_space(1))) f32x4*)(gp + 4); }
    tr_load(t, lane, v);
}
__device__ __forceinline__ void tr_store_g(const TrItem& t, int lane, const f32x2v (&v)[16], const f32x4 ks0, const f32x4 ks1, LAS float* scr) {
    const int c = lane & 7;
#pragma unroll
    for (int i = 0; i < 16; ++i) { const int kk = 4 * i + (lane >> 4); LAS float* d = scr + kk * 33 + 2 * (lane & 15); d[0] = (t.sc >= 0) ? v[i][0] : 0.f; d[1] = (t.sc >= 0) ? v[i][1] : 0.f; }
    asm volatile("s_waitcnt lgkmcnt(0)" ::: "memory");
#pragma unroll
    for (int j = 0; j < 4; ++j) { const int n = (lane >> 3) + 8 * j; const LAS float* sp = scr + (8 * c) * 33 + n;
        u32x4 o; o.x = pkh(sp[0 * 33] * ks0[0], sp[1 * 33] * ks0[1]); o.y = pkh(sp[2 * 33] * ks0[2], sp[3 * 33] * ks0[3]); o.z = pkh(sp[4 * 33] * ks1[0], sp[5 * 33] * ks1[1]); o.w = pkh(sp[6 * 33] * ks1[2], sp[7 * 33] * ks1[3]);
        *(__attribute__((address_space(1))) u32x4*)(t.WT + (size_t)(t.n0 + n) * t.K + t.k0 + 8 * c) = o; }
    asm volatile("s_waitcnt lgkmcnt(0)" ::: "memory");
}
struct ConvJob { const Params* p; unsigned segs; int nseg, total, slot0; };
__device__ __forceinline__ void wconv_stream(const Params& p, unsigned segs, int nseg, int total, LAS float* scr, const LAS float* gains, int lane, int gw, int NGW) {
    int g = gw; asm volatile("" : "+s"(g));
    if (g >= total) return;
    TrItem ia, ib; f32x2v va[16], vb[16];
    tr_decode(p, segs, nseg, g, lane, ia); tr_load(ia, lane, va);
#pragma unroll 1
    while (true) {
        { const int gn = g + NGW; const bool more = gn < total; ib = ia;
          if (more) tr_decode(p, segs, nseg, gn, lane, ib); else ib.Nsrc = 0;
          tr_load(ib, lane, vb);
          __builtin_amdgcn_sched_barrier(0);
          tr_store(ia, lane, va, scr, gains);
          if (!more) break; g = gn; }
        { const int gn = g + NGW; const bool more = gn < total; ia = ib;
          if (more) tr_decode(p, segs, nseg, gn, lane, ia); else ia.Nsrc = 0;
          tr_load(ia, lane, va);
          __builtin_amdgcn_sched_barrier(0);
          tr_store(ib, lane, vb, scr, gains);
          if (!more) break; g = gn; }
    }
}
__device__ __forceinline__ void tr_fill_gains(const Params& p, LAS float* gains, int tid) {
    for (int i = tid; i < 1024; i += NTHR) { gains[i] = 1.f; gains[1024 + i] = p.norm1_g[i]; gains[2048 + i] = p.norm1_g[1024 + i]; gains[3072 + i] = p.norm2_g[i]; gains[4096 + i] = p.norm2_g[1024 + i]; }
}
__device__ __forceinline__ void xg_row(const float* xrow, u16* orow, float* rssrow, int lane) {
    const f32x4* xr = (const f32x4*)xrow + lane; f32x4 v[4]; float ss = 0.f;
#pragma unroll
    for (int j = 0; j < 4; ++j) { v[j] = xr[64 * j]; ss += (v[j][0] * v[j][0] + v[j][1] * v[j][1]) + (v[j][2] * v[j][2] + v[j][3] * v[j][3]); }
    ss = wave_sum(ss);
#pragma unroll
    for (int j = 0; j < 4; ++j) { uint2 w; w.x = pkh(v[j][0], v[j][1]); w.y = pkh(v[j][2], v[j][3]); *((uint2*)orow + lane + 64 * j) = w; }
    if (lane < 16) rssrow[lane] = (lane == 0) ? ss : 0.f;
}

__device__ __forceinline__ void xg_row4(const float* xrow, u16* orow, float* rssrow, int lane) {
    typedef __attribute__((address_space(1))) f32x4 gx4;
    const gx4* xr = (const gx4*)xrow + lane; f32x4 v[16]; float sm[4] = {0.f, 0.f, 0.f, 0.f};
#pragma unroll
    for (int j = 0; j < 16; ++j) v[j] = xr[64 * j];
#pragma unroll
    for (int j = 0; j < 16; ++j) sm[j >> 2] += (v[j][0] * v[j][0] + v[j][1] * v[j][1]) + (v[j][2] * v[j][2] + v[j][3] * v[j][3]);
#pragma unroll
    for (int r = 0; r < 4; ++r) sm[r] = wave_sum(sm[r]);
#pragma unroll
    for (int j = 0; j < 16; ++j) { uint2 w; w.x = pkh(v[j][0], v[j][1]); w.y = pkh(v[j][2], v[j][3]); *((uint2*)orow + lane + 64 * j) = w; }
    rssrow[lane] = (lane == 0) ? sm[0] : (lane == 16) ? sm[1] : (lane == 32) ? sm[2] : (lane == 48) ? sm[3] : 0.f;
}
__device__ __forceinline__ void xg_row2(const float* xrow, u16* orow, float* rssrow, int lane) {
    const f32x4* xr = (const f32x4*)xrow + lane; f32x4 v[8]; float s0 = 0.f, s1 = 0.f;
#pragma unroll
    for (int j = 0; j < 8; ++j) v[j] = xr[64 * j];
#pragma unroll
    for (int j = 0; j < 4; ++j) { s0 += (v[j][0] * v[j][0] + v[j][1] * v[j][1]) + (v[j][2] * v[j][2] + v[j][3] * v[j][3]); s1 += (v[j + 4][0] * v[j + 4][0] + v[j + 4][1] * v[j + 4][1]) + (v[j + 4][2] * v[j + 4][2] + v[j + 4][3] * v[j + 4][3]); }
    s0 = wave_sum(s0); s1 = wave_sum(s1);
#pragma unroll
    for (int j = 0; j < 8; ++j) { uint2 w; w.x = pkh(v[j][0], v[j][1]); w.y = pkh(v[j][2], v[j][3]); *((uint2*)orow + lane + 64 * j) = w; }
    if (lane < 32) rssrow[lane] = (lane == 0) ? s0 : (lane == 16) ? s1 : 0.f;
}

typedef float f32x16 __attribute__((ext_vector_type(16)));
constexpr int TK_CAP = 1024, TK_R = 64;
constexpr int TKL_SAMP = 0, TKL_MT = 65536, TKL_ZM = 98304, TKL_W = 131072, TKL_LO = 131584, TKL_CNT = 131712, TKL_FLAG = 131840;

__device__ __forceinline__ float relu_s(float a) { float r; asm("v_max_f32_e32 %0, 0, %1" : "=v"(r) : "v"(a)); return r; }
__device__ __forceinline__ float fma_s(float a, float b, float c) { float r; asm("v_fma_f32 %0, %1, %2, %3" : "=v"(r) : "v"(a), "v"(b), "v"(c)); return r; }
__device__ __forceinline__ float mul_s(float a, float b) { float r; asm("v_mul_f32_e32 %0, %1, %2" : "=v"(r) : "v"(a), "v"(b)); return r; }
__device__ __forceinline__ void score2(float a0, float a1, float a2, float a3, const f32x4& w, float b0, float b1, float b2, float b3, const f32x4& x, float& s, float& r) {
    float t0, t1, u0, u1;
    asm("v_max_f32_e32 %2, 0, %6\n\tv_max_f32_e32 %4, 0, %14\n\t"
        "v_max_f32_e32 %3, 0, %7\n\tv_max_f32_e32 %5, 0, %15\n\t"
        "v_mul_f32_e32 %0, %10, %2\n\tv_mul_f32_e32 %1, %18, %4\n\t"
        "v_max_f32_e32 %2, 0, %8\n\tv_max_f32_e32 %4, 0, %16\n\t"
        "v_fma_f32 %0, %11, %3, %0\n\tv_fma_f32 %1, %19, %5, %1\n\t"
        "v_max_f32_e32 %3, 0, %9\n\tv_max_f32_e32 %5, 0, %17\n\t"
        "v_fma_f32 %0, %12, %2, %0\n\tv_fma_f32 %1, %20, %4, %1\n\t"
        "v_fma_f32 %0, %13, %3, %0\n\tv_fma_f32 %1, %21, %5, %1"
        : "=&v"(s), "=&v"(r), "=&v"(t0), "=&v"(t1), "=&v"(u0), "=&v"(u1)
        : "v"(a0), "v"(a1), "v"(a2), "v"(a3), "v"(w[0]), "v"(w[1]), "v"(w[2]), "v"(w[3]), "v"(b0), "v"(b1), "v"(b2), "v"(b3), "v"(x[0]), "v"(x[1]), "v"(x[2]), "v"(x[3]));
}
__device__ __forceinline__ void tk_load_b(const u16* __restrict__ KIb, int keybase, int keystride, int lane, f16x8 (&bf)[4]) {
    const u16* kp = KIb + (size_t)(keybase + keystride * (lane & 31)) * 64 + 8 * (lane >> 5);
#pragma unroll
    for (int ks = 0; ks < 4; ++ks) bf[ks] = *(const __attribute__((address_space(1))) f16x8*)(kp + 16 * ks);
}
__device__ __forceinline__ void tk_score_tile(const f16x8 (&bf)[4], const f16x8 (&af)[4][4], LAS const float* wtab, int lane, float (&score)[16]) {
    LAS const float* wtab_h = wtab + (lane >> 5) * 4;
#pragma unroll
    for (int blk = 0; blk < 4; ++blk) {
        f32x16 acc = {0.f, 0.f, 0.f, 0.f, 0.f, 0.f, 0.f, 0.f, 0.f, 0.f, 0.f, 0.f, 0.f, 0.f, 0.f, 0.f};
#pragma unroll
        for (int ks = 0; ks < 4; ++ks) acc = __builtin_amdgcn_mfma_f32_32x32x16_f16(af[blk][ks], bf[ks], acc, 0, 0, 0);
        asm volatile("s_nop 15\n\ts_nop 3" : "+v"(acc));
#pragma unroll
        for (int g = 0; g < 4; g += 2) {
            const f32x4 w = *(LAS const f32x4*)(wtab_h + (8 * blk + 2 * g) * 4), x = *(LAS const f32x4*)(wtab_h + (8 * blk + 2 * g + 2) * 4);
            score2(acc[4 * g], acc[4 * g + 1], acc[4 * g + 2], acc[4 * g + 3], w, acc[4 * g + 4], acc[4 * g + 5], acc[4 * g + 6], acc[4 * g + 7], x, score[blk * 4 + g], score[blk * 4 + g + 1]);
        }
        __builtin_amdgcn_sched_barrier(0);
    }
}
__device__ __forceinline__ void tk_score_tile_lds(const f16x8 (&bf)[4], LAS const unsigned char* afl, LAS const float* wtab, int lane, float (&score)[16]) {
    LAS const float* wtab_h = wtab + (lane >> 5) * 4;
    f16x8 a[4];
#pragma unroll
    for (int ks = 0; ks < 4; ++ks) a[ks] = *(LAS const f16x8*)(afl + ks * 1024 + lane * 16);
#pragma unroll
    for (int blk = 0; blk < 4; ++blk) {
        f16x8 an[4]; f32x4 w[4];
        if (blk < 3) {
#pragma unroll
            for (int ks = 0; ks < 4; ++ks) an[ks] = *(LAS const f16x8*)(afl + ((blk + 1) * 4 + ks) * 1024 + lane * 16);
        }
#pragma unroll
        for (int g = 0; g < 4; ++g) w[g] = *(LAS const f32x4*)(wtab_h + (8 * blk + 2 * g) * 4);
        f32x16 acc = {0.f, 0.f, 0.f, 0.f, 0.f, 0.f, 0.f, 0.f, 0.f, 0.f, 0.f, 0.f, 0.f, 0.f, 0.f, 0.f};
#pragma unroll
        for (int ks = 0; ks < 4; ++ks) acc = __builtin_amdgcn_mfma_f32_32x32x16_f16(a[ks], bf[ks], acc, 0, 0, 0);
        asm volatile("s_nop 15\n\ts_nop 3" : "+v"(acc));
#pragma unroll
        for (int g = 0; g < 4; g += 2)
            score2(acc[4 * g], acc[4 * g + 1], acc[4 * g + 2], acc[4 * g + 3], w[g], acc[4 * g + 4], acc[4 * g + 5], acc[4 * g + 6], acc[4 * g + 7], w[g + 1], score[blk * 4 + g], score[blk * 4 + g + 1]);
        if (blk < 3) {
#pragma unroll
            for (int ks = 0; ks < 4; ++ks) a[ks] = an[ks];
        }
        __builtin_amdgcn_sched_barrier(0);
    }
}
__device__ __forceinline__ void tk_score_tile_reg(const f16x8 (&bf)[4], const f16x8 (&af)[4][4], LAS const float* wtab, int lane, float (&score)[16]) {
    LAS const float* wtab_h = wtab + (lane >> 5) * 4;
#pragma unroll
    for (int blk = 0; blk < 4; ++blk) {
        f32x4 w[4];
#pragma unroll
        for (int g = 0; g < 4; ++g) w[g] = *(LAS const f32x4*)(wtab_h + (8 * blk + 2 * g) * 4);
        f32x16 acc = {0.f, 0.f, 0.f, 0.f, 0.f, 0.f, 0.f, 0.f, 0.f, 0.f, 0.f, 0.f, 0.f, 0.f, 0.f, 0.f};
#pragma unroll
        for (int ks = 0; ks < 4; ++ks) acc = __builtin_amdgcn_mfma_f32_32x32x16_f16(af[blk][ks], bf[ks], acc, 0, 0, 0);
        asm volatile("s_nop 15\n\ts_nop 3" : "+v"(acc));
#pragma unroll
        for (int g = 0; g < 4; g += 2)
            score2(acc[4 * g], acc[4 * g + 1], acc[4 * g + 2], acc[4 * g + 3], w[g], acc[4 * g + 4], acc[4 * g + 5], acc[4 * g + 6], acc[4 * g + 7], w[g + 1], score[blk * 4 + g], score[blk * 4 + g + 1]);
        __builtin_amdgcn_sched_barrier(0);
    }
}
__device__ __forceinline__ void tk_score_tile_regw(const f16x8 (&bf)[4], const f16x8 (&af)[4][4], const f32x4 (&wr)[4][4], float (&score)[16]) {
#pragma unroll
    for (int blk = 0; blk < 4; ++blk) {
        f32x16 acc = {0.f, 0.f, 0.f, 0.f, 0.f, 0.f, 0.f, 0.f, 0.f, 0.f, 0.f, 0.f, 0.f, 0.f, 0.f, 0.f};
#pragma unroll
        for (int ks = 0; ks < 4; ++ks) acc = __builtin_amdgcn_mfma_f32_32x32x16_f16(af[blk][ks], bf[ks], acc, 0, 0, 0);
        asm volatile("s_nop 15\n\ts_nop 3" : "+v"(acc));
#pragma unroll
        for (int g = 0; g < 4; g += 2)
            score2(acc[4 * g], acc[4 * g + 1], acc[4 * g + 2], acc[4 * g + 3], wr[blk][g], acc[4 * g + 4], acc[4 * g + 5], acc[4 * g + 6], acc[4 * g + 7], wr[blk][g + 1], score[blk * 4 + g], score[blk * 4 + g + 1]);
        __builtin_amdgcn_sched_barrier(0);
    }
}
__device__ __forceinline__ int wave_count(bool p) { return __builtin_popcountll(__ballot(p)); }


__device__ __forceinline__ int wave_isum(int c) {
    int r = c;
    r += __builtin_amdgcn_update_dpp(0, r, 0x111, 0xf, 0xf, true);
    r += __builtin_amdgcn_update_dpp(0, r, 0x112, 0xf, 0xf, true);
    r += __builtin_amdgcn_update_dpp(0, r, 0x114, 0xf, 0xf, true);
    r += __builtin_amdgcn_update_dpp(0, r, 0x118, 0xf, 0xf, true);
    r += __builtin_amdgcn_update_dpp(0, r, 0x142, 0xa, 0xf, true);
    r += __builtin_amdgcn_update_dpp(0, r, 0x143, 0xc, 0xf, true);
    return __builtin_amdgcn_readlane(r, 63);
}
__device__ __forceinline__ int count_ge16(const unsigned (&v)[16], unsigned cand) {
    int c0 = 0, c1 = 0;
#pragma unroll
    for (int e = 0; e < 16; e += 2) { c0 += (v[e] >= cand) ? 1 : 0; c1 += (v[e + 1] >= cand) ? 1 : 0; }
    return wave_isum(c0 + c1);
}
__device__ __forceinline__ int count_ge16s(const unsigned (&v)[16], unsigned g) {
    unsigned acc, t0, t1, t2, t3;
    asm("v_mov_b32 %0, 0\n\t"
        "v_sub_u32 %1, %5, %21\n\t"
        "v_sub_u32 %2, %6, %21\n\t"
        "v_sub_u32 %3, %7, %21\n\t"
        "v_sub_u32 %4, %8, %21\n\t"
        "v_lshrrev_b32 %1, 31, %1\n\t"
        "v_lshrrev_b32 %2, 31, %2\n\t"
        "v_lshrrev_b32 %3, 31, %3\n\t"
        "v_lshrrev_b32 %4, 31, %4\n\t"
        "v_add3_u32 %0, %0, %1, %2\n\t"
        "v_add3_u32 %0, %0, %3, %4\n\t"
        "v_sub_u32 %1, %9, %21\n\t"
        "v_sub_u32 %2, %10, %21\n\t"
        "v_sub_u32 %3, %11, %21\n\t"
        "v_sub_u32 %4, %12, %21\n\t"
        "v_lshrrev_b32 %1, 31, %1\n\t"
        "v_lshrrev_b32 %2, 31, %2\n\t"
        "v_lshrrev_b32 %3, 31, %3\n\t"
        "v_lshrrev_b32 %4, 31, %4\n\t"
        "v_add3_u32 %0, %0, %1, %2\n\t"
        "v_add3_u32 %0, %0, %3, %4\n\t"
        "v_sub_u32 %1, %13, %21\n\t"
        "v_sub_u32 %2, %14, %21\n\t"
        "v_sub_u32 %3, %15, %21\n\t"
        "v_sub_u32 %4, %16, %21\n\t"
        "v_lshrrev_b32 %1, 31, %1\n\t"
        "v_lshrrev_b32 %2, 31, %2\n\t"
        "v_lshrrev_b32 %3, 31, %3\n\t"
        "v_lshrrev_b32 %4, 31, %4\n\t"
        "v_add3_u32 %0, %0, %1, %2\n\t"
        "v_add3_u32 %0, %0, %3, %4\n\t"
        "v_sub_u32 %1, %17, %21\n\t"
        "v_sub_u32 %2, %18, %21\n\t"
        "v_sub_u32 %3, %19, %21\n\t"
        "v_sub_u32 %4, %20, %21\n\t"
        "v_lshrrev_b32 %1, 31, %1\n\t"
        "v_lshrrev_b32 %2, 31, %2\n\t"
        "v_lshrrev_b32 %3, 31, %3\n\t"
        "v_lshrrev_b32 %4, 31, %4\n\t"
        "v_add3_u32 %0, %0, %1, %2\n\t"
        "v_add3_u32 %0, %0, %3, %4"
        : "=&v"(acc), "=&v"(t0), "=&v"(t1), "=&v"(t2), "=&v"(t3)
        : "v"(v[0]), "v"(v[1]), "v"(v[2]), "v"(v[3]), "v"(v[4]), "v"(v[5]), "v"(v[6]), "v"(v[7]), "v"(v[8]), "v"(v[9]), "v"(v[10]), "v"(v[11]), "v"(v[12]), "v"(v[13]), "v"(v[14]), "v"(v[15]), "v"(g));
    return 64 * 16 - wave_isum((int)acc);
}
typedef unsigned gl_u2v __attribute__((ext_vector_type(2))); typedef __attribute__((address_space(1))) gl_u2v* gl_u2p;
template <int NE>
__device__ __forceinline__ int count_geN(const unsigned (&v)[NE], unsigned cand) {
    int c0 = 0, c1 = 0;
#pragma unroll
    for (int e = 0; e < NE; e += 2) { c0 += (v[e] >= cand) ? 1 : 0; c1 += (v[e + 1] >= cand) ? 1 : 0; }
    return wave_isum(c0 + c1);
}
template <int NE>
__device__ __forceinline__ unsigned sel_query(LAS const u16* sq, int nsv, int lane) {
    unsigned v[NE];
#pragma unroll
    for (int e = 0; e < NE; ++e) v[e] = (lane + 64 * e < nsv) ? (unsigned)sq[64 * e] : 0u;
    unsigned T = 0u;
#pragma unroll 1
    for (int bit = 15; bit >= 2; --bit) { const unsigned cand = T | (1u << bit); const int c = count_geN<NE>(v, cand); if (c >= TK_R) { T = cand; if (c == TK_R) break; } }
    return T;
}
template <int NE>
__device__ __forceinline__ void s3_query(const int ql, const int m, const int mm, const bool over, const int lane, const uint2* list, LAS const unsigned* zm, LAS unsigned* mt, unsigned* ctl, const float lo) {
        unsigned ord[NE], key[NE];
        { gl_u2v tv[NE];
#pragma unroll
          for (int e = 0; e < NE; ++e) { const int sidx = lane + 64 * e; tv[e] = *(const gl_u2p)(list + ql * TK_CAP + (sidx < mm ? sidx : 0)); }
#pragma unroll
          for (int e = 0; e < NE; ++e) { const bool vld = lane + 64 * e < mm; key[e] = vld ? tv[e].x : 0xffffffffu; ord[e] = vld ? f2ord(__uint_as_float(tv[e].y)) : 0u; } }
        const int cpos = (lo > 0.f) ? mm : count_geN<NE>(ord, 0x80000001u);
        u32x4 zw = {0u, 0u, 0u, 0u}; int zl = 0, zincl = 0, Zc = 0;
        if (cpos < TOPK) {
            zw = *(LAS const u32x4*)(zm + ql * 256 + 4 * lane);
            zl = __builtin_popcount(zw[0]) + __builtin_popcount(zw[1]) + __builtin_popcount(zw[2]) + __builtin_popcount(zw[3]);
            zincl = zl;
#pragma unroll
            for (int o = 1; o < 64; o <<= 1) { const int v = shfl_upL(zincl, o, lane); if (lane >= o) zincl += v; }
            Zc = __builtin_amdgcn_readlane(zincl, 63);
        }
        const int klist = (cpos >= TOPK) ? TOPK : ((cpos + Zc >= TOPK) ? cpos : TOPK - Zc);
        if (over) { if (lane == 0) __hip_atomic_store(ctl + CW_FAIL + 1, 1u, __ATOMIC_RELAXED, __HIP_MEMORY_SCOPE_AGENT); }
        if (m < klist) { if (lane == 0) __hip_atomic_store(ctl + CW_FAIL, 1u, __ATOMIC_RELAXED, __HIP_MEMORY_SCOPE_AGENT); }
        if (klist > 0) {
            unsigned T = 0u; bool exact = false; int hb = 31;
            {
                unsigned mx = 0u;
#pragma unroll
                for (int e = 0; e < NE; ++e) mx = (ord[e] > mx) ? ord[e] : mx;
#define WR_STEP(ctrl, rm) { const unsigned o_ = (unsigned)__builtin_amdgcn_update_dpp(0, (int)mx, ctrl, rm, 0xf, true); mx = (o_ > mx) ? o_ : mx; }
                WR_STEP(0x111, 0xf) WR_STEP(0x112, 0xf) WR_STEP(0x114, 0xf) WR_STEP(0x118, 0xf) WR_STEP(0x142, 0xa) WR_STEP(0x143, 0xc)
#undef WR_STEP
                const unsigned m_all = (unsigned)__builtin_amdgcn_readlane((int)mx, 63), df = m_all ^ f2ord(lo);
                if (df == 0u) { T = m_all; hb = -1; } else { hb = 31 - __builtin_clz(df); T = (hb == 31) ? 0u : (m_all & ~((2u << hb) - 1u)); }
            }
#pragma unroll 1
            for (int bit = hb; bit >= 0; --bit) {
                const unsigned cand = T | (1u << bit); const int c = count_geN<NE>(ord, cand);
                if (c >= klist) { T = cand; if (c == klist) { exact = true; break; } }
            }
            unsigned kmax = 0xffffffffu;
            if (!exact) {
                const int cgt = (T == 0xffffffffu) ? 0 : count_geN<NE>(ord, T + 1u);
                const int need = klist - cgt;
                unsigned wv[NE];
#pragma unroll
                for (int e = 0; e < NE; ++e) wv[e] = (ord[e] == T) ? (0x2000u - key[e]) : 0u;
                unsigned T2 = 0u;
#pragma unroll 1
                for (int bit = 13; bit >= 0; --bit) { const unsigned cand = T2 | (1u << bit); if (count_geN<NE>(wv, cand) >= need) T2 = cand; }
                kmax = 0x2000u - T2;
            }
            LAS unsigned* mq = mt + ql * 2;
            if (exact) {
#pragma unroll
                for (int e = 0; e < NE; ++e) if (ord[e] >= T) { const unsigned k = key[e] & 8191u;
                    __hip_atomic_fetch_or(mq + ((k >> 6) * 64 + ((k >> 5) & 1u)), 1u << (k & 31u), __ATOMIC_RELAXED, __HIP_MEMORY_SCOPE_WORKGROUP); }
            } else {
#pragma unroll
                for (int e = 0; e < NE; ++e) {
                    const bool sel = ord[e] > T || (ord[e] == T && key[e] <= kmax);
                    if (sel && key[e] != 0xffffffffu) { const unsigned k = key[e];
                        __hip_atomic_fetch_or(mq + ((k >> 6) * 64 + ((k >> 5) & 1u)), 1u << (k & 31u), __ATOMIC_RELAXED, __HIP_MEMORY_SCOPE_WORKGROUP); }
                }
            }
        }
        if (klist < TOPK) {
        int ztake = TOPK - klist - (zincl - zl);
#pragma unroll
        for (int j = 0; j < 4; ++j) {
            unsigned w = zw[j];
            while (w != 0u && ztake > 0) {
                const unsigned c = (unsigned)__builtin_ctz(w); w &= w - 1u; --ztake;
                const unsigned k = (unsigned)(4 * lane + j) * 32u + c;
                __hip_atomic_fetch_or(mt + (((k >> 6) * 32 + ql) * 2 + ((k >> 5) & 1u)), 1u << c, __ATOMIC_RELAXED, __HIP_MEMORY_SCOPE_WORKGROUP);
            }
        }
        }
}
__device__ __forceinline__ void topk_unit(int b, int qblk, const u16* __restrict__ QI, const u16* __restrict__ KI, const float* __restrict__ WI, unsigned long long* __restrict__ MASKL, uint2* __restrict__ list,
                                          unsigned* __restrict__ ctl, LAS unsigned char* lds, const int WV, const ConvJob cj) {
    const int tid = otid(WV), lane = tid & 63, wave = __builtin_amdgcn_readfirstlane(tid >> 6), hh = lane >> 5;
    LAS float* cscr = (LAS float*)(lds + (wave < 7 ? TKL_SAMP + wave * 8448 : 133120));
    const int cgw = (int)blockIdx.x * NWAVES + wave, cngw = (int)gridDim.x * NWAVES;
    const int t0 = qblk * 32, tokb = b * SEQ;
    LAS unsigned* mt = (LAS unsigned*)(lds + TKL_MT);
    LAS float* wtab = (LAS float*)(lds + TKL_W);
    LAS float* lo_s = (LAS float*)(lds + TKL_LO);
    LAS unsigned* cnt_s = (LAS unsigned*)(lds + TKL_CNT);
    LAS u16* samp = (LAS u16*)(lds + TKL_SAMP);
    LAS unsigned* zm = (LAS unsigned*)(lds + TKL_ZM);
    const int nkt_w = 4 * (qblk / 8 + 1);
    unsigned long long* mdst = MASKL + (size_t)(b * 256 + qblk) * 128 * 32;
    __syncthreads();
    for (int i = tid; i < nkt_w * 64; i += NTHR) mt[i] = 0u;
    if (tid < 128) wtab[tid] = WI[(size_t)(tokb + t0) * 4 + tid];
    for (int i = tid; i < 32 * 256; i += NTHR) zm[i] = 0u;
    if (tid < 32) cnt_s[tid] = (unsigned)(tid * TK_CAP * 8);
    if (t0 < TOPK) {
        __syncthreads();
        for (int i = tid; i < nkt_w * 64; i += NTHR) {
            const int kt = i >> 6, ql = (i & 63) >> 1, half = i & 1, k0 = 64 * kt + 32 * half, last = t0 + ql;
            unsigned word = 0u;
            if (k0 <= last) { const int cnt = last - k0 + 1; word = cnt >= 32 ? 0xffffffffu : ((1u << cnt) - 1u); }
            mt[i] = word;
        }
        __syncthreads();
        for (int i = tid; i < nkt_w * 32; i += NTHR) mdst[i] = (unsigned long long)mt[2 * i] | ((unsigned long long)mt[2 * i + 1] << 32);
        __syncthreads();
#pragma unroll 1
        for (int i = 0; i < 4; ++i) { const int g = cgw + cngw * (cj.slot0 + i);
            if (g < cj.total) { TrItem ti; f32x2v cv[16]; f32x4 k0v, k1v; tr_decode(*cj.p, cj.segs, cj.nseg, g, lane, ti); tr_load_g(*cj.p, ti, lane, cv, k0v, k1v); tr_store_g(ti, lane, cv, k0v, k1v, cscr); } }
        return;
    }
    f16x8 af[4][4];
    { const int r = lane & 31;
#pragma unroll
      for (int blk = 0; blk < 4; ++blk)
#pragma unroll
          for (int ks = 0; ks < 4; ++ks) af[blk][ks] = *(const f16x8*)(QI + (size_t)(tokb + t0 + 8 * blk + (r >> 2)) * 256 + (r & 3) * 64 + 16 * ks + 8 * hh); }
    __syncthreads();
    const int nst = qblk / 8 + 1;
    LAS u16* samp_h = samp + hh * 1024 + (lane & 31);
    f16x8 bfs[4];
    if (wave < nst) tk_load_b(KI + (size_t)tokb * 64, 256 * wave, 8, lane, bfs);
    for (int st = wave; st < nst; st += NWAVES) {
        float sc[16]; tk_score_tile_reg(bfs, af, wtab, lane, sc);
        if (st + NWAVES < nst) tk_load_b(KI + (size_t)tokb * 64, 256 * (st + NWAVES), 8, lane, bfs);
#pragma unroll
        for (int blk = 0; blk < 4; ++blk)
#pragma unroll
            for (int g = 0; g < 4; ++g) samp_h[(8 * blk + 2 * g) * 1024 + 32 * st] = (u16)(f2ord(sc[blk * 4 + g]) >> 16);
    }
    __syncthreads();
    for (int i = 0; i < 4; ++i) {
        const int ql = wave * 4 + i, nsv = (t0 + ql) / 8 + 1;
        unsigned T = 0u;
        if (nsv >= TK_R) {
            const int ne = (nsv + 63) >> 6; LAS const u16* sq = samp + ql * 1024 + lane;
            if (ne <= 4) T = sel_query<4>(sq, nsv, lane); else if (ne <= 8) T = sel_query<8>(sq, nsv, lane); else if (ne <= 12) T = sel_query<12>(sq, nsv, lane); else T = sel_query<16>(sq, nsv, lane);
        }
        if (lane == 0) {
            unsigned fb;
            if (T == 0u) fb = 0xff800000u;
            else if (T & 0x8000u) { const unsigned m = T & 0x7fffu; fb = (m == 0u) ? 0x80010000u : ((m - 1u) << 16); }
            else fb = ((~T + 1u) & 0xffffu) << 16;
            lo_s[ql] = __uint_as_float(fb); }
    }
    __syncthreads();
    const int nkt = qblk + 1;
    LAS unsigned* zm_h = zm + hh * 256;
    unsigned nzm;
    { const unsigned long long nb = __ballot(lane < 32 && lo_s[lane & 31] <= 0.f); const unsigned m32 = (unsigned)nb; nzm = (m32 | (m32 >> 1)) & 0x55555555u; }
    float thr[16];
#pragma unroll
    for (int i = 0; i < 16; ++i) { thr[i] = __uint_as_float(__float_as_uint(lo_s[8 * (i >> 2) + 2 * (i & 3) + hh]) & 0xffff0000u); if (i & 1) __builtin_amdgcn_sched_barrier(0); }
    const __amdgpu_buffer_rsrc_t lrs = __builtin_amdgcn_make_buffer_rsrc((void*)opq(list), 0, 32 * TK_CAP * 8, 0x00020000);
    const unsigned cnt_addr = (unsigned)(uintptr_t)(cnt_s + hh);
    f32x4 wreg[4][4];
    { LAS const float* wtab_h = wtab + (lane >> 5) * 4;
#pragma unroll
      for (int blk = 0; blk < 4; ++blk)
#pragma unroll
          for (int g = 0; g < 4; ++g) wreg[blk][g] = *(LAS const f32x4*)(wtab_h + (8 * blk + 2 * g) * 4); }
    f16x8 bf[4];
    if (wave < nkt) tk_load_b(KI + (size_t)tokb * 64, 32 * wave, 1, lane, bf);
    for (int kt = wave; kt < nkt; kt += NWAVES) {
        float sc[16]; tk_score_tile_regw(bf, af, wreg, sc);
        if (kt + NWAVES < nkt) tk_load_b(KI + (size_t)tokb * 64, 32 * (kt + NWAVES), 1, lane, bf);
        const unsigned key = (unsigned)(32 * kt + (lane & 31)); const int keyh = (int)key - hh;
        if (kt == qblk) {
#pragma unroll
            for (int i = 0; i < 16; ++i) if (keyh > t0 + 8 * (i >> 2) + 2 * (i & 3)) sc[i] = -__builtin_inff();
        }
        if (nzm != 0u) {
#pragma unroll
            for (int i = 0; i < 16; ++i) if ((nzm >> (2 * i)) & 1u) {
                const int c = 8 * (i >> 2) + 2 * (i & 3);
                const bool isz = sc[i] == 0.f;
                const unsigned long long zb = __ballot(isz);
                if ((lane & 31) == 0) zm_h[c * 256 + kt] = (unsigned)(zb >> (hh * 32));
                if (isz) sc[i] = -__builtin_inff();
            }
        }
#pragma unroll
        for (int hf = 0; hf < 2; ++hf) {
            unsigned s0 = 0x80000000u, s1 = s0, s2 = s0, s3 = s0, s4 = s0, s5 = s0, s6 = s0, s7 = s0;
            { unsigned long long sav; const unsigned one = 8u; const unsigned ca = cnt_addr + 64u * hf;
#define TK_SLOT(n, off) "v_cmp_gt_f32 vcc, %" #n ", %[t" #n "]\n\ts_and_saveexec_b64 %[sav], vcc\n\tds_add_rtn_u32 %[s" #n "], %[ca], %[one] offset:" #off "\n\ts_mov_b64 exec, %[sav]\n\t"
              asm volatile(
                  "v_cmp_gt_f32 vcc, %[c0], %[t0]\n\ts_and_saveexec_b64 %[sav], vcc\n\tds_add_rtn_u32 %[s0], %[ca], %[one] offset:0\n\ts_mov_b64 exec, %[sav]\n\t"
                  "v_cmp_gt_f32 vcc, %[c1], %[t1]\n\ts_and_saveexec_b64 %[sav], vcc\n\tds_add_rtn_u32 %[s1], %[ca], %[one] offset:8\n\ts_mov_b64 exec, %[sav]\n\t"
                  "v_cmp_gt_f32 vcc, %[c2], %[t2]\n\ts_and_saveexec_b64 %[sav], vcc\n\tds_add_rtn_u32 %[s2], %[ca], %[one] offset:16\n\ts_mov_b64 exec, %[sav]\n\t"
                  "v_cmp_gt_f32 vcc, %[c3], %[t3]\n\ts_and_saveexec_b64 %[sav], vcc\n\tds_add_rtn_u32 %[s3], %[ca], %[one] offset:24\n\ts_mov_b64 exec, %[sav]\n\t"
                  "v_cmp_gt_f32 vcc, %[c4], %[t4]\n\ts_and_saveexec_b64 %[sav], vcc\n\tds_add_rtn_u32 %[s4], %[ca], %[one] offset:32\n\ts_mov_b64 exec, %[sav]\n\t"
                  "v_cmp_gt_f32 vcc, %[c5], %[t5]\n\ts_and_saveexec_b64 %[sav], vcc\n\tds_add_rtn_u32 %[s5], %[ca], %[one] offset:40\n\ts_mov_b64 exec, %[sav]\n\t"
                  "v_cmp_gt_f32 vcc, %[c6], %[t6]\n\ts_and_saveexec_b64 %[sav], vcc\n\tds_add_rtn_u32 %[s6], %[ca], %[one] offset:48\n\ts_mov_b64 exec, %[sav]\n\t"
                  "v_cmp_gt_f32 vcc, %[c7], %[t7]\n\ts_and_saveexec_b64 %[sav], vcc\n\tds_add_rtn_u32 %[s7], %[ca], %[one] offset:56\n\ts_mov_b64 exec, %[sav]\n\t"
                  "s_waitcnt lgkmcnt(0)"
                  : [s0] "+v"(s0), [s1] "+v"(s1), [s2] "+v"(s2), [s3] "+v"(s3), [s4] "+v"(s4), [s5] "+v"(s5), [s6] "+v"(s6), [s7] "+v"(s7), [sav] "=&s"(sav)
                  : [ca] "v"(ca), [one] "v"(one),
                    [c0] "v"(sc[8 * hf + 0]), [c1] "v"(sc[8 * hf + 1]), [c2] "v"(sc[8 * hf + 2]), [c3] "v"(sc[8 * hf + 3]), [c4] "v"(sc[8 * hf + 4]), [c5] "v"(sc[8 * hf + 5]), [c6] "v"(sc[8 * hf + 6]), [c7] "v"(sc[8 * hf + 7]),
                    [t0] "v"(thr[8 * hf + 0]), [t1] "v"(thr[8 * hf + 1]), [t2] "v"(thr[8 * hf + 2]), [t3] "v"(thr[8 * hf + 3]), [t4] "v"(thr[8 * hf + 4]), [t5] "v"(thr[8 * hf + 5]), [t6] "v"(thr[8 * hf + 6]), [t7] "v"(thr[8 * hf + 7])
                  : "vcc", "memory"); }
#undef TK_SLOT
            const unsigned slot[8] = {s0, s1, s2, s3, s4, s5, s6, s7};
#pragma unroll
            for (int ii = 0; ii < 8; ++ii) {
                const int i = 8 * hf + ii, c = 8 * (i >> 2) + 2 * (i & 3);
                __builtin_amdgcn_raw_buffer_store_b64((gl_u2v){key, __float_as_uint(sc[i])}, lrs, slot[ii], 0, 0); (void)c;
            }
        }
    }
    asm volatile("s_waitcnt vmcnt(0)" ::: "memory");
    __syncthreads();
    for (int i = 0; i < 4; ++i) {
        const int ql = wave * 4 + i;
        const int m = (int)(cnt_s[ql] >> 3) - ql * TK_CAP; const bool over = m > TK_CAP; const int mm = over ? TK_CAP : m;
        const int ne = (mm + 63) >> 6;
        TrItem ti; f32x2v cv[16]; f32x4 k0v, k1v; const int cg = cgw + cngw * (cj.slot0 + i); const bool chave = cg < cj.total;
        if (chave) { tr_decode(*cj.p, cj.segs, cj.nseg, cg, lane, ti); tr_load_g(*cj.p, ti, lane, cv, k0v, k1v); }
        __builtin_amdgcn_sched_barrier(0);
        if (ne <= 8) s3_query<8>(ql, m, mm, over, lane, list, zm, mt, ctl, lo_s[ql]);
        else if (ne <= 10) s3_query<10>(ql, m, mm, over, lane, list, zm, mt, ctl, lo_s[ql]);
        else if (ne <= 12) s3_query<12>(ql, m, mm, over, lane, list, zm, mt, ctl, lo_s[ql]);
        else s3_query<16>(ql, m, mm, over, lane, list, zm, mt, ctl, lo_s[ql]);
        __builtin_amdgcn_sched_barrier(0);
        if (chave) tr_store_g(ti, lane, cv, k0v, k1v, cscr);
    }
    __syncthreads();
    for (int i = tid; i < nkt_w * 32; i += NTHR) mdst[i] = (unsigned long long)mt[2 * i] | ((unsigned long long)mt[2 * i + 1] << 32);
}

#include <hip/hip_bf16.h>
#include <cmath>
namespace attn_body {
using bf16=__hip_bfloat16;
using bf16x8=__attribute__((ext_vector_type(8)))short;
using s16x4=__attribute__((ext_vector_type(4)))short;
using f32x16=__attribute__((ext_vector_type(16)))float;
using u32x4=__attribute__((ext_vector_type(4)))unsigned;
constexpr int BATCH=2,NHEAD=8,SEQ=8192,D=64,DM=NHEAD*D,DMO=1024;
constexpr int NW=8,QBLK=32,QB=QBLK*NW,KVBLK=64,NQB=SEQ/QB;
constexpr int ATTN_PITCH=DM, ATTN_UNIT_ROWS=QB;
__device__ __forceinline__ int crow(int r,int hi){return (r&3)+8*(r>>2)+4*hi;}
#define SBAR() __builtin_amdgcn_sched_barrier(0)
__device__ __forceinline__ void cmask(f32x16&p0,f32x16&p1,int jb,int qrel,int hi){
  const float NEG=-INFINITY; int kb=64*jb+4*hi;
  #pragma unroll
  for(int r=0;r<16;++r){int kv=kb+(r&3)+8*(r>>2); if(kv>qrel)p0[r]=NEG; if(kv+32>qrel)p1[r]=NEG;}
}

constexpr int NSLOT=3, SLOTB=8192;
constexpr int LDS_K=0, LDS_V=NSLOT*SLOTB, LDS_WS=2*NSLOT*SLOTB, LDS_OST=LDS_WS+NW*64*4, LDS_MK=LDS_OST+NW*4096, LDS_BYTES=LDS_MK+NW*512;
constexpr float C2=0.125f*1.4426950408889634f;
__device__ __forceinline__ void glds16(const void*gsrc,unsigned lds_dst){unsigned keep;
  asm volatile("s_mov_b32 %0, m0\n\ts_mov_b32 m0, %2\n\ts_nop 0\n\tglobal_load_lds_dwordx4 %1, off\n\ts_mov_b32 m0, %0":"=&s"(keep):"v"(gsrc),"s"(lds_dst):"memory");}
__device__ __forceinline__ void glds4(const void*gsrc,unsigned lds_dst){unsigned keep;
  asm volatile("s_mov_b32 %0, m0\n\ts_mov_b32 m0, %2\n\ts_nop 0\n\tglobal_load_lds_dword %1, off\n\ts_mov_b32 m0, %0":"=&s"(keep):"v"(gsrc),"s"(lds_dst):"memory");}
template<int BIT> __device__ __forceinline__ int bfe1_t(unsigned w){int m;asm("v_bfe_i32 %0, %1, %2, 1":"=v"(m):"v"(w),"n"(BIT));return m;}
#define bfe1(w,b) bfe1_t<(b)>(w)
__device__ __forceinline__ float max3f(float a,float b,float c){float r;asm("v_max3_f32 %0, %1, %2, %3":"=v"(r):"v"(a),"v"(b),"v"(c));return r;}
__device__ __forceinline__ float max2f(float a,float b){float r;asm("v_max_f32_e32 %0, %1, %2":"=v"(r):"v"(a),"v"(b));return r;}
__device__ __forceinline__ float fadd_s(float a,float b){float r;asm("v_add_f32_e32 %0, %1, %2":"=v"(r):"v"(a),"v"(b));return r;}
__device__ __forceinline__ float fsub_s(float a,float b){float r;asm("v_sub_f32_e32 %0, %1, %2":"=v"(r):"v"(a),"v"(b));return r;}
typedef float f32x2_t __attribute__((ext_vector_type(2))); typedef __bf16 bf16x2_t __attribute__((ext_vector_type(2)));
__device__ __forceinline__ unsigned cvtpk_s(float lo,float hi){f32x2_t v={lo,hi};bf16x2_t b=__builtin_convertvector(v,bf16x2_t);return __builtin_bit_cast(unsigned,b);}
#define WAIT_BAR(N) asm volatile("s_waitcnt vmcnt(" #N ") lgkmcnt(0)\n\ts_barrier":::"memory")

__device__ __forceinline__ void qkt(f32x16&p0,f32x16&p1,const char*Kslot,const bf16x8*qr,const f32x16&negm,int r32,int hi){
  const char*kb=Kslot+hi*1024+r32*16;
  #pragma unroll
  for(int d0=0;d0<4;++d0){
    const bf16x8 b0=*reinterpret_cast<const bf16x8*>(kb+d0*2048);
    const bf16x8 b1=*reinterpret_cast<const bf16x8*>(kb+d0*2048+512);
    if(d0==0){p0=__builtin_amdgcn_mfma_f32_32x32x16_bf16(b0,qr[0],negm,0,0,0);p1=__builtin_amdgcn_mfma_f32_32x32x16_bf16(b1,qr[0],negm,0,0,0);}
    else{p0=__builtin_amdgcn_mfma_f32_32x32x16_bf16(b0,qr[d0],p0,0,0,0);p1=__builtin_amdgcn_mfma_f32_32x32x16_bf16(b1,qr[d0],p1,0,0,0);}}
}
typedef __attribute__((address_space(3))) const char* lds_cptr;
typedef short v4i16_t __attribute__((ext_vector_type(4)));
__device__ __forceinline__ void kload8(bf16x8*kf,lds_cptr kp){
  kf[0]=*(const __attribute__((address_space(3))) bf16x8*)(kp);      kf[1]=*(const __attribute__((address_space(3))) bf16x8*)(kp+512);
  kf[2]=*(const __attribute__((address_space(3))) bf16x8*)(kp+2048); kf[3]=*(const __attribute__((address_space(3))) bf16x8*)(kp+2560);
  kf[4]=*(const __attribute__((address_space(3))) bf16x8*)(kp+4096); kf[5]=*(const __attribute__((address_space(3))) bf16x8*)(kp+4608);
  kf[6]=*(const __attribute__((address_space(3))) bf16x8*)(kp+6144); kf[7]=*(const __attribute__((address_space(3))) bf16x8*)(kp+6656);
}
__device__ __forceinline__ void kload2(bf16x8*kf,lds_cptr kp,int j){ kf[2*j]=*(const __attribute__((address_space(3))) bf16x8*)(kp+j*2048); kf[2*j+1]=*(const __attribute__((address_space(3))) bf16x8*)(kp+j*2048+512); }
__device__ __forceinline__ s16x4 vtr(lds_cptr p){ return __builtin_bit_cast(s16x4,__builtin_amdgcn_ds_read_tr16_b64_v4i16((__attribute__((address_space(3))) v4i16_t*)p)); }
__device__ __forceinline__ float rowmax(const f32x16&p0,const f32x16&p1){
  float a=max3f(p0[0],p0[1],p1[0]),b=max3f(p0[2],p0[3],p1[1]);a=max3f(a,p1[2],p1[3]);
  #pragma unroll
  for(int r=4;r<16;r+=4){a=max3f(a,p0[r],p0[r+1]);b=max3f(b,p0[r+2],p0[r+3]);a=max3f(a,p1[r],p1[r+1]);b=max3f(b,p1[r+2],p1[r+3]);}
  const float m=max2f(a,b);
  auto rr=__builtin_amdgcn_permlane32_swap(__float_as_uint(m),__float_as_uint(m),false,false);
  return max2f(__uint_as_float(rr[0]),__uint_as_float(rr[1]));
}
__device__ __forceinline__ void pv(f32x16*o,int vb,bf16x8 pa0,bf16x8 pa1,bf16x8 pa2,bf16x8 pa3){
  #pragma unroll
  for(int d0=0;d0<2;++d0){s16x4 lo[4],hi[4];
    #pragma unroll
    for(int ks=0;ks<4;++ks){
      asm volatile("ds_read_b64_tr_b16 %0,%1 offset:%c2":"=&v"(lo[ks]):"v"(vb),"i"(d0*4096+ks*1024):"memory");
      asm volatile("ds_read_b64_tr_b16 %0,%1 offset:%c2":"=&v"(hi[ks]):"v"(vb),"i"(d0*4096+ks*1024+512):"memory");}
    asm volatile("s_waitcnt lgkmcnt(0)":::"memory");SBAR();
    #define PK(k) (bf16x8){lo[k][0],lo[k][1],lo[k][2],lo[k][3],hi[k][0],hi[k][1],hi[k][2],hi[k][3]}
    o[d0]=__builtin_amdgcn_mfma_f32_32x32x16_bf16(pa0,PK(0),o[d0],0,0,0);
    o[d0]=__builtin_amdgcn_mfma_f32_32x32x16_bf16(pa1,PK(1),o[d0],0,0,0);
    o[d0]=__builtin_amdgcn_mfma_f32_32x32x16_bf16(pa2,PK(2),o[d0],0,0,0);
    o[d0]=__builtin_amdgcn_mfma_f32_32x32x16_bf16(pa3,PK(3),o[d0],0,0,0);
    #undef PK
  }
}

#ifndef ATTN_STORE16
#define ATTN_STORE16(p,v) (*(u32x4*)(p)=(v))
#endif
template<int THRL> __device__ __forceinline__ void attn_unit(int b,int h,int qb,const bf16*Q,const bf16*__restrict__ K,const bf16*__restrict__ V,unsigned short*O,const unsigned long long*MT,char*shm,const int WV){
  const int tid=otid(WV),lane=tid&63,r32=lane&31,hi=lane>>5; const int wid=__builtin_amdgcn_readfirstlane(tid>>6);
  const long rowbase=(long)b*SEQ; const int q0=qb*QB;
  const bf16*Qw=Q+(rowbase+q0+wid*QBLK)*DM+h*D;
  const bf16*Kh=K+rowbase*DM+h*D,*Vh=V+rowbase*DM+h*D;
  const unsigned lds0=(unsigned)(uintptr_t)shm;
  float*wsf=(float*)(shm+LDS_WS)+wid*64;
  const bf16*ksrc=Kh+(long)lane*DM+wid*8;
  const bf16*vsrc=Vh+(long)(16*(wid&3)+(lane>>2))*DM+(wid>>2)*32+(lane&3)*8;
  const unsigned kdst=lds0+LDS_K+wid*1024, vdst=lds0+LDS_V+wid*1024;
  const unsigned*msrc=(const unsigned*)(MT+((size_t)(b*256+qb*8+wid)*128)*32)+lane; const unsigned mdst=lds0+LDS_MK+wid*512;
  #define DMA_M(t) glds4(msrc+(long)(t)*64,(unsigned)__builtin_amdgcn_readfirstlane(mdst+((t)&1)*256))
  const __attribute__((address_space(3))) unsigned long long* mrd=(const __attribute__((address_space(3))) unsigned long long*)((lds_cptr)shm+LDS_MK+wid*512)+r32;
  #define DMA_K(t,slot) glds16(ksrc+(long)(t)*KVBLK*DM,(unsigned)__builtin_amdgcn_readfirstlane(kdst+(slot)))
  #define DMA_V(t,slot) glds16(vsrc+(long)(t)*KVBLK*DM,(unsigned)__builtin_amdgcn_readfirstlane(vdst+(slot)))
  const int vb0=(int)(lds0+LDS_V)+((lane>>4)&1)*32+(lane&3)*8+(4*hi+((lane&15)>>2))*64;
  const char*Kbase=shm+LDS_K; bf16x8 kf[8];
  const lds_cptr shm3=(lds_cptr)shm; const lds_cptr kp0=shm3+LDS_K+hi*1024+r32*16; const lds_cptr vp0=shm3+LDS_V+((lane>>4)&1)*32+(lane&3)*8+(4*hi+((lane&15)>>2))*64;
  const int NT=(q0+QB)/KVBLK;
  DMA_M(0);DMA_K(0,0);DMA_V(0,0);DMA_K(1,SLOTB);
  bf16x8 qr[4];
  #pragma unroll
  for(int d0=0;d0<4;++d0)qr[d0]=*reinterpret_cast<const bf16x8*>(&Qw[(long)r32*DM+d0*16+hi*8]);
  float mhat=0.f,l_reg=0.f;f32x16 o[2];o[0]=zero16();o[1]=zero16();f32x16 negm=zero16();asm volatile("":"+v"(negm));
  const int qrel=wid*QBLK+r32;
  #define CMASK(P0,P1,t) do{}while(0)
  #define MKBIT(r) (((r)&3)+8*((r)>>2))
  #define MK(v,w,r) __uint_as_float(__float_as_uint(v)&(unsigned)bfe1(w,MKBIT(r)))
  #define MKV(v,w,r) __uint_as_float(__float_as_uint(v)&(unsigned)(((int)((w)<<(31-MKBIT(r))))>>31))
  #define MLOAD(t,W0,W1) const unsigned long long mq_=mrd[((t)&1)*32]; const unsigned W0=((unsigned)mq_)>>(4*hi), W1=((unsigned)(mq_>>32))>>(4*hi)
  bool resc=false;
  #define START(P0,P1) do{ const float rm=rowmax(P0,P1); resc=false; \
    { const float dl=rm; mhat=fadd_s(mhat,dl); \
      _Pragma("unroll") for(int r=0;r<16;++r){P0[r]=fsub_s(P0[r],dl);P1[r]=fsub_s(P1[r],dl);} \
      _Pragma("unroll") for(int r=0;r<16;++r)negm[r]=-mhat; asm volatile("":"+v"(negm)); } \
    _Pragma("unroll") for(int r=0;r<16;++r)P0[r]=__builtin_amdgcn_exp2f(P0[r]); }while(0)
  #define RESC() do{ if(resc){ asm volatile("s_waitcnt lgkmcnt(0)":::"memory"); \
      _Pragma("unroll") for(int d_=0;d_<2;++d_) _Pragma("unroll") for(int r=0;r<16;++r)o[d_][r]*=wsf[crow(r,hi)]; } }while(0)
  f32x16 pA0,pA1,pB0,pB1;
  int sl_prev=0,sl_cur=0,sl_next=SLOTB;
  #define ROT() do{sl_prev=sl_cur;sl_cur=sl_next;sl_next=(sl_next==(NSLOT-1)*SLOTB)?0:sl_next+SLOTB;}while(0)
  DMA_K(2,2*SLOTB);
  WAIT_BAR(3);
  qkt(pA0,pA1,Kbase,qr,negm,r32,hi);asm volatile("s_nop 15\n\ts_nop 7":"+v"(pA0),"+v"(pA1));CMASK(pA0,pA1,0);
  START(pA0,pA1);
  _Pragma("unroll") for(int r=0;r<16;++r)pA1[r]=__builtin_amdgcn_exp2f(pA1[r]);
  { MLOAD(0,mwa,mwb); _Pragma("unroll") for(int r=0;r<16;++r){pA0[r]=MKV(pA0[r],mwa,r);pA1[r]=MKV(pA1[r],mwb,r);} }
  WAIT_BAR(0);
  DMA_M(1);DMA_K(3,0);DMA_V(1,SLOTB);
  ROT();
  kload8(kf,kp0+sl_cur);
  WAIT_BAR(2);
  s16x4 vlo[8],vhi[8]; u32x4 pw0,pw1,pw2,pw3;
  #define PKW(P,B) cvtpk_s(P[B],P[B+1])
  #define PAF(k) __builtin_bit_cast(bf16x8,pw##k)
  #define VFR(i) (bf16x8){vlo[i][0],vlo[i][1],vlo[i][2],vlo[i][3],vhi[i][0],vhi[i][1],vhi[i][2],vhi[i][3]}
  #define PIN(x) asm volatile("":"+v"(x))
  #define MX3(a,b,c) __builtin_fmaxf(__builtin_fmaxf((a),(b)),(c))
  #define GAPA(MF,A0,A1,A2,A3,W0,W1,PW) do{ MF; sacc+=A0; sacc+=A1; sacc+=A2; sacc+=A3; PIN(sacc); W0; W1; PIN(PW); SBAR(); }while(0)
  #define EX(v) __builtin_amdgcn_exp2f(v)
  #define GAPB(MF,X,B,W) do{ MF; X[B]=MK(EX(X[B]),W,B); X[B+1]=MK(EX(X[B+1]),W,B+1); X[B+2]=MK(EX(X[B+2]),W,B+2); X[B+3]=MK(EX(X[B+3]),W,B+3); PIN(X); SBAR(); }while(0)
  #define VRD(i) do{ vlo[i]=vtr(vp_+(((i)>>2)*4096+((i)&3)*1024)); vhi[i]=vtr(vp_+(((i)>>2)*4096+((i)&3)*1024+512)); }while(0)
  #define KRD(G,j) do{ if(G){ kload2(kf,kp0+sl_next,j); SBAR(); } }while(0)
  #define STEP(C0,C1,P0,P1,t,GK,GV,GL,GM) do{ SBAR(); \
    if(GM){DMA_M((t)+1);} \
    const lds_cptr vp_=vp0+sl_prev; \
    VRD(0); SBAR(); float sacc=(P0[0]+P0[1]); \
    GAPA(C0=__builtin_amdgcn_mfma_f32_32x32x16_bf16(kf[0],qr[0],negm,0,0,0), P0[2],P0[3],P0[4],P0[5],     pw0[0]=PKW(P0,0), pw0[1]=PKW(P0,2), pw0); \
    VRD(4); SBAR(); GAPA(C1=__builtin_amdgcn_mfma_f32_32x32x16_bf16(kf[1],qr[0],negm,0,0,0), P0[6],P0[7],P0[8],P0[9],     pw0[2]=PKW(P0,4), pw0[3]=PKW(P0,6), pw0); \
    VRD(1); SBAR(); GAPA(C0=__builtin_amdgcn_mfma_f32_32x32x16_bf16(kf[2],qr[1],C0,0,0,0),   P0[10],P0[11],P0[12],P0[13], pw1[0]=PKW(P0,8), pw1[1]=PKW(P0,10), pw1); \
    VRD(5); SBAR(); GAPA(C1=__builtin_amdgcn_mfma_f32_32x32x16_bf16(kf[3],qr[1],C1,0,0,0),   P0[14],P0[15],P1[0],P1[1],   pw1[2]=PKW(P0,12),pw1[3]=PKW(P0,14), pw1); \
    VRD(2); SBAR(); GAPA(C0=__builtin_amdgcn_mfma_f32_32x32x16_bf16(kf[4],qr[2],C0,0,0,0),   P1[2],P1[3],P1[4],P1[5],     pw2[0]=PKW(P1,0), pw2[1]=PKW(P1,2), pw2); \
    VRD(6); SBAR(); GAPA(C1=__builtin_amdgcn_mfma_f32_32x32x16_bf16(kf[5],qr[2],C1,0,0,0),   P1[6],P1[7],P1[8],P1[9],     pw2[2]=PKW(P1,4), pw2[3]=PKW(P1,6), pw2); \
    VRD(3); SBAR(); GAPA(C0=__builtin_amdgcn_mfma_f32_32x32x16_bf16(kf[6],qr[3],C0,0,0,0),   P1[10],P1[11],P1[12],P1[13], pw3[0]=PKW(P1,8), pw3[1]=PKW(P1,10), pw3); \
    VRD(7); SBAR(); GAPA(C1=__builtin_amdgcn_mfma_f32_32x32x16_bf16(kf[7],qr[3],C1,0,0,0),   P1[14],P1[15],0.f,0.f,       pw3[2]=PKW(P1,12),pw3[3]=PKW(P1,14), pw3); \
    l_reg+=sacc; \
    if(GK){DMA_K((t)+3,sl_cur);} if(GV){DMA_V((t)+1,sl_next);} \
    CMASK(C0,C1,t); \
    { float a=MX3(C0[0],C0[1],C1[0]),b=MX3(C0[2],C0[3],C1[1]); a=MX3(a,C1[2],C1[3]); \
      _Pragma("unroll") for(int r=4;r<16;r+=4){a=MX3(a,C0[r],C0[r+1]);b=MX3(b,C0[r+2],C0[r+3]);a=MX3(a,C1[r],C1[r+1]);b=MX3(b,C1[r+2],C1[r+3]);} \
      float rm=__builtin_fmaxf(a,b); { auto rr=__builtin_amdgcn_permlane32_swap(__float_as_uint(rm),__float_as_uint(rm),false,false); rm=__builtin_fmaxf(__uint_as_float(rr[0]),__uint_as_float(rr[1])); } \
      resc=false; \
      if(__builtin_expect(__any(rm>(float)THRL),0)){ const float dl=__builtin_fmaxf(rm,0.f); mhat+=dl; \
        _Pragma("unroll") for(int r=0;r<16;++r){C0[r]-=dl;C1[r]-=dl;} \
        _Pragma("unroll") for(int r=0;r<16;++r)negm[r]=-mhat; asm volatile("":"+v"(negm)); \
        const float f=__builtin_amdgcn_exp2f(-dl); l_reg*=f; if(hi==0)wsf[r32]=f; resc=true; } } \
    SBAR(); \
    MLOAD(t,mw0_,mw1_); \
    GAPB(o[0]=__builtin_amdgcn_mfma_f32_32x32x16_bf16(PAF(0),VFR(0),o[0],0,0,0), C0,0,mw0_); \
    GAPB(o[1]=__builtin_amdgcn_mfma_f32_32x32x16_bf16(PAF(0),VFR(4),o[1],0,0,0), C0,4,mw0_); \
    KRD(GL,0); GAPB(o[0]=__builtin_amdgcn_mfma_f32_32x32x16_bf16(PAF(1),VFR(1),o[0],0,0,0), C0,8,mw0_); \
    KRD(GL,1); GAPB(o[1]=__builtin_amdgcn_mfma_f32_32x32x16_bf16(PAF(1),VFR(5),o[1],0,0,0), C0,12,mw0_); \
    KRD(GL,2); GAPB(o[0]=__builtin_amdgcn_mfma_f32_32x32x16_bf16(PAF(2),VFR(2),o[0],0,0,0), C1,0,mw1_); \
    KRD(GL,3); GAPB(o[1]=__builtin_amdgcn_mfma_f32_32x32x16_bf16(PAF(2),VFR(6),o[1],0,0,0), C1,4,mw1_); \
    GAPB(o[0]=__builtin_amdgcn_mfma_f32_32x32x16_bf16(PAF(3),VFR(3),o[0],0,0,0), C1,8,mw1_); \
    GAPB(o[1]=__builtin_amdgcn_mfma_f32_32x32x16_bf16(PAF(3),VFR(7),o[1],0,0,0), C1,12,mw1_); \
    }while(0)
  int t=1;
  #undef CMASK
  #define CMASK(P0,P1,t) do{}while(0)
  for(;t+5<NT;t+=2){
    STEP(pB0,pB1,pA0,pA1,t,true,true,true,true);     WAIT_BAR(2); RESC(); ROT();
    STEP(pA0,pA1,pB0,pB1,t+1,true,true,true,true);   WAIT_BAR(2); RESC(); ROT();
  }
  #undef CMASK
  #define CMASK(P0,P1,t) do{}while(0)
  #define ENDW(tt) do{ if((tt)+3<NT){WAIT_BAR(2);} else if((tt)+2<NT){WAIT_BAR(1);} else {WAIT_BAR(0);} }while(0)
  for(;t+1<NT;t+=2){
    STEP(pB0,pB1,pA0,pA1,t,(t+3<NT),(t+1<NT),(t+1<NT),(t+1<NT));       ENDW(t);   RESC(); ROT();
    STEP(pA0,pA1,pB0,pB1,t+1,(t+4<NT),(t+2<NT),(t+2<NT),(t+2<NT));     ENDW(t+1); RESC(); ROT();
  }
  STEP(pB0,pB1,pA0,pA1,NT-1,false,false,false,false); RESC();
  { float sacc=pB0[0]+pB0[1]; _Pragma("unroll") for(int r=2;r<16;++r)sacc+=pB0[r]; _Pragma("unroll") for(int r=0;r<16;++r)sacc+=pB1[r]; l_reg+=sacc;
    pw0=(u32x4){PKW(pB0,0),PKW(pB0,2),PKW(pB0,4),PKW(pB0,6)};pw1=(u32x4){PKW(pB0,8),PKW(pB0,10),PKW(pB0,12),PKW(pB0,14)};pw2=(u32x4){PKW(pB1,0),PKW(pB1,2),PKW(pB1,4),PKW(pB1,6)};pw3=(u32x4){PKW(pB1,8),PKW(pB1,10),PKW(pB1,12),PKW(pB1,14)};
    SBAR(); pv(o,vb0+sl_cur,PAF(0),PAF(1),PAF(2),PAF(3)); }
  #undef PKW
  #undef PAF
  #undef VFR
  #undef PIN
  #undef MX3
  #undef GAPA
  #undef GAPB
  #undef EX
  #undef VRD
  #undef KRD
  #undef STEP
  #undef ENDW
  {auto rr=__builtin_amdgcn_permlane32_swap(__float_as_uint(l_reg),__float_as_uint(l_reg),false,false);l_reg=__uint_as_float(rr[0])+__uint_as_float(rr[1]);}
  if(hi==0)wsf[32+r32]=l_reg;asm volatile("s_waitcnt lgkmcnt(0)":::"memory");
  float rli[16];
  #pragma unroll
  for(int r=0;r<16;++r)rli[r]=__builtin_amdgcn_rcpf(wsf[32+crow(r,hi)]);
  unsigned short*Ow=O+(rowbase+q0+wid*QBLK)*DMO+h*D;
  { unsigned short*stg=(unsigned short*)(shm+LDS_OST)+wid*2048;
    #pragma unroll
    for(int r=0;r<16;++r){const int orow=crow(r,hi);
      #pragma unroll
      for(int d0=0;d0<2;++d0)stg[orow*64+d0*32+r32]=__builtin_bit_cast(unsigned short,(_Float16)(o[d0][r]*rli[r]));}
    asm volatile("s_waitcnt lgkmcnt(0)":::"memory");
    #pragma unroll
    for(int i=0;i<4;++i){const int row=i*8+(lane>>3),ch=lane&7; const u32x4 v=*(const u32x4*)(stg+row*64+ch*8); ATTN_STORE16(Ow+(long)row*DMO+ch*8,v);} }
  asm volatile("s_waitcnt lgkmcnt(0)\n\ts_barrier":::"memory");
  #undef DMA_K
  #undef DMA_V
  #undef DMA_M
  #undef MK
  #undef MKV
  #undef MKBIT
  #undef MLOAD
  #undef CMASK
  #undef START
  #undef RESC
  #undef ROT
}
constexpr int ATTN_LDS_BYTES=LDS_BYTES;
struct AttnTensors { const bf16* Q; const bf16* K; const bf16* V; unsigned short* O; const unsigned long long* MT; };
struct AttnUnit { int bh; int qb; };
struct StaticOrder {
  int vcu;
  __device__ __forceinline__ explicit StaticOrder(int grid,int block):vcu((block%8)*(grid/8)+block/8){}
  __device__ __forceinline__ bool next(int i,AttnUnit&u)const{ if(i>=2)return false; const int s=vcu&15; u.bh=vcu>>4; u.qb=(i==0)?s:31-s; return true; }
  __device__ __forceinline__ void a_ready(const AttnUnit&)const{}
  __device__ __forceinline__ void done(const AttnUnit&)const{}
};
template<class Sched,int THRL=8> __device__ __forceinline__ void attn_phase(char*lds,const AttnTensors&T,const Sched&S,const int WV){
  AttnUnit u;
  for(int i=0;S.next(i,u);++i){ S.a_ready(u); attn_unit<THRL>(u.bh/NHEAD,u.bh%NHEAD,u.qb,T.Q,T.K,T.V,T.O,T.MT,lds,WV); S.done(u); }
}
#undef SBAR
#undef WAIT_BAR
}


typedef __attribute__((address_space(1))) unsigned gu32;
#define XB_TMO      128
#define XB_XCNT(j)  (256  + 64 * (j))
#define XB_XSUB(j)  (1280 + 64 * (j))
#define XB_XGEN(j)  (2304 + 64 * (j))
#define XB_TOP      3328
#define XB_TOPGEN   3392
#define XCD_BAR_WORDS 3456
#define XB_SPIN_CAP (1u << 18)

__device__ __forceinline__ unsigned xb_ld(unsigned* p)              { return __hip_atomic_load(p, __ATOMIC_RELAXED, __HIP_MEMORY_SCOPE_AGENT); }
__device__ __forceinline__ unsigned xb_add(unsigned* p, unsigned v) { return __hip_atomic_fetch_add(p, v, __ATOMIC_RELAXED, __HIP_MEMORY_SCOPE_AGENT); }
__device__ __forceinline__ unsigned xb_xcc_id() { return (unsigned)__builtin_amdgcn_s_getreg((3 << 11) | 20) & 0xFu; }
#define XB_SPIN(cond, bar) do { unsigned _sp = 0; while (cond) { __builtin_amdgcn_s_sleep(1); \
    if ((++_sp & 255u) == 0u) { if (xb_ld(&(bar)[XB_TMO])) break; if (_sp > XB_SPIN_CAP) { atomicAdd(&(bar)[XB_TMO], 1u); break; } } } } while (0)

struct XcdBarrier {
    unsigned* bar; unsigned x;
    volatile LAS unsigned* st;
};

__device__ __forceinline__ XcdBarrier xcd_barrier_post(unsigned* bar, volatile LAS unsigned* st) {
    XcdBarrier b; b.bar = bar; b.x = xb_xcc_id(); b.st = st;
    if (threadIdx.x == 0) (void)xb_add(&bar[XB_XCNT(b.x)], 1u);
    return b;
}
__device__ __forceinline__ void xcd_barrier_complete(unsigned* bar, unsigned x, unsigned& nloc, unsigned& nx) {
    const unsigned G = gridDim.x * gridDim.y * gridDim.z;
    unsigned sum, cnt, mine, sp = 0u;
    for (;;) {
        sum = 0u; cnt = 0u; mine = 0u;
#pragma unroll
        for (unsigned j = 0; j < 16; ++j) { const unsigned c = xb_ld(&bar[XB_XCNT(j)]); sum += c; cnt += (c > 0u) ? 1u : 0u; mine = (j == x) ? c : mine; }
        if (sum == G) break;
        __builtin_amdgcn_s_sleep(1);
        if ((++sp & 255u) == 0u) { if (xb_ld(&bar[XB_TMO])) break; if (sp > XB_SPIN_CAP) { atomicAdd(&bar[XB_TMO], 1u); break; } }
    }
    nloc = mine > 0u ? mine : 1u; nx = cnt > 0u ? cnt : 1u;
}

__device__ __forceinline__ void xcd_barrier(const XcdBarrier& b) {
    asm volatile("s_waitcnt vmcnt(0)" ::: "memory");
    __syncthreads();
    if (threadIdx.x == 0) {
        unsigned* bar = b.bar;
        __builtin_amdgcn_s_waitcnt(0);
        unsigned nloc = b.st[0], nx = b.st[1];
        if (nloc == 0u) { xcd_barrier_complete(bar, b.x, nloc, nx); b.st[0] = nloc; b.st[1] = nx; }
        const unsigned old = xb_add(&bar[XB_XSUB(b.x)], 1u);
        const unsigned gen = old / nloc;
        if (old + 1u == (gen + 1u) * nloc) {
            __builtin_amdgcn_fence(__ATOMIC_RELEASE, "agent");
            asm volatile("s_waitcnt vmcnt(0)" ::: "memory");
            const unsigned og = xb_add(&bar[XB_TOP], 1u);
            const unsigned tg = og / nx;
            if (og + 1u == (tg + 1u) * nx) xb_add(&bar[XB_TOPGEN], 1u);
            else XB_SPIN(xb_ld(&bar[XB_TOPGEN]) == tg, bar);
            __builtin_amdgcn_fence(__ATOMIC_ACQUIRE, "agent");
            xb_add(&bar[XB_XGEN(b.x)], 1u);
            asm volatile("s_waitcnt vmcnt(0)" ::: "memory");
        } else {
            XB_SPIN(xb_ld(&bar[XB_XGEN(b.x)]) == gen, bar);
            __builtin_amdgcn_fence(__ATOMIC_ACQUIRE, "agent");
            asm volatile("s_waitcnt vmcnt(0)" ::: "memory");
        }
    }
    __syncthreads();
}

constexpr int GLA_HALF_BYTES = 61440;
__device__ __forceinline__ void gla_cumlog_h(const float* __restrict__ GL, const float* __restrict__ wg, const float* __restrict__ bg, int tok0, int h, LAS float* bl  , int t) {
    const int i = t >> 2, dq = t & 3;
    float gl[16];
#pragma unroll
    for (int r = 0; r < 4; ++r) { const f32x4 v = *(const f32x4*)(GL + (size_t)(tok0 + i) * 16 + 4 * r); gl[4 * r] = v[0]; gl[4 * r + 1] = v[1]; gl[4 * r + 2] = v[2]; gl[4 * r + 3] = v[3]; }
#pragma unroll
    for (int dd = 0; dd < 8; ++dd) {
        const int d = dq * 8 + dd; float z = bg[h * 32 + d];
#pragma unroll
        for (int r = 0; r < 16; ++r) z += gl[r] * wg[r * 128 + h * 32 + d];
        const float ls = fminf(z, 0.f) - log1pf(__expf(-fabsf(z)));
        bl[i * 33 + d] = ls * (1.f / 16.f);
    }
    __syncthreads();
    if (t < 32) { float a = 0.f; for (int ii = 0; ii < 64; ++ii) { a += bl[ii * 33 + t]; bl[ii * 33 + t] = a; } }
    __syncthreads();
}
__device__ __forceinline__ void gla1_item(int blk, int t, LAS unsigned char* sm, const float* GL, const u16* GQK, const u16* GV, const float* wg, const float* bg, float* DS, float* DD) {
    LAS float* bl = (LAS float*)sm; LAS float* kh = bl + 64 * 33; LAS float* vv = kh + 64 * 33;
    const int b = blk >> 9, h = (blk >> 7) & 3, c = blk & 127, tok0 = b * SEQ + c * 64;
    gla_cumlog_h(GL, wg, bg, tok0, h, bl, t);
    { const int j = t >> 2, dq = t & 3;
#pragma unroll
      for (int dd = 0; dd < 8; ++dd) { const int d = dq * 8 + dd; kh[j * 33 + d] = bf2f(GQK[(size_t)(tok0 + j) * 256 + 128 + h * 32 + d]) * __expf(bl[63 * 33 + d] - bl[j * 33 + d]); }
#pragma unroll
      for (int ee = 0; ee < 16; ++ee) { const int e = dq * 16 + ee; vv[j * 64 + e] = bf2f(GV[(size_t)(tok0 + j) * 256 + h * 64 + e]); } }
    __syncthreads();
    const int e = t & 63, dg = t >> 6;
#pragma unroll
    for (int dd = 0; dd < 8; ++dd) { const int d = dg * 8 + dd; float s = 0.f; for (int j = 0; j < 64; ++j) s += kh[j * 33 + d] * vv[j * 64 + e]; DS[(size_t)blk * 2048 + d * 64 + e] = s; }
    if (t < 32) DD[blk * 32 + t] = __expf(bl[63 * 33 + t]);
    __syncthreads();
}
__device__ __forceinline__ void gla3_item(int blk, int t, LAS unsigned char* sm, const float* GL, const u16* GQK, const u16* GV, const u16* GR, const float* wg, const float* bg, const float* S0, const float* gn, u16* MIX) {
    LAS float* bl = (LAS float*)sm; LAS float* qt = bl + 64 * 33; LAS float* kt = qt + 64 * 33; LAS float* Ss = kt + 64 * 33; LAS float* at = Ss + 32 * 64; LAS u16* vv = (LAS u16*)(at + 64 * 65);
    const int b = blk >> 9, h = (blk >> 7) & 3, c = blk & 127, tok0 = b * SEQ + c * 64;
    gla_cumlog_h(GL, wg, bg, tok0, h, bl, t);
    const int i = t >> 2, qd = t & 3;
#pragma unroll
    for (int dd = 0; dd < 8; ++dd) { const int d = qd * 8 + dd; const float bb = bl[i * 33 + d];
        qt[i * 33 + d] = bf2f(GQK[(size_t)(tok0 + i) * 256 + h * 32 + d]) * 0.17677669529663687f * __expf(bb);
        kt[i * 33 + d] = bf2f(GQK[(size_t)(tok0 + i) * 256 + 128 + h * 32 + d]) * __expf(-bb); }
#pragma unroll
    for (int ee = 0; ee < 16; ++ee) { const int e = qd * 16 + ee; vv[i * 64 + e] = GV[(size_t)(tok0 + i) * 256 + h * 64 + e]; }
    for (int x = t; x < 2048; x += 256) Ss[x] = S0[(size_t)blk * 2048 + x];
    __syncthreads();
#pragma unroll
    for (int jj = 0; jj < 16; ++jj) { const int j = qd * 16 + jj; float s = 0.f;
        if (j <= i) { for (int d = 0; d < 32; ++d) s += qt[i * 33 + d] * kt[j * 33 + d]; }
        at[i * 65 + j] = s; }
    __syncthreads();
    float o[16]; float ss = 0.f;
#pragma unroll
    for (int ee = 0; ee < 16; ++ee) { const int e = qd * 16 + ee; float s = 0.f;
        for (int d = 0; d < 32; ++d) s += qt[i * 33 + d] * Ss[d * 64 + e];
        for (int j = 0; j <= i; ++j) s += at[i * 65 + j] * bf2f(vv[j * 64 + e]);
        o[ee] = s; ss += s * s; }
    ss += __shfl_xor(ss, 1); ss += __shfl_xor(ss, 2);
    const float rs = rsqrtf(ss * (1.f / 64.f) + EPS);
#pragma unroll
    for (int ee = 0; ee < 16; ++ee) { const int e = qd * 16 + ee;
        const float r = bf2f(GR[(size_t)(tok0 + i) * 256 + h * 64 + e]);
        MIX[(size_t)(tok0 + i) * D_MODEL + 512 + h * 64 + e] = (u16)f2h(o[ee] * rs * gn[h * 64 + e] * silu_f(r)); }
    __syncthreads();
}
__device__ __forceinline__ void pool_item(int item, int t, LAS unsigned char* sm, const u16* UC, const float* wp, const float* psc, u16* MIX) {
    LAS float* pl = (LAS float*)sm;
    const int tok0 = item * 16, g = t >> 6, win = 2 << g;
    for (int tt = 0; tt < 16; ++tt) {
        const int tok = tok0 + tt, pos = tok & (SEQ - 1); const int cnt = (pos + 1 < win) ? pos + 1 : win;
        float s = 0.f;
        for (int j = 0; j < cnt; ++j) s += bf2f(UC[(size_t)(tok - j) * 256 + t]);
        pl[tt * 256 + t] = s / (float)cnt - bf2f(UC[(size_t)tok * 256 + t]);
    }
    __syncthreads();
    const int e = t & 63;
    float acc[16];
#pragma unroll
    for (int tt = 0; tt < 16; ++tt) acc[tt] = 0.f;
    for (int d = 0; d < 64; ++d) { const float wv = wp[(g * 64 + d) * 64 + e];
#pragma unroll
        for (int tt = 0; tt < 16; ++tt) acc[tt] += pl[tt * 256 + g * 64 + d] * wv; }
    const float sc = psc[t];
#pragma unroll
    for (int tt = 0; tt < 16; ++tt) MIX[(size_t)(tok0 + tt) * D_MODEL + 768 + t] = (u16)f2h(acc[tt] * sc);
    __syncthreads();
}


namespace gla {
using attn_body::f32x16; using attn_body::bf16x8; using attn_body::s16x4; using attn_body::cvtpk_s; using attn_body::crow;
constexpr int L_KT = 0;
constexpr int L_PP = 16384;
constexpr int L_Q = 0, L_K = 16384, L_V = 32768, L_S = 65536;
typedef _Float16 f16x8_t __attribute__((ext_vector_type(8)));

__device__ __forceinline__ float dpp_scan64(float v) {
#define GLA_SC(ctrl, rm, bc) v += __int_as_float(__builtin_amdgcn_update_dpp(0, __float_as_int(v), ctrl, rm, 0xf, bc))
    GLA_SC(0x111, 0xf, true); GLA_SC(0x112, 0xf, true); GLA_SC(0x114, 0xf, true); GLA_SC(0x118, 0xf, true); GLA_SC(0x142, 0xa, false); GLA_SC(0x143, 0xc, false);
#undef GLA_SC
    return v;
}
__device__ __forceinline__ float dpp_sum32(float v, int hi) {
#define GLA_SC(ctrl, rm, bc) v += __int_as_float(__builtin_amdgcn_update_dpp(0, __float_as_int(v), ctrl, rm, 0xf, bc))
    GLA_SC(0x111, 0xf, true); GLA_SC(0x112, 0xf, true); GLA_SC(0x114, 0xf, true); GLA_SC(0x118, 0xf, true); GLA_SC(0x142, 0xa, false);
#undef GLA_SC
    const float lo = __int_as_float(__builtin_amdgcn_readlane(__float_as_int(v), 31)), up = __int_as_float(__builtin_amdgcn_readlane(__float_as_int(v), 63));
    return hi ? up : lo;
}
constexpr int L_GT = 98304;
typedef __attribute__((address_space(1))) f32x4 gf4; typedef __attribute__((address_space(1))) u32x4 gu4; typedef __attribute__((address_space(1))) u16 gu16; typedef __attribute__((address_space(1))) float gf1;
__device__ __forceinline__ void gate_table(LAS unsigned char* L, const float* wg, const float* bg, int tid) {
    LAS float* t = (LAS float*)(L + L_GT);
    { const f32x4 v = *(const gf4*)(wg + 4 * tid); *(LAS f32x4*)(t + 4 * tid) = v; }
    if (tid < 32) { const f32x4 v = *(const gf4*)(bg + 4 * tid); *(LAS f32x4*)(t + 2048 + 4 * tid) = v; }
}
__device__ __forceinline__ void gates_load(const float* __restrict__ GL, int tok0, int lane, f32x4 (&g4)[4]) {
#pragma unroll
    for (int r = 0; r < 4; ++r) g4[r] = *(const gf4*)(GL + (size_t)(tok0 + lane) * 16 + 4 * r);
}
__device__ __forceinline__ void gates(const f32x4 (&g4)[4], LAS const unsigned char* L, int h, int dbase, float (&b)[16]) {
    float gl[16]; LAS const float* t = (LAS const float*)(L + L_GT);
#pragma unroll
    for (int r = 0; r < 4; ++r) { gl[4 * r] = g4[r][0]; gl[4 * r + 1] = g4[r][1]; gl[4 * r + 2] = g4[r][2]; gl[4 * r + 3] = g4[r][3]; }
    const int d0 = h * 32 + dbase;
#pragma unroll
    for (int q = 0; q < 4; ++q) {
        f32x4 z = *(LAS const f32x4*)(t + 2048 + d0 + 4 * q);
#pragma unroll
        for (int rh = 0; rh < 2; ++rh) {
            f32x4 w[8];
#pragma unroll
            for (int r = 0; r < 8; ++r) w[r] = *(LAS const f32x4*)(t + (8 * rh + r) * 128 + d0 + 4 * q);
            __builtin_amdgcn_sched_barrier(0);
#pragma unroll
            for (int r = 0; r < 8; ++r) { const float g = gl[8 * rh + r]; z[0] += g * w[r][0]; z[1] += g * w[r][1]; z[2] += g * w[r][2]; z[3] += g * w[r][3]; }
        }
#pragma unroll
        for (int e = 0; e < 4; ++e) b[4 * q + e] = (fminf(z[e], 0.f) - __logf(1.f + __expf(-fabsf(z[e])))    ) * (1.f / 16.f);
    }
#pragma unroll
    for (int dd = 0; dd < 16; ++dd) b[dd] = dpp_scan64(b[dd]);
}
__device__ __forceinline__ void cvt16bf(const u32x4 a, const u32x4 c, float (&x)[16]) {
#pragma unroll
    for (int e = 0; e < 4; ++e) { x[2 * e] = bf2f(a[e] & 0xffffu); x[2 * e + 1] = bf2f(a[e] >> 16); x[8 + 2 * e] = bf2f(c[e] & 0xffffu); x[8 + 2 * e + 1] = bf2f(c[e] >> 16); }
}
__device__ __forceinline__ void load16bf(const u16* p, float (&x)[16]) {
    const u32x4 a = *(const gu4*)p, c = *(const gu4*)(p + 8);
#pragma unroll
    for (int e = 0; e < 4; ++e) { x[2 * e] = bf2f(a[e] & 0xffffu); x[2 * e + 1] = bf2f(a[e] >> 16); x[8 + 2 * e] = bf2f(c[e] & 0xffffu); x[8 + 2 * e + 1] = bf2f(c[e] >> 16); }
}
template <int W>
__device__ __forceinline__ void pool_wave(const u16* __restrict__ UC, const u16* __restrict__ WPT, const float* __restrict__ psc, u16* __restrict__ MIX, int tokw  , int g, int lane, LAS unsigned char* pp) {
    const int pos0 = tokw & (SEQ - 1), col = g * 64 + lane;
    float uu[31 + W];
#pragma unroll
    for (int k = 0; k < 31 + W; ++k) { const int rel = k - (W - 1); uu[k] = (pos0 + rel >= 0) ? bf2f(*(const gu16*)(UC + (size_t)(tokw + rel) * 256 + col)) : 0.f; }
    float run = 0.f;
#pragma unroll
    for (int k = 0; k < W - 1; ++k) run += uu[k];
#pragma unroll
    for (int tt = 0; tt < 32; ++tt) {
        run += uu[tt + W - 1];
        const int pos = pos0 + tt; const float cnt = (float)((pos + 1 < W) ? pos + 1 : W);
        const float pooled = run * __builtin_amdgcn_rcpf(cnt) - uu[tt + W - 1];
        *(LAS u16*)(pp + tt * 128 + lane * 2) = (u16)f2h(pooled);
        run -= uu[tt];
    }
    asm volatile("s_waitcnt lgkmcnt(0)" ::: "memory");
    const int r32 = lane & 31, hh = lane >> 5;
    f32x16 acc[2];
    f16x8_t bw[2][4]; float scv[2];
#pragma unroll
    for (int nb = 0; nb < 2; ++nb) {
#pragma unroll
        for (int ks = 0; ks < 4; ++ks) bw[nb][ks] = *(const __attribute__((address_space(1))) f16x8_t*)(WPT + (size_t)(g * 64 + 32 * nb + r32) * 64 + 8 * hh + 16 * ks);
        scv[nb] = *(const gf1*)(psc + g * 64 + 32 * nb + r32);
    }
#pragma unroll
    for (int nb = 0; nb < 2; ++nb) {
        acc[nb] = zero16();
#pragma unroll
        for (int ks = 0; ks < 4; ++ks) {
            const f16x8_t a = *(LAS const f16x8_t*)(pp + r32 * 128 + (8 * hh + 16 * ks) * 2);
            acc[nb] = __builtin_amdgcn_mfma_f32_32x32x16_f16(a, bw[nb][ks], acc[nb], 0, 0, 0);
        }
#pragma unroll
        for (int r = 0; r < 16; ++r) { *(gu16*)(MIX + (size_t)(tokw + crow(r, hh)) * D_MODEL + 768 + g * 64 + 32 * nb + r32) = (u16)f2h(acc[nb][r] * scv[nb]); if ((r & 3) == 3) __builtin_amdgcn_sched_barrier(0); }
    }
}
__device__ __forceinline__ void pass1_item(int item, LAS unsigned char* L, const float* GL, const u16* GQK, const u16* GV, const u16* UC, const u16* WPT, const float* wg, const float* bg, const float* psc, float* DS, float* DD, u16* MIX, const int WV) {
    const int wave = WV, h = wave >> 1, ib = wave & 1;
    const int b = item >> 7, c = item & 127, tok0 = b * SEQ + c * 64, blk = (b * 4 + h) * 128 + c, dbase = 16 * ib;
    f32x4 g4[4]; u32x4 kra, krb;
    { const int lane0 = otid(WV) & 63; gates_load(GL, tok0, lane0, g4);
      const u16* kp = GQK + (size_t)(tok0 + lane0) * 256 + 128 + h * 32 + dbase; kra = *(const gu4*)kp; krb = *(const gu4*)(kp + 8); }
    gate_table(L, wg, bg, otid(WV)); __syncthreads();
    {
    const int lane = otid(WV) & 63;
    float bc[16]; gates(g4, L, h, dbase, bc);
    float kx[16]; cvt16bf(kra, krb, kx);
#pragma unroll
    for (int dd = 0; dd < 16; ++dd) {
        const float bl = __int_as_float(__builtin_amdgcn_readlane(__float_as_int(bc[dd]), 63));
        *(LAS u16*)(L + L_KT + h * 4096 + (dbase + dd) * 128 + lane * 2) = (u16)f2bf(kx[dd] * __expf(bl - bc[dd]));
        if (lane == 63) *(gf1*)(DD + blk * 32 + dbase + dd) = __expf(bl);
    }
    }
    __syncthreads();
    { const int lane = otid(WV) & 63, r32 = lane & 31, hh = lane >> 5;
    f32x16 acc = zero16();
    bf16x8 bv[4];
#pragma unroll
    for (int ks = 0; ks < 4; ++ks)
#pragma unroll
        for (int jj = 0; jj < 8; ++jj) bv[ks][jj] = (short)*(const gu16*)(GV + (size_t)(tok0 + 8 * hh + 16 * ks + jj) * 256 + h * 64 + 32 * ib + r32);
#pragma unroll
    for (int ks = 0; ks < 4; ++ks) {
        const bf16x8 a = *(LAS const bf16x8*)(L + L_KT + h * 4096 + r32 * 128 + (8 * hh + 16 * ks) * 2);
        acc = __builtin_amdgcn_mfma_f32_32x32x16_bf16(a, bv[ks], acc, 0, 0, 0);
    }
#pragma unroll
    for (int r = 0; r < 16; ++r) *(gf1*)(DS + (size_t)blk * 2048 + crow(r, hh) * 64 + 32 * ib + r32) = acc[r];
    }
    const int lane = otid(WV) & 63;
    LAS unsigned char* pp = L + L_PP + wave * 4096;
    if (h == 0) pool_wave<2>(UC, WPT, psc, MIX, tok0 + 32 * ib, 0, lane, pp);
    else if (h == 1) pool_wave<4>(UC, WPT, psc, MIX, tok0 + 32 * ib, 1, lane, pp);
    else if (h == 2) pool_wave<8>(UC, WPT, psc, MIX, tok0 + 32 * ib, 2, lane, pp);
    else pool_wave<16>(UC, WPT, psc, MIX, tok0 + 32 * ib, 3, lane, pp);
    __syncthreads();
}
__device__ __forceinline__ void pass2_item(int item, LAS unsigned char* L, char* Lg  , const float* GL, const u16* GQK, const u16* GV, const u16* GR, const float* wg, const float* bg, const float* S0, const float* gn, u16* MIX, const int WV) {
    const int tid = otid(WV), lane = tid & 63, wave = __builtin_amdgcn_readfirstlane(tid >> 6), h = wave >> 1, ib = wave & 1, r32 = lane & 31, hh = lane >> 5;
    const int b = item >> 7, c = item & 127, tok0 = b * SEQ + c * 64, blk = (b * 4 + h) * 128 + c, dbase = 16 * ib;
    const unsigned lds0 = (unsigned)(uintptr_t)Lg;
    { const u16* vh = GV + (size_t)tok0 * 256 + h * 64;
#pragma unroll
      for (int pc = 0; pc < 4; ++pc) { const int pw = 4 * ib + pc;
          attn_body::glds16(vh + (size_t)(16 * (pw & 3) + (lane >> 2)) * 256 + (pw >> 2) * 32 + (lane & 3) * 8, (unsigned)__builtin_amdgcn_readfirstlane(lds0 + L_V + h * 8192 + pw * 1024)); } }
    f32x4 g4[4]; u32x4 qra, qrb, kra, krb; float sv[16];
    gates_load(GL, tok0, lane, g4);
    { const u16* qp = GQK + (size_t)(tok0 + lane) * 256 + h * 32 + dbase; qra = *(const gu4*)qp; qrb = *(const gu4*)(qp + 8); kra = *(const gu4*)(qp + 128); krb = *(const gu4*)(qp + 136); }
#pragma unroll
    for (int k = 0; k < 16; ++k) sv[k] = *(const gf1*)(S0 + (size_t)blk * 2048 + ib * 64 + lane + 128 * k);
    gate_table(L, wg, bg, tid); __syncthreads();
    float bc[16]; gates(g4, L, h, dbase, bc);
    { float qx[16], kx[16]; cvt16bf(qra, qrb, qx); cvt16bf(kra, krb, kx);
      u32x4 qa, qb, ka, kb;
#pragma unroll
      for (int e = 0; e < 4; ++e) {
          const float e0 = __expf(bc[2 * e]), e1 = __expf(bc[2 * e + 1]), e2 = __expf(bc[8 + 2 * e]), e3 = __expf(bc[8 + 2 * e + 1]);
          qa[e] = pkbf(qx[2 * e] * 0.17677669529663687f * e0, qx[2 * e + 1] * 0.17677669529663687f * e1); qb[e] = pkbf(qx[8 + 2 * e] * 0.17677669529663687f * e2, qx[8 + 2 * e + 1] * 0.17677669529663687f * e3);
          ka[e] = pkbf(kx[2 * e] * __builtin_amdgcn_rcpf(e0), kx[2 * e + 1] * __builtin_amdgcn_rcpf(e1)); kb[e] = pkbf(kx[8 + 2 * e] * __builtin_amdgcn_rcpf(e2), kx[8 + 2 * e + 1] * __builtin_amdgcn_rcpf(e3)); }
      *(LAS u32x4*)(L + L_Q + h * 4096 + lane * 64 + dbase * 2) = qa; *(LAS u32x4*)(L + L_Q + h * 4096 + lane * 64 + dbase * 2 + 16) = qb;
      *(LAS u32x4*)(L + L_K + h * 4096 + lane * 64 + dbase * 2) = ka; *(LAS u32x4*)(L + L_K + h * 4096 + lane * 64 + dbase * 2 + 16) = kb; }
    {
#pragma unroll
      for (int k = 0; k < 16; ++k) { const int idx = ib * 64 + lane + 128 * k, d = idx >> 6, e = idx & 63; *(LAS u16*)(L + L_S + h * 4096 + e * 64 + d * 2) = (u16)f2bf(sv[k]); } }
    asm volatile("s_waitcnt vmcnt(0)" ::: "memory");
    __syncthreads();
    bf16x8 qf[2];
    f32x16 p0 = zero16(), p1 = zero16();
#pragma unroll
    for (int ks = 0; ks < 2; ++ks) {
        qf[ks] = *(LAS const bf16x8*)(L + L_Q + h * 4096 + (32 * ib + r32) * 64 + (8 * hh + 16 * ks) * 2);
        const bf16x8 k0 = *(LAS const bf16x8*)(L + L_K + h * 4096 + r32 * 64 + (8 * hh + 16 * ks) * 2);
        const bf16x8 k1 = *(LAS const bf16x8*)(L + L_K + h * 4096 + (32 + r32) * 64 + (8 * hh + 16 * ks) * 2);
        p0 = __builtin_amdgcn_mfma_f32_32x32x16_bf16(k0, qf[ks], p0, 0, 0, 0);
        p1 = __builtin_amdgcn_mfma_f32_32x32x16_bf16(k1, qf[ks], p1, 0, 0, 0);
    }
    { const int iq = 32 * ib + r32;
#pragma unroll
      for (int r = 0; r < 16; ++r) { const int j = crow(r, hh); if (j > iq) p0[r] = 0.f; if (j + 32 > iq) p1[r] = 0.f; } }
    f32x16 o[2]; o[0] = zero16(); o[1] = zero16();
#pragma unroll
    for (int nb = 0; nb < 2; ++nb)
#pragma unroll
        for (int ks = 0; ks < 2; ++ks) {
            const bf16x8 sf = *(LAS const bf16x8*)(L + L_S + h * 4096 + (32 * nb + r32) * 64 + (8 * hh + 16 * ks) * 2);
            o[nb] = __builtin_amdgcn_mfma_f32_32x32x16_bf16(qf[ks], sf, o[nb], 0, 0, 0);
        }
    { u32x4 pw0, pw1, pw2, pw3;
      pw0 = (u32x4){cvtpk_s(p0[0], p0[1]), cvtpk_s(p0[2], p0[3]), cvtpk_s(p0[4], p0[5]), cvtpk_s(p0[6], p0[7])};
      pw1 = (u32x4){cvtpk_s(p0[8], p0[9]), cvtpk_s(p0[10], p0[11]), cvtpk_s(p0[12], p0[13]), cvtpk_s(p0[14], p0[15])};
      pw2 = (u32x4){cvtpk_s(p1[0], p1[1]), cvtpk_s(p1[2], p1[3]), cvtpk_s(p1[4], p1[5]), cvtpk_s(p1[6], p1[7])};
      pw3 = (u32x4){cvtpk_s(p1[8], p1[9]), cvtpk_s(p1[10], p1[11]), cvtpk_s(p1[12], p1[13]), cvtpk_s(p1[14], p1[15])};
      int l2 = lane; asm volatile("" : "+v"(l2));
      const int vb = (int)(lds0 + L_V + h * 8192) + ((l2 >> 4) & 1) * 32 + (l2 & 3) * 8 + (4 * (l2 >> 5) + ((l2 & 15) >> 2)) * 64;
      __builtin_amdgcn_sched_barrier(0);
      attn_body::pv(o, vb, __builtin_bit_cast(bf16x8, pw0), __builtin_bit_cast(bf16x8, pw1), __builtin_bit_cast(bf16x8, pw2), __builtin_bit_cast(bf16x8, pw3)); }
    { int l3 = lane; asm volatile("" : "+v"(l3)); const int r3 = l3 & 31, h3 = l3 >> 5;
      u16 grv[16][2];
#pragma unroll
      for (int r = 0; r < 16; ++r)
#pragma unroll
          for (int nb = 0; nb < 2; ++nb) grv[r][nb] = *(const gu16*)(GR + (size_t)(tok0 + 32 * ib + crow(r, h3)) * 256 + h * 64 + 32 * nb + r3);
      const float gn0 = *(const gf1*)(gn + h * 64 + r3), gn1 = *(const gf1*)(gn + h * 64 + 32 + r3);
      __builtin_amdgcn_sched_barrier(0);
#pragma unroll
      for (int r = 0; r < 16; ++r) {
        const float ss = dpp_sum32(o[0][r] * o[0][r] + o[1][r] * o[1][r], h3);
        const float rs = rsqrtf(ss * (1.f / 64.f) + EPS);
        const size_t tok = (size_t)(tok0 + 32 * ib + crow(r, h3));
        *(gu16*)(MIX + tok * D_MODEL + 512 + h * 64 + r3) = (u16)f2h(o[0][r] * rs * gn0 * silu_f(bf2f(grv[r][0])));
        *(gu16*)(MIX + tok * D_MODEL + 512 + h * 64 + 32 + r3) = (u16)f2h(o[1][r] * rs * gn1 * silu_f(bf2f(grv[r][1])));
      } }
    __syncthreads();
}
}

constexpr int CW_BAR = 4096;
constexpr int LDS_BARST = LDS_BYTES - 64;

__device__ __forceinline__ void ph_prologue(const Params& p, LAS unsigned char* L, const int WV) {
    const int tid = otid(WV), lane = tid & 63, wave = tid >> 6;
    LAS float* scr = (LAS float*)(L + WV * TR_SCR_BYTES); LAS float* gains = (LAS float*)(L + TR_GAIN_OFF);
    tr_fill_gains(p, gains, tid); __syncthreads();
    const int gw = blockIdx.x * NWAVES + WV, NGW = gridDim.x * NWAVES;
    wconv_stream(p, 0x0u, 1, wconv_items(0), scr, gains, lane, gw, NGW);
    float* cs = (float*)(p.ws + WS_CS); float* sn = cs + M_TOK * 8;
    for (int i = blockIdx.x * NTHR + tid; i < M_TOK * 8; i += gridDim.x * NTHR) {
        const int t = i >> 3, j = i & 7; const float inv = powf(500000.0f, -(float)(2 * j) / 16.0f); const float ang = (float)p.pos[t] * inv;
        float s, c; sincosf(ang, &s, &c); cs[i] = c; sn[i] = s; }
    { u16* wpt = (u16*)(p.ws + WS_WPT);
      for (int i = blockIdx.x * NTHR + tid; i < DEPTH * 4 * 64 * 64; i += gridDim.x * NTHR) { const int d = i & 63, e = (i >> 6) & 63, lg = i >> 12; wpt[i] = (u16)f2h(p.w_pool[(size_t)lg * 4096 + d * 64 + e]); } }
    for (int m = 4 * gw; m < M_TOK; m += 4 * NGW) xg_row4(p.x + (size_t)m * D_MODEL, (u16*)(p.ws + WS_XG) + (size_t)m * D_MODEL, (float*)(p.ws + WS_RSS) + (size_t)m * 16, lane);
}
__device__ __forceinline__ void ph_proj(const Params& p, int l, LAS unsigned char* L, const int WV) {
    unsigned char* ws = opq(p.ws);
    pg8::Gemm g{(const u16*)(ws + WS_XG), (const u16*)(ws + (l ? WS_WIN1 : WS_WIN0)), M_TOK, NPROJ, D_MODEL, D_MODEL};
    pg8::StaticOrder S; S.init(M_TOK, NPROJ, gridDim.x, blockIdx.x);
    pg8::EpiProj E{(const float*)(ws + WS_RSS), (const float*)(ws + WS_CS), (const float*)(ws + WS_CS) + M_TOK * 8,
                   (u16*)(ws + WS_Q), (u16*)(ws + WS_K), (u16*)(ws + WS_V), (u16*)(ws + WS_QI), (u16*)(ws + WS_KI), (u16*)(ws + WS_GQK), (u16*)(ws + WS_GV), (u16*)(ws + WS_GR), (u16*)(ws + WS_UC),
                   (float*)(ws + WS_WI), (float*)(ws + WS_GL), L + pg8::STAGE_BYTES};
    pg8::gemm_phase<pg8::EpiProj, pg8::StaticOrder, true, true, true>(L, g, S, E, WV);
}
__device__ __forceinline__ void ph_out(const Params& p, int l, LAS unsigned char* L, const int WV, bool dummy = false) {
    unsigned char* ws = opq(p.ws);
    pg8::Gemm g{(const u16*)(ws + WS_MIX), (const u16*)(ws + (l ? WS_WOUT1 : WS_WOUT0)), M_TOK, D_MODEL, D_MODEL, D_MODEL};
    pg8::StaticOrder S; S.init(M_TOK, D_MODEL, gridDim.x, blockIdx.x);
    pg8::EpiResid E{(u16*)(ws + (dummy ? WS_Q : WS_XG)), (float*)(ws + (dummy ? WS_QI : WS_RSS))};
    pg8::gemm_phase<pg8::EpiResid, pg8::StaticOrder, true, true, true>(L, g, S, E, WV);
}
__device__ __forceinline__ void ph_up(const Params& p, int l, LAS unsigned char* L, const int WV) {
    unsigned char* ws = opq(p.ws);
    pg8::Gemm g{(const u16*)(ws + WS_XG), (const u16*)(ws + WS_WUP), M_TOK, 2 * D_FF, D_MODEL, D_MODEL};
    pg8::HaloOrder S; S.init(2 * D_FF, gridDim.x, blockIdx.x);
    pg8::EpiUpConv E{(const float*)(ws + WS_RSS), p.conv_w + (size_t)l * 3 * D_FF, p.conv_b + (size_t)l * D_FF, (u16*)(ws + WS_AB), (LAS float*)(L + pg8::STAGE_BYTES)};
    pg8::gemm_phase<pg8::EpiUpConv, pg8::HaloOrder, true, true, true>(L, g, S, E, WV);
}
__device__ __forceinline__ void ph_down(const Params& p, int l, LAS unsigned char* L, const int WV, bool dummy = false) {
    unsigned char* ws = opq(p.ws);
    pg8::Gemm g{(const u16*)(ws + WS_AB), (const u16*)(ws + WS_WDN), M_TOK, D_MODEL, D_FF, D_FF};
    pg8::StaticOrder S; S.init(M_TOK, D_MODEL, gridDim.x, blockIdx.x);
    pg8::EpiResid E{(u16*)(ws + (dummy ? WS_MIX : WS_XG)), (float*)(ws + (dummy ? WS_LIST : WS_RSS))};
    pg8::gemm_phase<pg8::EpiResid, pg8::StaticOrder, true, true, true>(L, g, S, E, WV);
}
__device__ __forceinline__ void ph_convgate(const Params& p, int l, const int WV) {
    u16* AB = (u16*)(opq(p.ws) + WS_AB);
    const float* cw = p.conv_w + (size_t)l * 3 * D_FF; const float* cb = p.conv_b + (size_t)l * D_FF;
    constexpr int CPR = D_FF / 8;
    for (long it = (long)blockIdx.x * NTHR + otid(WV); it < (long)M_TOK * CPR; it += (long)gridDim.x * NTHR) {
        const int row = (int)(it / CPR), c0 = (int)(it % CPR) * 8, pos = row & (SEQ - 1);
        const u16* pa = AB + (size_t)row * (2 * D_FF) + c0;
        const u32x4 a0 = *(const u32x4*)pa; u32x4 a1 = {0u, 0u, 0u, 0u}, a2 = a1;
        if (pos >= 1) a1 = *(const u32x4*)(pa - 2 * D_FF);
        if (pos >= 2) a2 = *(const u32x4*)(pa - 4 * D_FF);
        const u32x4 bb = *(const u32x4*)(pa + D_FF);
        u32x4 o;
#pragma unroll
        for (int q = 0; q < 4; ++q) {
            float r[2];
#pragma unroll
            for (int e = 0; e < 2; ++e) { const int kk = c0 + q * 2 + e;
                const float x0 = h2f(e ? (a0[q] >> 16) : (a0[q] & 0xffffu)), x1 = h2f(e ? (a1[q] >> 16) : (a1[q] & 0xffffu)), x2 = h2f(e ? (a2[q] >> 16) : (a2[q] & 0xffffu)), bv = h2f(e ? (bb[q] >> 16) : (bb[q] & 0xffffu));
                const float cv = cb[kk] + x2 * cw[kk] + x1 * cw[D_FF + kk] + x0 * cw[2 * D_FF + kk]; r[e] = silu_f(cv) * bv; }
            o[q] = pkh(r[0], r[1]);
        }
        *(u32x4*)(AB + (size_t)row * (2 * D_FF) + D_FF + c0) = o;
    }
}
__device__ __forceinline__ void ph_final(const Params& p, const int WV) {
    unsigned char* wsf = opq(p.ws); const float* rss = (const float*)(wsf + WS_RSS); unsigned* ctl = (unsigned*)(wsf + WS_CTL);
    const unsigned badu = __hip_atomic_load(ctl + CW_FAIL, __ATOMIC_RELAXED, __HIP_MEMORY_SCOPE_AGENT), bado = __hip_atomic_load(ctl + CW_FAIL + 1, __ATOMIC_RELAXED, __HIP_MEMORY_SCOPE_AGENT),
                   badb = __hip_atomic_load(ctl + CW_BAR + XB_TMO, __ATOMIC_RELAXED, __HIP_MEMORY_SCOPE_AGENT);
    const bool bad = (badu | bado | badb) != 0u;
    typedef __attribute__((address_space(1))) f32x4 gf4; typedef unsigned u2v __attribute__((ext_vector_type(2))); typedef __attribute__((address_space(1))) u2v gu2;
    const long total = (long)M_TOK * (D_MODEL / 4), stride = (long)gridDim.x * NTHR;
    long it = (long)blockIdx.x * NTHR + otid(WV);
    for (; it + 3 * stride < total; it += 4 * stride) {
        f32x4 pr[4][4], g[4]; u2v xw[4];
#pragma unroll
        for (int k = 0; k < 4; ++k) { const long i2 = it + k * stride; const int row = (int)(i2 >> 8), c = (int)(i2 & 255) * 4;
#pragma unroll
            for (int q = 0; q < 4; ++q) pr[k][q] = *(const gf4*)(rss + (size_t)row * 16 + 4 * q);
            g[k] = *(const gf4*)(p.final_g + c); xw[k] = *(const gu2*)((const u16*)(wsf + WS_XG) + (size_t)row * D_MODEL + c); }
#pragma unroll
        for (int k = 0; k < 4; ++k) { const long i2 = it + k * stride; const int row = (int)(i2 >> 8), c = (int)(i2 & 255) * 4;
            const f32x4 s4 = (pr[k][0] + pr[k][1]) + (pr[k][2] + pr[k][3]); const float rs = rsqrtf(((s4[0] + s4[1]) + (s4[2] + s4[3])) * (1.f / D_MODEL) + EPS);
            f32x4 o = (f32x4){h2f(xw[k].x & 0xffffu), h2f(xw[k].x >> 16), h2f(xw[k].y & 0xffffu), h2f(xw[k].y >> 16)} * rs * g[k]; if (bad) { const float qn = __builtin_nanf(""); o = (f32x4){qn, qn, qn, qn}; }
            *(gf4*)(p.out + (size_t)row * D_MODEL + c) = o; }
    }
    for (; it < total; it += stride) {
        const int row = (int)(it >> 8), c = (int)(it & 255) * 4; const float rs = pg8::row_rs(rss, row);
        f32x4* px = (f32x4*)(p.out + (size_t)row * D_MODEL + c); const f32x4 g = *(const f32x4*)(p.final_g + c);
        const uint2 xw = *(const uint2*)((const u16*)(wsf + WS_XG) + (size_t)row * D_MODEL + c);
        f32x4 o = (f32x4){h2f(xw.x & 0xffffu), h2f(xw.x >> 16), h2f(xw.y & 0xffffu), h2f(xw.y >> 16)} * rs * g; if (bad) { const float qn = __builtin_nanf(""); o = (f32x4){qn, qn, qn, qn}; } *px = o;
    }
}
__device__ __forceinline__ void ph_mix1(const Params& p, int l, LAS unsigned char* L, const int WV) {
    unsigned char* ws = opq(p.ws); unsigned char* ob = (unsigned char*)opq(p.out);   unsigned* ctl = (unsigned*)(ws + WS_CTL);
    const int tid = otid(WV), lane = tid & 63, wave = tid >> 6, half = tid >> 8, t = tid & 255;
    int useq = 0; const int ctot = l ? wconv_items(2) + wconv_items(3) : 2 * wconv_items(1) + wconv_items(2) + wconv_items(3) + wconv_items(0);
#ifdef REP_TOPK
#pragma unroll 1
    for (int i = 0; i < 4; ++i) {
#else
#pragma unroll 1
    for (int i = 0; i < 2; ++i) {
#endif
        const int pairs = 256;
        for (int w = blockIdx.x; w < pairs; w += gridDim.x) { const int it = ((i & 1) == 0) ? w : 511 - w;
            const ConvJob cj{&p, l ? 0x76u : 0x54321u, l ? 2 : 5, ctot, 4 * useq}; ++useq;
            topk_unit(it & 1, 255 - (it >> 1), (const u16*)(ws + WS_QI), (const u16*)(ws + WS_KI), (const float*)(ws + WS_WI), (unsigned long long*)(ob + OUT_MASK),
                      (uint2*)(ws + WS_LIST) + (size_t)blockIdx.x * 32 * TK_CAP, ctl, L, WV, cj); }
    }
    __syncthreads();
    {
        LAS float* cscr = (LAS float*)(L + (WV < 7 ? WV * 8448 : 133120)); const int cgw = (int)blockIdx.x * NWAVES + WV, cngw = (int)gridDim.x * NWAVES;
#pragma unroll 1
        for (int g = cgw + cngw * 4 * useq; g < ctot; g += cngw) { TrItem ti; f32x2v cv[16]; f32x4 k0v, k1v; tr_decode(p, l ? 0x76u : 0x54321u, l ? 2 : 5, g, lane, ti); tr_load_g(p, ti, lane, cv, k0v, k1v); tr_store_g(ti, lane, cv, k0v, k1v, cscr); }
        __syncthreads();
    }
    for (int item = blockIdx.x; item < 256; item += gridDim.x)
        gla::pass1_item(item, L, (const float*)(ws + WS_GL), (const u16*)(ws + WS_GQK), (const u16*)(ws + WS_GV), (const u16*)(ws + WS_UC), (const u16*)(ws + WS_WPT) + (size_t)l * 16384,
                        p.w_gate_up + l * 16 * 128, p.b_gate + l * 128, p.pool_scale + l * 256, (float*)(ob + OUT_GST), (float*)(ob + OUT_GST + 8 * MiB), (u16*)(ws + WS_MIX), WV);
}
__device__ __forceinline__ void ph_attn(const Params& p, int l, LAS unsigned char* L, char* Lg, const int WV) {
    unsigned char* ws = opq(p.ws); unsigned char* ob = (unsigned char*)opq(p.out);
    unsigned* ctl = (unsigned*)(ws + WS_CTL);
    { float* DS = (float*)(ob + OUT_GST); const float* DD = (const float*)(ob + OUT_GST + 8 * MiB);
      const int tid = otid(WV), el = blockIdx.x * 64 + (tid & 63), seg = tid >> 6, bh = el >> 11, de = el & 2047;
      LAS float* pq = (LAS float*)L;
      __syncthreads();
      typedef __attribute__((address_space(1))) float gfl;
      float dsv[16], ddv[16];
      if (el < 16384) {
#pragma unroll
          for (int k = 0; k < 16; ++k) { const int blk = bh * 128 + seg * 16 + k; ddv[k] = *(const gfl*)(DD + blk * 32 + (de >> 6)); dsv[k] = *(const gfl*)(DS + (size_t)blk * 2048 + de); }
          float P = 1.f, Q = 0.f;
#pragma unroll
          for (int k = 0; k < 16; ++k) { Q = ddv[k] * Q + dsv[k]; P *= ddv[k]; }
          pq[(seg * 64 + (tid & 63)) * 2] = P; pq[(seg * 64 + (tid & 63)) * 2 + 1] = Q;
      }
      __syncthreads();
      if (el < 16384) {
          float S = 0.f;
          for (int s2 = 0; s2 < seg; ++s2) S = pq[(s2 * 64 + (tid & 63)) * 2] * S + pq[(s2 * 64 + (tid & 63)) * 2 + 1];
#pragma unroll
          for (int k = 0; k < 16; ++k) { const int blk = bh * 128 + seg * 16 + k; *(gfl*)(DS + (size_t)blk * 2048 + de) = S; S = ddv[k] * S + dsv[k]; }
      }
    }
    asm volatile("s_waitcnt vmcnt(0)" ::: "memory");
    __syncthreads();
    if (otid(WV) == 0) { __builtin_amdgcn_fence(__ATOMIC_RELEASE, "agent"); asm volatile("s_waitcnt vmcnt(0)" ::: "memory");
        (void)__hip_atomic_fetch_add(ctl + CW_SCAN, 1u, __ATOMIC_RELAXED, __HIP_MEMORY_SCOPE_AGENT); }
    const attn_body::AttnTensors AT{(const attn_body::bf16*)(ws + WS_Q), (const attn_body::bf16*)(ws + WS_K), (const attn_body::bf16*)(ws + WS_V), (unsigned short*)(ws + WS_MIX), (const unsigned long long*)(ob + OUT_MASK)};
    const attn_body::StaticOrder S((int)gridDim.x, (int)blockIdx.x);
    attn_body::attn_phase<attn_body::StaticOrder>((char*)L, AT, S, WV);
#ifdef REP_ATT2
    attn_body::attn_phase<attn_body::StaticOrder>((char*)L, AT, S, WV);
#endif
    __syncthreads();
    if (otid(WV) == 0) { const unsigned target = gridDim.x * (unsigned)(l + 1); unsigned* bar = ctl + CW_BAR;
        XB_SPIN(xb_ld(ctl + CW_SCAN) < target, bar);
        __builtin_amdgcn_fence(__ATOMIC_ACQUIRE, "agent"); asm volatile("s_waitcnt vmcnt(0)" ::: "memory"); }
    __syncthreads();
    for (int item = blockIdx.x; item < 256; item += gridDim.x)
        gla::pass2_item(item, L, Lg, (const float*)(ws + WS_GL), (const u16*)(ws + WS_GQK), (const u16*)(ws + WS_GV), (const u16*)(ws + WS_GR), p.w_gate_up + l * 16 * 128, p.b_gate + l * 128,
                        (const float*)(ob + OUT_GST), p.gla_norm_g + l * 256, (u16*)(ws + WS_MIX), WV);
}

__global__ void __launch_bounds__(NTHR, 2) k_fwd(Params p) {
    extern __shared__ __attribute__((aligned(16))) unsigned char lds[];
    LAS unsigned char* L = (LAS unsigned char*)lds;
    volatile LAS unsigned* st = (volatile LAS unsigned*)(L + LDS_BARST);
    if (threadIdx.x < 16) st[threadIdx.x] = 0u;
    __syncthreads();
    (void)xcd_barrier_post((unsigned*)(p.ws + WS_CTL) + CW_BAR, st);
#define GRID_BAR() do { XcdBarrier bar_; bar_.bar = (unsigned*)(opq(p.ws) + WS_CTL) + CW_BAR; bar_.x = xb_xcc_id(); bar_.st = (volatile LAS unsigned*)(L + LDS_BARST); xcd_barrier(bar_); } while (0)
    const int WV = __builtin_amdgcn_readfirstlane(threadIdx.x >> 6);
    ph_prologue(p, L, WV); GRID_BAR();
#ifdef REP_PRO
    ph_prologue(p, L, WV); GRID_BAR();
#endif
#pragma unroll 1
    for (int l = 0; l < DEPTH; ++l) {
#ifndef NO_PROJ
        ph_proj(p, l, L, WV); GRID_BAR();
#ifdef REP_PROJ
        ph_proj(p, l, L, WV); GRID_BAR();
#endif
#endif
#ifndef NO_MIX1
        ph_mix1(p, l, L, WV); GRID_BAR();
#ifdef REP_MIX1
        ph_mix1(p, l, L, WV); GRID_BAR();
#endif
#endif
        ph_attn(p, l, L, (char*)lds, WV); GRID_BAR();
        ph_out(p, l, L, WV); GRID_BAR();
#ifdef REP_OUT
        ph_out(p, l, L, WV, true); GRID_BAR();
#endif
        ph_up(p, l, L, WV); GRID_BAR();
#ifdef REP_UP
        ph_up(p, l, L, WV); GRID_BAR();
#endif
#ifdef REP_DOWN
        ph_down(p, l, L, WV, true); GRID_BAR();
#endif
        ph_down(p, l, L, WV); GRID_BAR();
    }
    ph_final(p, WV);
#undef GRID_BAR
}

extern "C" void kernel_launch(void* const* d_in, const int* in_sizes, int n_in, void* d_out, int out_size, void* d_ws, size_t ws_size, hipStream_t stream) {
    static int grid = 0;
    if (grid == 0) {
        int dev = 0, cus = 0, per_cu = 0; (void)hipGetDevice(&dev); (void)hipDeviceGetAttribute(&cus, hipDeviceAttributeMultiprocessorCount, dev);
        (void)hipFuncSetAttribute((const void*)k_fwd, hipFuncAttributeMaxDynamicSharedMemorySize, LDS_BYTES);
        (void)hipOccupancyMaxActiveBlocksPerMultiprocessor(&per_cu, (const void*)k_fwd, NTHR, LDS_BYTES);
        (void)hipGetLastError();
        grid = cus > 0 ? cus : 256;
        if (per_cu < 1) fprintf(stderr, "kernel_launch: occupancy query reports %d workgroups per CU\n", per_cu);
        if (ws_size < WS_END) fprintf(stderr, "kernel_launch: workspace too small (%zu)\n", ws_size);
    }
    Params p; memset(&p, 0, sizeof(p));
    p.x = (const float*)d_in[0]; p.pos = (const int*)d_in[1]; p.norm1_g = (const float*)d_in[2]; p.w_in = (const float*)d_in[3]; p.w_gate_up = (const float*)d_in[4]; p.b_gate = (const float*)d_in[5];
    p.gla_norm_g = (const float*)d_in[6]; p.w_pool = (const float*)d_in[7]; p.pool_scale = (const float*)d_in[8]; p.w_out = (const float*)d_in[9]; p.norm2_g = (const float*)d_in[10]; p.w_up = (const float*)d_in[11];
    p.conv_w = (const float*)d_in[12]; p.conv_b = (const float*)d_in[13]; p.w_down = (const float*)d_in[14]; p.final_g = (const float*)d_in[15];
    p.out = (float*)d_out; p.ws = (unsigned char*)d_ws;
    (void)hipMemsetAsync(d_ws, 0, CTL_ZERO_BYTES, stream);
    void* args[] = {&p};
    hipError_t e = hipLaunchCooperativeKernel((const void*)k_fwd, dim3(grid), dim3(NTHR), args, LDS_BYTES, stream);
    if (e != hipSuccess) fprintf(stderr, "kernel_launch: cooperative launch failed: %s (grid %d)\n", hipGetErrorString(e), grid);
}
```
